# Optimizing an MI355X kernel written in HIP

```python
import math
import jax
import jax.numpy as jnp
from jax import lax
import numpy as np

D_MODEL = 2048
BATCH = 1
SEQ = 16384
DEPTH = 4

D_FF = 5504
N_SUB = 3
N_MOD = 3 * N_SUB
A_HEADS = 8
A_QK_DIM = 64
A_V_DIM = 2 * A_QK_DIM
A_WIDTH = A_HEADS * A_V_DIM
B_GROUPS = 8
B_GROUP_DIM = 128
B_WIDTH = B_GROUPS * B_GROUP_DIM
CHUNK = 128
AB_IN = 3 * A_WIDTH + 2 * B_WIDTH
AB_OUT = A_WIDTH + B_WIDTH
C_HEADS = 16
C_KV_HEADS = 4
C_GROUP = C_HEADS // C_KV_HEADS
C_HEAD_DIM = 128
C_WIDTH = C_HEADS * C_HEAD_DIM
C_KV_WIDTH = C_KV_HEADS * C_HEAD_DIM
IDX_HEADS = 16
IDX_DIM = 64
C_IN = C_WIDTH + 2 * C_KV_WIDTH + IDX_HEADS * IDX_DIM + IDX_DIM + IDX_HEADS
TOPK_MAX = 256
REL_BUCKETS = 32
REL_MAX_DIST = 128
REL_HEADS = 16
Q_BLOCK = 128
EPS = 1e-6
N_EVEN = (DEPTH + 1) // 2
N_ODD = DEPTH // 2

kernel_name = 'hybrid_diffattn_sgmlp_dsa_macaron_adaln'


def rms_norm(x, g):
    xf = x.astype(jnp.float32)
    y = xf * lax.rsqrt(jnp.mean(xf * xf, axis=-1, keepdims=True) + EPS)
    return (y * g.astype(jnp.float32)).astype(x.dtype)


def layer_norm(x, g, b):
    xf = x.astype(jnp.float32)
    mu = jnp.mean(xf, axis=-1, keepdims=True)
    var = jnp.mean(jnp.square(xf - mu), axis=-1, keepdims=True)
    y = (xf - mu) * lax.rsqrt(var + EPS)
    return (y * g.astype(jnp.float32) + b.astype(jnp.float32)).astype(x.dtype)


def rel_bucket(dist):
    n = jnp.maximum(dist, 0)
    max_exact = REL_BUCKETS // 2
    nf = jnp.maximum(n, 1).astype(jnp.float32)
    large = max_exact + (jnp.log(nf / max_exact) / math.log(REL_MAX_DIST / max_exact)
                         * (REL_BUCKETS - max_exact)).astype(jnp.int32)
    large = jnp.minimum(large, REL_BUCKETS - 1)
    return jnp.where(n < max_exact, n, large)


def swiglu(h, w1, w2):
    g, u = jnp.split(h @ w1, 2, axis=-1)
    return (jax.nn.silu(g) * u) @ w2


def diff_attention(q, k, v, lam, lam_init, subln_g, rel_table):
    B, S = q.shape[0], q.shape[1]
    nblk = S // Q_BLOCK
    key_pos = jnp.arange(S)
    table = rel_table.reshape(REL_BUCKETS, A_HEADS, 2)
    qb = q.reshape(B, nblk, Q_BLOCK, A_HEADS, 2, A_QK_DIM).swapaxes(0, 1)
    scale = A_QK_DIM ** -0.5

    def block(args):
        qblk, i = args
        qpos = i * Q_BLOCK + jnp.arange(Q_BLOCK)
        dist = qpos[:, None] - key_pos[None, :]
        bias = table[rel_bucket(dist)].transpose(2, 3, 0, 1)
        logits = (jnp.einsum('bqhmd,bshmd->bhmqs', qblk, k).astype(jnp.float32) * scale
                  + bias.astype(jnp.float32))
        logits = jnp.where(dist >= 0, logits, -jnp.inf)
        p = jax.nn.softmax(logits, axis=-1)
        attn = (p[:, :, 0] - lam * p[:, :, 1]).astype(v.dtype)
        return jnp.einsum('bhqs,bshe->bqhe', attn, v)

    out = lax.map(block, (qb, jnp.arange(nblk)))
    out = out.swapaxes(0, 1).reshape(B, S, A_HEADS, A_V_DIM)
    out = rms_norm(out, subln_g) * (1.0 - lam_init)
    return out.reshape(B, S, A_WIDTH)


def chunked_spatial_gating(u, z, ln_g, ln_b, w_s, b_s):
    B, S = u.shape[0], u.shape[1]
    zn = layer_norm(z, ln_g, ln_b)
    zc = zn.reshape(B, S // CHUNK, CHUNK, B_GROUPS, B_GROUP_DIM)
    mask = jnp.tril(jnp.ones((CHUNK, CHUNK), dtype=bool))
    w = jnp.where(mask, w_s, 0)
    sz = jnp.einsum('gts,bnsgc->bntgc', w, zc) + b_s.T[None, None, :, :, None]
    return u * sz.reshape(B, S, B_WIDTH)


def ab_mixer(h, w_in, w_out, lam_p, subln_g, ln_g, ln_b, w_s, b_s, rel_table, layer_idx):
    B, S = h.shape[0], h.shape[1]
    proj = h @ w_in
    qa, ka, va, zb = jnp.split(proj, [A_WIDTH, 2 * A_WIDTH, 3 * A_WIDTH], axis=-1)
    q = qa.reshape(B, S, A_HEADS, 2, A_QK_DIM)
    k = ka.reshape(B, S, A_HEADS, 2, A_QK_DIM)
    v = va.reshape(B, S, A_HEADS, A_V_DIM)
    lam_init = 0.8 - 0.6 * math.exp(-0.3 * layer_idx)
    lp = lam_p.astype(jnp.float32)
    lam = jnp.exp(jnp.sum(lp[0] * lp[1])) - jnp.exp(jnp.sum(lp[2] * lp[3])) + lam_init
    ya = diff_attention(q, k, v, lam, lam_init, subln_g, rel_table)
    u, z = jnp.split(jax.nn.gelu(zb), 2, axis=-1)
    yb = chunked_spatial_gating(u, z, ln_g, ln_b, w_s, b_s)
    return jnp.concatenate([ya, yb], axis=-1) @ w_out


def dsa_mixer(h, w_in, w_out, rel_table):
    B, S = h.shape[0], h.shape[1]
    proj = h @ w_in
    s1 = C_WIDTH
    s2 = s1 + C_KV_WIDTH
    s3 = s2 + C_KV_WIDTH
    s4 = s3 + IDX_HEADS * IDX_DIM
    s5 = s4 + IDX_DIM
    qc, kc, vc, qi, ki, wi = jnp.split(proj, [s1, s2, s3, s4, s5], axis=-1)
    q = qc.reshape(B, S, C_KV_HEADS, C_GROUP, C_HEAD_DIM)
    k = kc.reshape(B, S, C_KV_HEADS, C_HEAD_DIM)
    v = vc.reshape(B, S, C_KV_HEADS, C_HEAD_DIM)
    q_idx = qi.reshape(B, S, IDX_HEADS, IDX_DIM)
    k_idx = ki
    topk = min(TOPK_MAX, S // 4)
    nblk = S // Q_BLOCK
    key_pos = jnp.arange(S)
    gather = jax.vmap(lambda arr, idx: arr[idx])

    def to_blocks(a):
        return a.reshape(B, nblk, Q_BLOCK, *a.shape[2:]).swapaxes(0, 1)

    def block(args):
        qblk, qiblk, wblk, i = args
        qpos = i * Q_BLOCK + jnp.arange(Q_BLOCK)
        sc = jnp.einsum('bqhd,bsd->bqhs', qiblk, k_idx).astype(jnp.float32) * IDX_DIM ** -0.5
        iscore = jnp.einsum('bqhs,bqh->bqs', jax.nn.relu(sc), wblk.astype(jnp.float32))
        iscore = jnp.where(key_pos[None, None, :] <= qpos[None, :, None], iscore, -jnp.inf)
        _, sel = lax.top_k(iscore, topk)
        valid = sel <= qpos[None, :, None]
        k_sel = gather(k, sel)
        v_sel = gather(v, sel)
        bias = rel_table[rel_bucket(qpos[None, :, None] - sel)]
        bias = bias.reshape(B, Q_BLOCK, topk, C_KV_HEADS, C_GROUP).transpose(0, 3, 4, 1, 2)
        logits = (jnp.einsum('bqgrd,bqkgd->bgrqk', qblk, k_sel).astype(jnp.float32)
                  * C_HEAD_DIM ** -0.5 + bias.astype(jnp.float32))
        logits = jnp.where(valid[:, None, None], logits, -jnp.inf)
        p = jax.nn.softmax(logits, axis=-1).astype(v.dtype)
        return jnp.einsum('bgrqk,bqkgd->bqgrd', p, v_sel)

    out = lax.map(block, (to_blocks(q), to_blocks(q_idx), to_blocks(wi), jnp.arange(nblk)))
    out = out.swapaxes(0, 1).reshape(B, S, C_WIDTH)
    return out @ w_out


def setup_inputs(seed: int = 0) -> dict:
    key = jax.random.key(seed)
    ks = jax.random.split(key, 19)

    def nrm(k, shape, scale):
        return jax.random.normal(k, shape, jnp.float32) * scale

    return {
        'x': nrm(ks[0], (BATCH, SEQ, D_MODEL), 1.0),
        'c': nrm(ks[1], (BATCH, D_MODEL), 1.0),
        'norm_g': 1.0 + nrm(ks[2], (DEPTH, N_SUB, D_MODEL), 0.02),
        'mod_w': nrm(ks[3], (DEPTH, D_MODEL, N_MOD * D_MODEL), 0.1 * D_MODEL ** -0.5),
        'mod_b': nrm(ks[4], (DEPTH, N_MOD * D_MODEL), 0.01),
        'ffn_w1': nrm(ks[5], (DEPTH, 2, D_MODEL, 2 * D_FF), D_MODEL ** -0.5),
        'ffn_w2': nrm(ks[6], (DEPTH, 2, D_FF, D_MODEL), D_FF ** -0.5),
        'rel_table': nrm(ks[7], (REL_BUCKETS, REL_HEADS), 0.5),
        'ab_w_in': nrm(ks[8], (N_EVEN, D_MODEL, AB_IN), D_MODEL ** -0.5),
        'ab_w_out': nrm(ks[9], (N_EVEN, AB_OUT, D_MODEL), AB_OUT ** -0.5),
        'diff_lam': nrm(ks[10], (N_EVEN, 4, A_QK_DIM), 0.1),
        'diff_subln_g': 1.0 + nrm(ks[11], (N_EVEN, A_V_DIM), 0.02),
        'sg_ln_g': 1.0 + nrm(ks[12], (N_EVEN, B_WIDTH), 0.02),
        'sg_ln_b': nrm(ks[13], (N_EVEN, B_WIDTH), 0.02),
        'sg_w': nrm(ks[14], (N_EVEN, B_GROUPS, CHUNK, CHUNK), CHUNK ** -0.5),
        'sg_b': 1.0 + nrm(ks[15], (N_EVEN, B_GROUPS, CHUNK), 0.02),
        'dsa_w_in': nrm(ks[16], (N_ODD, D_MODEL, C_IN), D_MODEL ** -0.5),
        'dsa_w_out': nrm(ks[17], (N_ODD, C_WIDTH, D_MODEL), C_WIDTH ** -0.5),
        'final_g': 1.0 + nrm(ks[18], (D_MODEL,), 0.02),
    }


def reference(x, c, norm_g, mod_w, mod_b, ffn_w1, ffn_w2, rel_table, ab_w_in, ab_w_out,
              diff_lam, diff_subln_g, sg_ln_g, sg_ln_b, sg_w, sg_b, dsa_w_in, dsa_w_out,
              final_g):
    B = x.shape[0]
    cs = jax.nn.silu(c)
    for li in range(DEPTH):
        mod = (cs @ mod_w[li] + mod_b[li]).reshape(B, N_MOD, D_MODEL)

        def pre(h, j):
            shift, scale = mod[:, 3 * j], mod[:, 3 * j + 1]
            return rms_norm(h, norm_g[li, j]) * (1.0 + scale[:, None, :]) + shift[:, None, :]

        def gate(j):
            return (1.0 + mod[:, 3 * j + 2])[:, None, :]

        x = x + 0.5 * gate(0) * swiglu(pre(x, 0), ffn_w1[li, 0], ffn_w2[li, 0])
        h = pre(x, 1)
        if li % 2 == 0:
            j = li // 2
            y = ab_mixer(h, ab_w_in[j], ab_w_out[j], diff_lam[j], diff_subln_g[j],
                         sg_ln_g[j], sg_ln_b[j], sg_w[j], sg_b[j], rel_table, li)
        else:
            j = li // 2
            y = dsa_mixer(h, dsa_w_in[j], dsa_w_out[j], rel_table)
        x = x + gate(1) * y
        x = x + 0.5 * gate(2) * swiglu(pre(x, 2), ffn_w1[li, 1], ffn_w2[li, 1])
    return rms_norm(x, final_g)
```

```cpp
#define MK_MULTI 0
#define MK_AB 1
#define MK_DSA 1
#include <hip/hip_runtime.h>
#include <cstdio>
#include <cstdint>
#ifndef MK_DIAG
#define MK_DIAG 0
#endif
#ifndef MK_DIAGJ
#define MK_DIAGJ 0
#endif
#ifndef MK_DUP
#define MK_DUP 0
#endif
#ifndef MK_MULTI
#define MK_MULTI 0
#endif

namespace pg8 {
#define PG8_LAS __attribute__((address_space(3)))
typedef unsigned short bf16_t;
typedef short bf16x8 __attribute__((ext_vector_type(8)));
typedef float f32x4 __attribute__((ext_vector_type(4)));
typedef unsigned u32x4 __attribute__((ext_vector_type(4)));
constexpr int BM = 256, BK = 64, HALF = 128, HTB = HALF * BK * 2  , STAGE_BYTES = 8 * HTB, NXCD = 8, WGM = 8;

__host__ __device__ __forceinline__ int lds_byte(int r, int c) { const int st = (r >> 4) * 2 + (c >> 5), rr = r & 15, cc = c & 31, ob = rr * 64 + cc * 2; return st * 1024 + (ob ^ (((ob >> 9) & 1) << 5)); }
__host__ __device__ __forceinline__ void stage_rc(int b, int& R, int& C) { const int st = b / 1024, sb = b % 1024, swz = sb ^ (((sb >> 9) & 1) << 5); R = (st >> 1) * 16 + swz / 64; C = (st & 1) * 32 + (swz % 64) / 2; }
__host__ __device__ __forceinline__ int perm32(int rho) { const int n = rho >> 4, i = rho & 15; return 8 * (i >> 2) + 4 * n + (i & 3); }

struct Unit { int pm, pn; };
struct Gemm { const bf16_t* A; const bf16_t* Bt; int M, N, K; };

struct StaticOrder {
    int nM, nN, nwg, G, c;
    __host__ __device__ void init(int M, int N, int G_, int c_) { nM = M / BM; nN = N / BM; nwg = nM * nN; G = G_; c = c_; }
    __host__ __device__ bool next(int i, Unit& u) const {
        const long L = (long)i * G + c; if (L >= nwg) return false;
        int wgid = (int)L; { const int q = nwg / NXCD, r = nwg % NXCD, xcd = wgid % NXCD, off = wgid / NXCD; wgid = (xcd < r ? xcd * (q + 1) : r * (q + 1) + (xcd - r) * q) + off; }
        const int nig = WGM * nN, gid = wgid / nig, fm = gid * WGM, gsz = (nM - fm) < WGM ? (nM - fm) : WGM;
        u.pm = fm + ((wgid % nig) % gsz); u.pn = (wgid % nig) / gsz; return true;
    }
    __device__ __forceinline__ void a_ready(const Unit&) const {}
    __device__ __forceinline__ void done(const Unit&) const {}
};

__device__ __forceinline__ unsigned cvt_pk_bf16(float lo, float hi) { unsigned r; asm volatile("v_cvt_pk_bf16_f32 %0, %1, %2" : "=v"(r) : "v"(lo), "v"(hi)); return r; }
typedef float f32x2 __attribute__((ext_vector_type(2)));

__device__ __forceinline__ float fast_sigmoid(float x) { return __builtin_amdgcn_rcpf(1.0f + __builtin_amdgcn_exp2f(-1.4426950408889634f * x)); }
struct EpiSwiglu {
    static constexpr bool PERM = true, AFTER_DRAIN = false;
    bf16_t* O; int ldc;
    __device__ __forceinline__ void operator()(const f32x4 (&acc)[2][2][4][2], const Unit& u, int wr, int wc, int fr, int fq) const {
        const int row0 = u.pm * BM + wr * 64 + fr, col0 = u.pn * HALF + wc * 32 + 8 * fq;
#pragma unroll
        for (int ai = 0; ai < 2; ++ai)
#pragma unroll
            for (int m = 0; m < 4; ++m) { bf16_t* rowp = O + (size_t)(row0 + ai * HALF + m * 16) * ldc + col0;
                const f32x4 g0 = acc[ai][0][m][0], g1 = acc[ai][0][m][1], u0 = acc[ai][1][m][0], u1 = acc[ai][1][m][1];
                float v[8];
#pragma unroll
                for (int j = 0; j < 4; ++j) { v[j] = g0[j] * fast_sigmoid(g0[j]) * u0[j]; v[4 + j] = g1[j] * fast_sigmoid(g1[j]) * u1[j]; }
                u32x4 w; w.x = cvt_pk_bf16(v[0], v[1]); w.y = cvt_pk_bf16(v[2], v[3]); w.z = cvt_pk_bf16(v[4], v[5]); w.w = cvt_pk_bf16(v[6], v[7]);
                *(u32x4*)rowp = w; }
    }
};
struct EpiResid {
    static constexpr bool PERM = false, AFTER_DRAIN = false;
    const float* base; float* out; const float* coef; int ldc;
    __device__ __forceinline__ void operator()(const f32x4 (&acc)[2][2][4][2], const Unit& u, int wr, int wc, int fr, int fq) const {
        const int row0 = u.pm * BM + wr * 64 + fr, col0 = u.pn * BM + wc * 32 + 4 * fq;
        f32x4 cv[2][2];
#pragma unroll
        for (int bj = 0; bj < 2; ++bj)
#pragma unroll
            for (int n = 0; n < 2; ++n) cv[bj][n] = *(const f32x4*)(coef + col0 + bj * HALF + n * 16);
#pragma unroll
        for (int ai = 0; ai < 2; ++ai)
#pragma unroll
            for (int m = 0; m < 4; ++m) { const size_t off = (size_t)(row0 + ai * HALF + m * 16) * ldc + col0;
#pragma unroll
                for (int bj = 0; bj < 2; ++bj)
#pragma unroll
                    for (int n = 0; n < 2; ++n) { const f32x4 b = *(const f32x4*)(base + off + bj * HALF + n * 16);
                        *(f32x4*)(out + off + bj * HALF + n * 16) = b + cv[bj][n] * acc[ai][bj][m][n]; } }
    }
};
struct EpiProj {
    static constexpr bool PERM = true, AFTER_DRAIN = false;
    bf16_t* O; int ldc; int nscale; float scale; int gelu_from;
    __device__ __forceinline__ void operator()(const f32x4 (&acc)[2][2][4][2], const Unit& u, int wr, int wc, int fr, int fq) const {
        const int row0 = u.pm * BM + wr * 64 + fr, col0 = u.pn * BM + wc * 32 + 8 * fq;
        const float sc = (u.pn < nscale) ? scale : 1.0f; const bool gl = (u.pn >= gelu_from);
#pragma unroll
        for (int ai = 0; ai < 2; ++ai)
#pragma unroll
            for (int m = 0; m < 4; ++m) { bf16_t* rowp = O + (size_t)(row0 + ai * HALF + m * 16) * ldc + col0;
#pragma unroll
                for (int bj = 0; bj < 2; ++bj) { f32x4 v0 = acc[ai][bj][m][0] * sc, v1 = acc[ai][bj][m][1] * sc;
                    if (gl) {
#pragma unroll
                        for (int j = 0; j < 4; ++j) { const float a = v0[j], b = v1[j];
                            v0[j] = a * fast_sigmoid(1.5957691216057308f * (a + 0.044715f * a * a * a));
                            v1[j] = b * fast_sigmoid(1.5957691216057308f * (b + 0.044715f * b * b * b)); } }
                    u32x4 w; w.x = cvt_pk_bf16(v0[0], v0[1]); w.y = cvt_pk_bf16(v0[2], v0[3]); w.z = cvt_pk_bf16(v1[0], v1[1]); w.w = cvt_pk_bf16(v1[2], v1[3]);
                    *(u32x4*)(rowp + bj * HALF) = w; } }
    }
};

template <class Epi, class Sched, bool ALIGN_EPI = false, bool SP2 = false>
__device__ __forceinline__ void gemm_phase(PG8_LAS unsigned char* lds, const Gemm g, const Sched& S, const Epi& E) {
    int tid_ = threadIdx.x; asm volatile("" : "+v"(tid_));
    const int tid = tid_, wid = __builtin_amdgcn_readfirstlane(tid >> 6), lane = tid & 63, wr = wid >> 2, wc = wid & 3, fr = lane & 15, fq = lane >> 4;
    const int K = g.K, nt = K / BK;
    unsigned voffA[2], voffB[2];
#pragma unroll
    for (int i = 0; i < 2; ++i) { int R, C; stage_rc(tid * 16 + i * 8192, R, C); const int Rb = Epi::PERM ? ((R & ~31) + perm32(R & 31)) : R;
        voffA[i] = (unsigned)(R * K + C) * 2u; voffB[i] = (unsigned)(Rb * K + C) * 2u; }
    const size_t kstep = (size_t)(BK * 2);
    const size_t hstep = (size_t)HALF * K * 2;
    const size_t tstep = 2 * hstep;
    const unsigned ldsw = (unsigned)wid * 1024u;
    const int aoff = lds_byte(wr * 64 + fr, fq * 8), boff = lds_byte(wc * 32 + fr, fq * 8);
#define PG8_SA(b, h) (((b) * 2 + (h)) * HTB)
#define PG8_SB(b, h) ((4 + (b) * 2 + (h)) * HTB)
#define PG8_STAGE(bufoff, gbase, voff) do { _Pragma("unroll") for (int _i = 0; _i < 2; ++_i) \
        __builtin_amdgcn_global_load_lds((const unsigned*)((const char*)(gbase) + (voff)[_i]), (PG8_LAS unsigned*)(lds + (bufoff) + ldsw + _i * 8192), 16, 0, 0); } while (0)
#define PG8_LDA(dst, b, h) do { _Pragma("unroll") for (int m = 0; m < 4; ++m) _Pragma("unroll") for (int k = 0; k < 2; ++k) dst[m][k] = *(const PG8_LAS bf16x8*)(lds + PG8_SA(b, h) + aoff + m * 2048 + k * 1024); } while (0)
#define PG8_LDB(dst, b, h) do { _Pragma("unroll") for (int n = 0; n < 2; ++n) _Pragma("unroll") for (int k = 0; k < 2; ++k) dst[n][k] = *(const PG8_LAS bf16x8*)(lds + PG8_SB(b, h) + boff + n * 2048 + k * 1024); } while (0)
#define PG8_MMA(ai, bj, At, Bt) do { __builtin_amdgcn_s_setprio(1); _Pragma("unroll") for (int m = 0; m < 4; ++m) _Pragma("unroll") for (int n = 0; n < 2; ++n) _Pragma("unroll") for (int k = 0; k < 2; ++k) \
        acc[ai][bj][m][n] = __builtin_amdgcn_mfma_f32_16x16x32_bf16(Bt[n][k], At[m][k], acc[ai][bj][m][n], 0, 0, 0); __builtin_amdgcn_s_setprio(0); } while (0)
#define PG8_WAIT_V(n) asm volatile("s_waitcnt vmcnt(" #n ")" ::: "memory")
#define PG8_WAIT_L(n) asm volatile("s_waitcnt lgkmcnt(" #n ")" ::: "memory")
#define PG8_BAR __builtin_amdgcn_s_barrier()
#define PG8_SCHED __builtin_amdgcn_sched_barrier(0)
    Unit cur, nxt; int ui = 0;
    if (!S.next(0, cur)) return;
    f32x4 acc[2][2][4][2];
#pragma unroll
    for (int a = 0; a < 2; ++a)
#pragma unroll
        for (int b = 0; b < 2; ++b)
#pragma unroll
            for (int m = 0; m < 4; ++m)
#pragma unroll
                for (int n = 0; n < 2; ++n) acc[a][b][m][n] = (f32x4){0.f, 0.f, 0.f, 0.f};
    bf16x8 At[4][2], B0[2][2], B1[2][2];
    const char* cA = (const char*)g.A + (size_t)cur.pm * tstep; const char* cB = (const char*)g.Bt + (size_t)cur.pn * tstep;
    S.a_ready(cur);
    if constexpr (SP2) {
        PG8_STAGE(PG8_SB(0, 0), cB, voffB); PG8_STAGE(PG8_SB(0, 1), cB + hstep, voffB); PG8_STAGE(PG8_SA(0, 0), cA, voffA); PG8_STAGE(PG8_SA(0, 1), cA + hstep, voffA);
        if (wr == 1) PG8_BAR;
        PG8_WAIT_V(2); PG8_BAR;
        PG8_STAGE(PG8_SB(1, 0), cB + kstep, voffB); PG8_STAGE(PG8_SA(1, 0), cA + kstep, voffA); PG8_STAGE(PG8_SB(1, 1), cB + hstep + kstep, voffB);
        PG8_WAIT_V(6); PG8_BAR;
    } else {
        PG8_STAGE(PG8_SB(0, 0), cB, voffB); PG8_STAGE(PG8_SA(0, 0), cA, voffA); PG8_STAGE(PG8_SB(0, 1), cB + hstep, voffB); PG8_STAGE(PG8_SA(0, 1), cA + hstep, voffA);
        if (wr == 1) PG8_BAR;
        PG8_WAIT_V(4); PG8_BAR;
        PG8_STAGE(PG8_SB(1, 0), cB + kstep, voffB); PG8_STAGE(PG8_SA(1, 0), cA + kstep, voffA); PG8_STAGE(PG8_SB(1, 1), cB + hstep + kstep, voffB);
        PG8_WAIT_V(6); PG8_BAR;
    }
    for (;;) {
        const bool has_next = S.next(ui + 1, nxt);
        const char* nA = has_next ? (const char*)g.A + (size_t)nxt.pm * tstep : cA; const char* nB = has_next ? (const char*)g.Bt + (size_t)nxt.pn * tstep : cB;
        for (int t = 0; t < nt; t += 2) {
            const bool last = (t == nt - 2);
            const char* a1 = cA + (size_t)(t + 1) * kstep;
            const char* a2 = last ? nA : cA + (size_t)(t + 2) * kstep; const char* b2 = last ? nB : cB + (size_t)(t + 2) * kstep;
            const char* a3 = a2 + kstep; const char* b3 = b2 + kstep;
            if (last && has_next) S.a_ready(nxt);
            if constexpr (SP2) {
            PG8_LDB(B0, 0, 0); PG8_LDB(B1, 0, 1); PG8_SCHED; PG8_LDA(At, 0, 0); PG8_STAGE(PG8_SA(1, 1), a1 + hstep, voffA);
            PG8_WAIT_V(8); PG8_WAIT_L(0); PG8_BAR; PG8_MMA(0, 0, At, B0); PG8_MMA(0, 1, At, B1); PG8_BAR; PG8_SCHED;
            PG8_LDA(At, 0, 1); PG8_STAGE(PG8_SB(0, 0), b2, voffB); PG8_STAGE(PG8_SB(0, 1), b2 + hstep, voffB); PG8_STAGE(PG8_SA(0, 0), a2, voffA);
            PG8_WAIT_V(8); PG8_WAIT_L(0); PG8_BAR; PG8_MMA(1, 0, At, B0); PG8_MMA(1, 1, At, B1); PG8_BAR; PG8_SCHED;
            PG8_LDB(B0, 1, 0); PG8_LDB(B1, 1, 1); PG8_SCHED; PG8_LDA(At, 1, 0); PG8_STAGE(PG8_SA(0, 1), a2 + hstep, voffA);
            PG8_WAIT_V(8); PG8_WAIT_L(0); PG8_BAR; PG8_MMA(0, 0, At, B0); PG8_MMA(0, 1, At, B1); PG8_BAR; PG8_SCHED;
            PG8_LDA(At, 1, 1); PG8_STAGE(PG8_SB(1, 0), b3, voffB); PG8_STAGE(PG8_SB(1, 1), b3 + hstep, voffB); PG8_STAGE(PG8_SA(1, 0), a3, voffA);
            PG8_WAIT_V(8); PG8_WAIT_L(0); PG8_BAR; PG8_MMA(1, 0, At, B0); PG8_MMA(1, 1, At, B1); PG8_BAR; PG8_SCHED;
            } else {
            PG8_LDB(B0, 0, 0); PG8_SCHED; PG8_LDA(At, 0, 0); PG8_STAGE(PG8_SA(1, 1), a1 + hstep, voffA);
            PG8_WAIT_L(8); PG8_BAR; PG8_WAIT_L(0); PG8_MMA(0, 0, At, B0); PG8_BAR; PG8_SCHED;
            PG8_LDB(B1, 0, 1); PG8_STAGE(PG8_SB(0, 0), b2, voffB);
            PG8_BAR; PG8_WAIT_L(0); PG8_MMA(0, 1, At, B1); PG8_BAR;
            PG8_LDA(At, 0, 1); PG8_STAGE(PG8_SA(0, 0), a2, voffA);
            PG8_BAR; PG8_WAIT_L(0); PG8_MMA(1, 0, At, B0); PG8_BAR; PG8_SCHED;
            PG8_STAGE(PG8_SB(0, 1), b2 + hstep, voffB);
            PG8_WAIT_V(6); PG8_BAR; PG8_MMA(1, 1, At, B1); PG8_BAR;
            PG8_LDB(B0, 1, 0); PG8_SCHED; PG8_LDA(At, 1, 0); PG8_STAGE(PG8_SA(0, 1), a2 + hstep, voffA);
            PG8_WAIT_L(8); PG8_BAR; PG8_WAIT_L(0); PG8_MMA(0, 0, At, B0); PG8_BAR; PG8_SCHED;
            PG8_LDB(B1, 1, 1); PG8_STAGE(PG8_SB(1, 0), b3, voffB);
            PG8_BAR; PG8_WAIT_L(0); PG8_MMA(0, 1, At, B1); PG8_BAR;
            PG8_LDA(At, 1, 1); PG8_STAGE(PG8_SA(1, 0), a3, voffA);
            PG8_BAR; PG8_WAIT_L(0); PG8_MMA(1, 0, At, B0); PG8_BAR; PG8_SCHED;
            PG8_STAGE(PG8_SB(1, 1), b3 + hstep, voffB);
            PG8_WAIT_V(6); PG8_BAR; PG8_MMA(1, 1, At, B1); PG8_BAR;
            }
        }
        if constexpr (ALIGN_EPI) { if (wr == 0) PG8_BAR; }
        if constexpr (!Epi::AFTER_DRAIN) { E(acc, cur, wr, wc, fr, fq); S.done(cur); }
        if (!has_next) break;
#pragma unroll
        for (int a = 0; a < 2; ++a)
#pragma unroll
            for (int b = 0; b < 2; ++b)
#pragma unroll
                for (int m = 0; m < 4; ++m)
#pragma unroll
                    for (int n = 0; n < 2; ++n) acc[a][b][m][n] = (f32x4){0.f, 0.f, 0.f, 0.f};
        cur = nxt; cA = nA; cB = nB; ++ui;
        if constexpr (ALIGN_EPI) { if (wr == 1) PG8_BAR; }
    }
    PG8_WAIT_V(0);
    if constexpr (!ALIGN_EPI) { if (wr == 0) PG8_BAR; }
    PG8_BAR;
    if constexpr (Epi::AFTER_DRAIN) { E.fused(acc, cur, wr, wc, fr, fq, lds, wid, lane); S.done(cur); }
#undef PG8_SA
#undef PG8_SB
#undef PG8_STAGE
#undef PG8_LDA
#undef PG8_LDB
#undef PG8_MMA
#undef PG8_WAIT_V
#undef PG8_WAIT_L
#undef PG8_BAR
#undef PG8_SCHED
}
}

constexpr int S = 16384, D = 2048, DEPTH = 4, DFF = 5504, NMODV = 9 * 2048;
constexpr int ABN = 5120, CIN = 4176, CINP = 4352;
constexpr float EPS = 1e-6f, LOG2E = 1.4426950408889634f;
constexpr int NWAVES = 8;
constexpr size_t MiB = 1u << 20;
constexpr size_t WS_CTL = 0, CTL_ZERO_BYTES = 1 * MiB;
constexpr size_t WS_PART = 1 * MiB, WS_VEC = 3 * MiB;
constexpr size_t WS_W1T = 4 * MiB, WS_W2T = 348 * MiB, WS_ABIN = 520 * MiB, WS_ABOUT = 560 * MiB, WS_DSAIN = 576 * MiB, WS_DSAOUT = 610 * MiB;
constexpr size_t WS_XRES = 626 * MiB, WS_XN = 754 * MiB, WS_H = 818 * MiB, WS_PROJ = 990 * MiB, WS_CAT = 1150 * MiB, WS_SEL = 1214 * MiB, WS_END = 1222 * MiB;
constexpr size_t W1T_SZ = (size_t)2 * DFF * D, W2T_SZ = (size_t)D * DFF, ABIN_SZ = (size_t)ABN * D, SQ_SZ = (size_t)D * D, DSAIN_SZ = (size_t)CINP * D;
static_assert(WS_W1T + 8 * W1T_SZ * 2 <= WS_W2T && WS_W2T + 8 * W2T_SZ * 2 <= WS_ABIN && WS_ABIN + 2 * ABIN_SZ * 2 <= WS_ABOUT && WS_ABOUT + 2 * SQ_SZ * 2 <= WS_DSAIN &&
              WS_DSAIN + 2 * DSAIN_SZ * 2 <= WS_DSAOUT && WS_DSAOUT + 2 * SQ_SZ * 2 <= WS_XRES && WS_XRES + (size_t)S * D * 4 <= WS_XN && WS_XN + (size_t)S * D * 2 <= WS_H &&
              WS_H + (size_t)S * DFF * 2 <= WS_PROJ && WS_PROJ + (size_t)S * ABN * 2 <= WS_CAT && WS_CAT + (size_t)S * D * 2 <= WS_SEL && WS_SEL + (size_t)S * 256 * 2 <= WS_END, "d_ws map");
constexpr int CW_BAR = 4096;
constexpr int RING_BYTES = 147456;
constexpr int MISC_OFF = RING_BYTES;
constexpr int INP_OFF = RING_BYTES + 256;
constexpr int LDS_BYTES = RING_BYTES + 512;

#define GAS __attribute__((address_space(1)))
#define LAS __attribute__((address_space(3)))
typedef unsigned short bf16;
typedef unsigned v4u __attribute__((ext_vector_type(4)));
typedef unsigned v2u __attribute__((ext_vector_type(2)));
typedef float f32x4 __attribute__((ext_vector_type(4)));
typedef float f32x16 __attribute__((ext_vector_type(16)));
typedef short bf16x8 __attribute__((ext_vector_type(8)));
typedef short s16x4 __attribute__((ext_vector_type(4)));
typedef GAS unsigned gu32;
#define LDS_WAIT() asm volatile("s_waitcnt lgkmcnt(0)" ::: "memory")
#define VM_WAIT() asm volatile("s_waitcnt vmcnt(0)" ::: "memory")
__device__ __forceinline__ unsigned f2bf(float f) { unsigned u = __builtin_bit_cast(unsigned, f); return (u + 0x7fffu + ((u >> 16) & 1u)) >> 16; }
__device__ __forceinline__ unsigned pk2(float lo, float hi) { return f2bf(lo) | (f2bf(hi) << 16); }
__device__ __forceinline__ float bf2f(unsigned short b) { return __builtin_bit_cast(float, (unsigned)b << 16); }
typedef float f32x2_t __attribute__((ext_vector_type(2))); typedef __bf16 bf16x2_t __attribute__((ext_vector_type(2)));
__device__ __forceinline__ unsigned cvtpk(float lo, float hi) { f32x2_t v = {lo, hi}; bf16x2_t b = __builtin_convertvector(v, bf16x2_t); return __builtin_bit_cast(unsigned, b); }
__device__ __forceinline__ int crow(int i, int hh) { return (i & 3) + 8 * (i >> 2) + 4 * hh; }
template <int K> __device__ __forceinline__ float swz_xor(float v) { return __builtin_bit_cast(float, __builtin_amdgcn_ds_swizzle(__builtin_bit_cast(int, v), (K << 10) | 0x1f)); }
__device__ __forceinline__ float sum32(float v) { const unsigned u = __builtin_bit_cast(unsigned, v); auto rr = __builtin_amdgcn_permlane32_swap(u, u, false, false); return __builtin_bit_cast(float, (unsigned)rr[0]) + __builtin_bit_cast(float, (unsigned)rr[1]); }
__device__ __forceinline__ float max32(float v) { const unsigned u = __builtin_bit_cast(unsigned, v); auto rr = __builtin_amdgcn_permlane32_swap(u, u, false, false); return fmaxf(__builtin_bit_cast(float, (unsigned)rr[0]), __builtin_bit_cast(float, (unsigned)rr[1])); }
__device__ __forceinline__ float wave_sum(float v) {
    v += swz_xor<1>(v); v += swz_xor<2>(v); v += swz_xor<4>(v); v += swz_xor<8>(v); v += swz_xor<16>(v);
    return sum32(v);
}
#define MFMA32(a, b, c) __builtin_amdgcn_mfma_f32_32x32x16_bf16((a), (b), (c), 0, 0, 0)
typedef short v4i16_t __attribute__((ext_vector_type(4)));
__device__ __forceinline__ s16x4 vtr(const LAS unsigned char* p) { return __builtin_bit_cast(s16x4, __builtin_amdgcn_ds_read_tr16_b64_v4i16((LAS v4i16_t*)p)); }
__device__ const unsigned char REL_BUCKET[129] = {
    0, 1, 2, 3, 4, 5, 6, 7, 8, 9, 10, 11, 12, 13, 14, 15,
    16, 16, 16, 17, 17, 18, 18, 18, 19, 19, 19, 20, 20, 20, 20, 21,
    21, 21, 21, 22, 22, 22, 22, 22, 23, 23, 23, 23, 23, 23, 24, 24,
    24, 24, 24, 24, 25, 25, 25, 25, 25, 25, 25, 26, 26, 26, 26, 26,
    26, 26, 26, 27, 27, 27, 27, 27, 27, 27, 27, 27, 27, 28, 28, 28,
    28, 28, 28, 28, 28, 28, 28, 29, 29, 29, 29, 29, 29, 29, 29, 29,
    29, 29, 29, 30, 30, 30, 30, 30, 30, 30, 30, 30, 30, 30, 30, 30,
    30, 31, 31, 31, 31, 31, 31, 31, 31, 31, 31, 31, 31, 31, 31, 31,
    31
};

#define XB_TMO      128
#define XB_XCNT(j)  (256  + 64 * (j))
#define XB_XSUB(j)  (1280 + 64 * (j))
#define XB_XGEN(j)  (2304 + 64 * (j))
#define XB_TOP      3328
#define XB_TOPGEN   3392
#define XCD_BAR_WORDS 3456
#define XB_SPIN_CAP (1u << 22)

__device__ __forceinline__ unsigned xb_ld(unsigned* p)              { return __hip_atomic_load(p, __ATOMIC_RELAXED, __HIP_MEMORY_SCOPE_AGENT); }
__device__ __forceinline__ unsigned xb_add(unsigned* p, unsigned v) { return __hip_atomic_fetch_add(p, v, __ATOMIC_RELAXED, __HIP_MEMORY_SCOPE_AGENT); }
__device__ __forceinline__ unsigned xb_xcc_id() { return (unsigned)__builtin_amdgcn_s_getreg((3 << 11) | 20) & 0xFu; }
#define XB_SPIN(cond, bar) do { unsigned _sp = 0; while (cond) { __builtin_amdgcn_s_sleep(1); \
    if ((++_sp & 255u) == 0u) { if (xb_ld(&(bar)[XB_TMO])) break; if (_sp > XB_SPIN_CAP) { atomicAdd(&(bar)[XB_TMO], 1u); break; } } } } while (0)

struct XcdBarrier {
    unsigned* bar; unsigned x;
    volatile LAS unsigned* st;
};

__device__ __forceinline__ bool xb_thread0(int wave) { unsigned z = 0u; asm volatile("" : "+v"(z)); return wave == 0 && __builtin_amdgcn_mbcnt_hi(~0u, __builtin_amdgcn_mbcnt_lo(~0u, z)) == 0u; }
__device__ __forceinline__ XcdBarrier xcd_barrier_post(unsigned* bar, volatile LAS unsigned* st, int wave) {
    XcdBarrier b; b.bar = bar; b.x = xb_xcc_id(); b.st = st;
    if (xb_thread0(wave)) (void)xb_add(&bar[XB_XCNT(b.x)], 1u);
    return b;
}
__device__ __forceinline__ void xcd_barrier_complete(unsigned* bar, unsigned x, unsigned& nloc, unsigned& nx) {
    const unsigned G = gridDim.x * gridDim.y * gridDim.z;
    unsigned sum, cnt, mine, sp = 0u;
    for (;;) {
        sum = 0u; cnt = 0u; mine = 0u;
#pragma unroll
        for (unsigned j = 0; j < 16; ++j) { const unsigned c = xb_ld(&bar[XB_XCNT(j)]); sum += c; cnt += (c > 0u) ? 1u : 0u; mine = (j == x) ? c : mine; }
        if (sum == G) break;
        __builtin_amdgcn_s_sleep(1);
        if ((++sp & 255u) == 0u) { if (xb_ld(&bar[XB_TMO])) break; if (sp > XB_SPIN_CAP) { atomicAdd(&bar[XB_TMO], 1u); break; } }
    }
    nloc = mine > 0u ? mine : 1u; nx = cnt > 0u ? cnt : 1u;
}

__device__ __forceinline__ void xcd_barrier(const XcdBarrier& b, int wave) {
    asm volatile("s_waitcnt vmcnt(0)" ::: "memory");
    __syncthreads();
    if (xb_thread0(wave)) {
        unsigned* bar = b.bar;
        __builtin_amdgcn_s_waitcnt(0);
        unsigned nloc = b.st[0], nx = b.st[1];
        if (nloc == 0u) { xcd_barrier_complete(bar, b.x, nloc, nx); b.st[0] = nloc; b.st[1] = nx; }
        const unsigned old = xb_add(&bar[XB_XSUB(b.x)], 1u);
        const unsigned gen = old / nloc;
        if (old + 1u == (gen + 1u) * nloc) {
            __builtin_amdgcn_fence(__ATOMIC_RELEASE, "agent");
            asm volatile("s_waitcnt vmcnt(0)" ::: "memory");
            const unsigned og = xb_add(&bar[XB_TOP], 1u);
            const unsigned tg = og / nx;
            if (og + 1u == (tg + 1u) * nx) xb_add(&bar[XB_TOPGEN], 1u);
            else XB_SPIN(xb_ld(&bar[XB_TOPGEN]) == tg, bar);
            __builtin_amdgcn_fence(__ATOMIC_ACQUIRE, "agent");
            xb_add(&bar[XB_XGEN(b.x)], 1u);
            asm volatile("s_waitcnt vmcnt(0)" ::: "memory");
        } else {
            XB_SPIN(xb_ld(&bar[XB_XGEN(b.x)]) == gen, bar);
            __builtin_amdgcn_fence(__ATOMIC_ACQUIRE, "agent");
            asm volatile("s_waitcnt vmcnt(0)" ::: "memory");
        }
    }
    __syncthreads();
}

struct Frame {
    LAS unsigned char* lds;
    int tid, lane, wave, vcu, G;
};

__device__ __forceinline__ void tr_item(const float* W, int K, int N, int ncols, bf16* WT, int out_row0, LAS float* scr, int k0, int n0, int lane) {
    const int col = n0 + (lane & 31); const bool ok = col < ncols;
    float tv[32];
    const float* wp = W + (size_t)(k0 + (lane >> 5)) * N + (ok ? col : 0);
#pragma unroll
    for (int i = 0; i < 32; ++i) tv[i] = wp[(size_t)(2 * i) * N];
#pragma unroll
    for (int i = 0; i < 32; ++i) scr[(2 * i + (lane >> 5)) * 33 + (lane & 31)] = ok ? tv[i] : 0.f;
    LDS_WAIT(); asm volatile("" ::: "memory");
    const int c = lane & 7;
#pragma unroll
    for (int j = 0; j < 4; ++j) { const int n = (lane >> 3) + 8 * j; const LAS float* s = scr + (8 * c) * 33 + n;
        v4u o; o.x = pk2(s[0 * 33], s[1 * 33]); o.y = pk2(s[2 * 33], s[3 * 33]); o.z = pk2(s[4 * 33], s[5 * 33]); o.w = pk2(s[6 * 33], s[7 * 33]);
        *(GAS v4u*)(WT + (size_t)(out_row0 + n) * K + k0 + 8 * c) = o; }
    LDS_WAIT(); asm volatile("" ::: "memory");
}
constexpr int I_W1 = 32 * 344, I_W2 = 86 * 64, I_ABI = 32 * 160, I_SQ = 32 * 64, I_DSI = 32 * 136;
constexpr int N_TR_ITEMS = 8 * I_W1 + 8 * I_W2 + 2 * I_ABI + 2 * I_SQ + 2 * I_DSI + 2 * I_SQ;
constexpr int N_GEMV_UNITS = 4 * 72 * 4;
struct Args; __device__ __forceinline__ const float* in_ptr(const Args& a, int i);
__device__ __forceinline__ void prologue_phase(Frame& F, const Args& A, unsigned char* ws) {
    const float* c = in_ptr(A, 1); const float* mod_w = in_ptr(A, 3); float* PART = (float*)(ws + WS_PART);
    for (int unit = F.vcu; unit < N_GEMV_UNITS; unit += F.G) {
        const int l = unit / 288, rem = unit % 288, cb = rem >> 2, kq = rem & 3;
        LAS float* sc = (LAS float*)F.lds + F.wave * 64;
        const int k0 = kq * 512 + F.wave * 64;
        { const float cv = c[k0 + F.lane]; sc[F.lane] = cv * pg8::fast_sigmoid(cv); }
        LDS_WAIT(); asm volatile("" ::: "memory");
        const float* W = mod_w + ((size_t)l * 2048 + k0) * NMODV + cb * 256 + 4 * F.lane;
        f32x4 acc = {0.f, 0.f, 0.f, 0.f};
#pragma unroll 16
        for (int kk = 0; kk < 64; ++kk) acc += sc[kk] * *(const f32x4*)(W + (size_t)kk * NMODV);
        *((LAS f32x4*)(F.lds + 4096) + F.wave * 64 + F.lane) = acc;
        __syncthreads();
        if (F.tid < 256) { float s = 0.f;
#pragma unroll
            for (int w = 0; w < 8; ++w) s += ((LAS float*)(F.lds + 4096))[w * 256 + F.tid];
            PART[(size_t)(kq * 4 + l) * NMODV + cb * 256 + F.tid] = s; }
        __syncthreads();
    }
    LAS float* scr = (LAS float*)(F.lds + 16384 + F.wave * 8704);
    const int gw = F.vcu * NWAVES + F.wave, NGW = F.G * NWAVES;
    for (int it = gw; it < N_TR_ITEMS; it += NGW) {
        int r = it;
        if (r < 8 * I_W1) { const int mi = r / I_W1, q = r % I_W1, kb = q / 344, nb = q % 344, n0 = nb * 32;
            const int orow = (n0 < DFF) ? (n0 / 128) * 256 + (n0 % 128) : ((n0 - DFF) / 128) * 256 + 128 + ((n0 - DFF) % 128);
            tr_item(in_ptr(A, 5) + (size_t)mi * D * 2 * DFF, D, 2 * DFF, 2 * DFF, (bf16*)(ws + WS_W1T) + (size_t)mi * W1T_SZ, orow, scr, kb * 64, n0, F.lane); continue; } r -= 8 * I_W1;
        if (r < 8 * I_W2) { const int mi = r / I_W2, q = r % I_W2, kb = q / 64, nb = q % 64;
            tr_item(in_ptr(A, 6) + (size_t)mi * DFF * D, DFF, D, D, (bf16*)(ws + WS_W2T) + (size_t)mi * W2T_SZ, nb * 32, scr, kb * 64, nb * 32, F.lane); continue; } r -= 8 * I_W2;
        if (r < 2 * I_ABI) { const int mi = r / I_ABI, q = r % I_ABI, kb = q / 160, nb = q % 160;
            tr_item(in_ptr(A, 8) + (size_t)mi * D * ABN, D, ABN, ABN, (bf16*)(ws + WS_ABIN) + (size_t)mi * ABIN_SZ, nb * 32, scr, kb * 64, nb * 32, F.lane); continue; } r -= 2 * I_ABI;
        if (r < 2 * I_SQ) { const int mi = r / I_SQ, q = r % I_SQ, kb = q / 64, nb = q % 64;
            tr_item(in_ptr(A, 9) + (size_t)mi * SQ_SZ, D, D, D, (bf16*)(ws + WS_ABOUT) + (size_t)mi * SQ_SZ, nb * 32, scr, kb * 64, nb * 32, F.lane); continue; } r -= 2 * I_SQ;
        if (r < 2 * I_DSI) { const int mi = r / I_DSI, q = r % I_DSI, kb = q / 136, nb = q % 136;
            tr_item(in_ptr(A, 16) + (size_t)mi * D * CIN, D, CIN, CIN, (bf16*)(ws + WS_DSAIN) + (size_t)mi * DSAIN_SZ, nb * 32, scr, kb * 64, nb * 32, F.lane); continue; } r -= 2 * I_DSI;
        { const int mi = r / I_SQ, q = r % I_SQ, kb = q / 64, nb = q % 64;
            tr_item(in_ptr(A, 17) + (size_t)mi * SQ_SZ, D, D, D, (bf16*)(ws + WS_DSAOUT) + (size_t)mi * SQ_SZ, nb * 32, scr, kb * 64, nb * 32, F.lane); }
    }
}
__device__ __forceinline__ void vec_phase(Frame& F, const Args& A, unsigned char* ws) {
    const float* PART = (const float*)(ws + WS_PART); const float* mod_b = in_ptr(A, 4); const float* norm_g = in_ptr(A, 2);
    float* NA = (float*)(ws + WS_VEC); float* NB = NA + 12 * 2048; float* GT = NB + 12 * 2048;
    for (int idx = F.vcu * 512 + F.tid; idx < 12 * 2048; idx += F.G * 512) {
        const int lj = idx >> 11, col = idx & 2047, l = lj / 3, j = lj % 3;
        float mv[3];
#pragma unroll
        for (int t = 0; t < 3; ++t) { const int n = (3 * j + t) * 2048 + col; float s = mod_b[l * NMODV + n];
#pragma unroll
            for (int kq = 0; kq < 4; ++kq) s += PART[(size_t)(kq * 4 + l) * NMODV + n];
            mv[t] = s; }
        NA[idx] = norm_g[idx] * (1.0f + mv[1]); NB[idx] = mv[0]; GT[idx] = (j == 1 ? 1.0f : 0.5f) * (1.0f + mv[2]);
    }
}
__device__ __forceinline__ void norm_phase(Frame& F, const float* src, const float* na, const float* nb, bf16* dst) {
    const int gw = F.vcu * NWAVES + F.wave, NGW = F.G * NWAVES;
    for (int m = gw; m < S; m += NGW) {
        const GAS f32x4* xr = (const GAS f32x4*)(src + (size_t)m * D) + F.lane;
        f32x4 v[8]; float ss = 0.f;
#pragma unroll
        for (int j = 0; j < 8; ++j) { v[j] = xr[64 * j]; ss += (v[j].x * v[j].x + v[j].y * v[j].y) + (v[j].z * v[j].z + v[j].w * v[j].w); }
        const float rstd = 1.0f / sqrtf(wave_sum(ss) * (1.0f / D) + EPS);
        GAS v2u* o8 = (GAS v2u*)(dst + (size_t)m * D) + F.lane;
#pragma unroll
        for (int j = 0; j < 8; ++j) { const f32x4 a = ((const f32x4*)na)[64 * j + F.lane], b = ((const f32x4*)nb)[64 * j + F.lane]; const f32x4 o = v[j] * rstd * a + b;
            v2u w; w.x = cvtpk(o.x, o.y); w.y = cvtpk(o.z, o.w); o8[64 * j] = w; }
    }
}
__device__ __forceinline__ void final_norm_phase(Frame& F, const float* src, const float* g, float* out) {
    const int gw = F.vcu * NWAVES + F.wave, NGW = F.G * NWAVES;
    for (int m = gw; m < S; m += NGW) {
        const GAS f32x4* xr = (const GAS f32x4*)(src + (size_t)m * D) + F.lane;
        f32x4 v[8]; float ss = 0.f;
#pragma unroll
        for (int j = 0; j < 8; ++j) { v[j] = xr[64 * j]; ss += (v[j].x * v[j].x + v[j].y * v[j].y) + (v[j].z * v[j].z + v[j].w * v[j].w); }
        const float rstd = 1.0f / sqrtf(wave_sum(ss) * (1.0f / D) + EPS);
        GAS f32x4* o = (GAS f32x4*)(out + (size_t)m * D) + F.lane;
#pragma unroll
        for (int j = 0; j < 8; ++j) o[64 * j] = v[j] * rstd * ((const f32x4*)g)[64 * j + F.lane];
    }
}

namespace da {
constexpr int PITCH = ABN, KOFF = 1024, VOFF = 2048;
constexpr float C2 = 0.125f * LOG2E;
constexpr int LDS_LUT = 65536;
constexpr float THR = 8.0f;
__device__ __forceinline__ void dma_tile(LAS unsigned char* lds, const bf16* P, int h, int k0, int buf, int wid, int lane) {
#pragma unroll
    for (int i = 0; i < 2; ++i) {
        const int piece = wid * 2 + i, row = piece * 4 + (lane >> 4), pc = lane & 15;
        const int ck = pc ^ (row & 15), cv = pc ^ (2 * (row & 7));
        const bf16* rp = P + (size_t)(k0 + row) * PITCH + h * 128;
        __builtin_amdgcn_global_load_lds((const unsigned*)(rp + KOFF + ck * 8), (LAS unsigned*)(lds + buf * 32768 + piece * 1024), 16, 0, 0);
        __builtin_amdgcn_global_load_lds((const unsigned*)(rp + VOFF + cv * 8), (LAS unsigned*)(lds + buf * 32768 + 16384 + piece * 1024), 16, 0, 0);
    }
}
__device__ __forceinline__ void unit(int tid, LAS unsigned char* lds, const bf16* P, bf16* CAT, int h, int qb, float lam, float oscale, const float* subg, const float* rel) {
    const int lane = tid & 63, wid = __builtin_amdgcn_readfirstlane(tid >> 6), r = lane & 31, hh = lane >> 5;
    const int rb = wid >> 1, m = wid & 1;
    const int q0w = qb * 128 + rb * 32, qpos = q0w + r;
    LAS float* lut = (LAS float*)(lds + LDS_LUT);
    __syncthreads();
    if (tid < 258) { const int mm = tid / 129, d = tid % 129; const int b = REL_BUCKET[d];
        lut[mm * 132 + d] = (rel[b * 16 + h * 2 + mm] - rel[31 * 16 + h * 2 + mm]) * LOG2E; }
    const int NT = 2 * qb + 2;
    dma_tile(lds, P, h, 0, 0, wid, lane);
    bf16x8 qf[4];
#pragma unroll
    for (int ks = 0; ks < 4; ++ks) qf[ks] = *(const bf16x8*)(P + (size_t)qpos * PITCH + h * 128 + m * 64 + ks * 16 + hh * 8);
    f32x16 O[4];
#pragma unroll
    for (int e = 0; e < 4; ++e)
#pragma unroll
        for (int i = 0; i < 16; ++i) O[e][i] = 0.f;
    float mref = -1e30f, lsum = 0.f;
    const int klane = r * 256, kbits0 = (8 * m + hh) ^ (r & 15);
    const int l16 = lane & 15, qq = l16 >> 2, p4 = l16 & 3, G4 = lane >> 4;
    const int x0 = 4 * hh + qq, lanev20 = (2 * (G4 & 1) + (p4 >> 1)) ^ (2 * x0), vlane = x0 * 256 + (p4 & 1) * 8;
    VM_WAIT(); __syncthreads();
    for (int t = 0; t < NT; ++t) {
        const int buf = t & 1, k0 = t * 64;
        if (t + 1 < NT) dma_tile(lds, P, h, k0 + 64, buf ^ 1, wid, lane);
        int kbits = kbits0, lanev2 = lanev20; asm volatile("" : "+v"(kbits), "+v"(lanev2));
        if (k0 <= q0w + 31) {
            const bool near = (k0 + 191 > q0w);
            const LAS unsigned char* Kb = lds + buf * 32768; const LAS unsigned char* Vb = Kb + 16384;
#pragma unroll
            for (int kb = 0; kb < 2; ++kb) {
                if (k0 + 32 * kb <= q0w + 31) {
                    f32x16 s;
#pragma unroll
                    for (int i = 0; i < 16; ++i) s[i] = 0.f;
#pragma unroll
                    for (int ks = 0; ks < 4; ++ks) { const bf16x8 kf = *(const LAS bf16x8*)(Kb + kb * 8192 + klane + (((2 * ks) ^ kbits) << 4)); s = MFMA32(kf, qf[ks], s); }
                    if (near) {
#pragma unroll
                        for (int i = 0; i < 16; ++i) { const int dist = qpos - (k0 + 32 * kb + crow(i, hh));
                            const float bv = lut[m * 132 + (dist < 0 ? 0 : (dist > 128 ? 128 : dist))];
                            s[i] = dist < 0 ? -INFINITY : s[i] + bv; }
                    }
                    float mx = s[0];
#pragma unroll
                    for (int i = 1; i < 16; ++i) mx = fmaxf(mx, s[i]);
                    mx = max32(mx);
                    if (__any(mx > mref + THR)) {
                        const float mnew = fmaxf(mref, mx), alpha = __builtin_amdgcn_exp2f(mref - mnew);
                        mref = mnew; lsum *= alpha;
#pragma unroll
                        for (int e = 0; e < 4; ++e)
#pragma unroll
                            for (int i = 0; i < 16; ++i) O[e][i] *= alpha;
                    }
                    float ps = 0.f;
#pragma unroll
                    for (int i = 0; i < 16; ++i) { s[i] = __builtin_amdgcn_exp2f(s[i] - mref); ps += s[i]; }
                    lsum += ps;
                    bf16x8 pk[2];
#pragma unroll
                    for (int s2 = 0; s2 < 2; ++s2) { v4u w; w.x = cvtpk(s[8 * s2], s[8 * s2 + 1]); w.y = cvtpk(s[8 * s2 + 2], s[8 * s2 + 3]); w.z = cvtpk(s[8 * s2 + 4], s[8 * s2 + 5]); w.w = cvtpk(s[8 * s2 + 6], s[8 * s2 + 7]);
                        pk[s2] = __builtin_bit_cast(bf16x8, w); }
#pragma unroll
                    for (int s2 = 0; s2 < 2; ++s2)
#pragma unroll
                        for (int e = 0; e < 4; ++e) {
                            const LAS unsigned char* a0 = Vb + (32 * kb + 16 * s2) * 256 + vlane + (((4 * e) ^ lanev2) << 4);
                            const s16x4 lo = vtr(a0), hi = vtr(a0 + 2048);
                            const bf16x8 vf = (bf16x8){lo[0], lo[1], lo[2], lo[3], hi[0], hi[1], hi[2], hi[3]};
                            O[e] = MFMA32(vf, pk[s2], O[e]);
                        }
                }
            }
        }
        VM_WAIT(); __syncthreads();
    }
    lsum = sum32(lsum);
    LAS float* xch = (LAS float*)lds + rb * 4096 + lane;
    if (m == 1) { const float i1 = lam / lsum;
#pragma unroll
        for (int e = 0; e < 4; ++e)
#pragma unroll
            for (int i = 0; i < 16; ++i) xch[(e * 16 + i) * 64] = O[e][i] * i1; }
    __syncthreads();
    if (m == 0) {
        const float i0 = 1.0f / lsum; float ss = 0.f;
#pragma unroll
        for (int e = 0; e < 4; ++e)
#pragma unroll
            for (int i = 0; i < 16; ++i) { const float o = O[e][i] * i0 - xch[(e * 16 + i) * 64]; O[e][i] = o; ss += o * o; }
        ss = sum32(ss);
        const float rs = oscale / sqrtf(ss * (1.0f / 128.0f) + EPS);
        GAS bf16* orow = (GAS bf16*)CAT + (size_t)qpos * D + h * 128;
#pragma unroll
        for (int e = 0; e < 4; ++e)
#pragma unroll
            for (int g4 = 0; g4 < 4; ++g4) { const int ecol = 32 * e + 8 * g4 + 4 * hh; const f32x4 gv = *(const f32x4*)(subg + ecol);
                v2u w; w.x = cvtpk(O[e][4 * g4] * rs * gv.x, O[e][4 * g4 + 1] * rs * gv.y); w.y = cvtpk(O[e][4 * g4 + 2] * rs * gv.z, O[e][4 * g4 + 3] * rs * gv.w);
                *(GAS v2u*)(orow + ecol) = w; }
    }
}
}

namespace sgp {
constexpr int PITCH = ABN, UOFF = 3072, ZOFF = 4096;
constexpr int L_ST = 0, L_W = 1024, L_Z = 1024 + 128 * 272, RS = 272;
__device__ __forceinline__ void unit(int tid, LAS unsigned char* lds, const bf16* P, bf16* CAT, int n, int g, const float* lng, const float* lnb, const float* sgw, const float* sgb) {
    const int lane = tid & 63, wid = __builtin_amdgcn_readfirstlane(tid >> 6), r = lane & 31, hh = lane >> 5;
    const int R0 = n * 128;
    LAS float* st = (LAS float*)(lds + L_ST);
    __syncthreads();
    for (int rr = 0; rr < 16; ++rr) { const int rl = wid * 16 + rr; const bf16* zp = P + (size_t)(R0 + rl) * PITCH + ZOFF + lane * 16;
        const bf16x8 a = *(const bf16x8*)zp, b = *(const bf16x8*)(zp + 8);
        float x[16]; float s = 0.f;
#pragma unroll
        for (int i = 0; i < 8; ++i) { x[i] = bf2f((unsigned short)a[i]); x[8 + i] = bf2f((unsigned short)b[i]); }
#pragma unroll
        for (int i = 0; i < 16; ++i) s += x[i];
        const float mean = wave_sum(s) * (1.0f / 1024.0f); float q = 0.f;
#pragma unroll
        for (int i = 0; i < 16; ++i) { const float d = x[i] - mean; q += d * d; }
        const float rstd = 1.0f / sqrtf(wave_sum(q) * (1.0f / 1024.0f) + EPS);
        if (lane == 0) { st[2 * rl] = mean; st[2 * rl + 1] = rstd; } }
    __syncthreads();
    LAS bf16* ZT = (LAS bf16*)(lds + L_Z); LAS bf16* WT = (LAS bf16*)(lds + L_W);
#pragma unroll
    for (int i = 0; i < 4; ++i) { const int item = tid + 512 * i, sr = item >> 4, ch = item & 15;
        const bf16x8 z = *(const bf16x8*)(P + (size_t)(R0 + sr) * PITCH + ZOFF + g * 128 + ch * 8);
        const float mean = st[2 * sr], rstd = st[2 * sr + 1];
#pragma unroll
        for (int e = 0; e < 8; ++e) { const int c = ch * 8 + e; const float zn = (bf2f((unsigned short)z[e]) - mean) * rstd * lng[g * 128 + c] + lnb[g * 128 + c];
            ZT[c * (RS / 2) + sr] = (bf16)f2bf(zn); } }
#pragma unroll
    for (int i = 0; i < 4; ++i) { const int item = tid + 512 * i, t = item >> 4, sch = item & 15;
        const float* wp = sgw + ((size_t)g * 128 + t) * 128 + sch * 8; const f32x4 a = *(const f32x4*)wp, b = *(const f32x4*)(wp + 4);
        float w[8] = {a.x, a.y, a.z, a.w, b.x, b.y, b.z, b.w};
#pragma unroll
        for (int e = 0; e < 8; ++e) if (sch * 8 + e > t) w[e] = 0.f;
        v4u o; o.x = pk2(w[0], w[1]); o.y = pk2(w[2], w[3]); o.z = pk2(w[4], w[5]); o.w = pk2(w[6], w[7]);
        *(LAS v4u*)(lds + L_W + t * RS + sch * 16) = o; }
    __syncthreads();
    const int tb = wid >> 1, cbp = (wid & 1) * 2;
    f32x16 acc[2];
#pragma unroll
    for (int cc = 0; cc < 2; ++cc)
#pragma unroll
        for (int i = 0; i < 16; ++i) acc[cc][i] = 0.f;
#pragma unroll
    for (int ks = 0; ks < 8; ++ks) {
        if (16 * ks <= 32 * tb + 31) {
            const bf16x8 a = *(const LAS bf16x8*)(lds + L_W + (32 * tb + r) * RS + (16 * ks + 8 * hh) * 2);
#pragma unroll
            for (int cc = 0; cc < 2; ++cc) { const bf16x8 b = *(const LAS bf16x8*)(lds + L_Z + (32 * (cbp + cc) + r) * RS + (16 * ks + 8 * hh) * 2); acc[cc] = MFMA32(a, b, acc[cc]); }
        }
    }
#pragma unroll
    for (int cc = 0; cc < 2; ++cc) { const int c = g * 128 + 32 * (cbp + cc) + r;
#pragma unroll
        for (int i = 0; i < 16; ++i) { const int t = 32 * tb + crow(i, hh); const size_t row = (size_t)(R0 + t);
            const float u = bf2f(P[row * PITCH + UOFF + c]); CAT[row * D + 1024 + c] = (bf16)f2bf(u * (acc[cc][i] + sgb[g * 128 + t])); } }
}
}


namespace dsa {
constexpr int PITCH = CINP, KOFF = 2048, VOFF = 2560, QIOFF = 3072, KIOFF = 4096, WIOFF = 4160;
constexpr float CQ = 0.08838834764831845f * LOG2E;
#define MFMA16(a, b, c) __builtin_amdgcn_mfma_f32_16x16x32_bf16((a), (b), (c), 0, 0, 0)
constexpr int L_HIST = 0, L_KT = 65536, L_SEL = 98304, L_CS = 114688, L_CK = 131072, L_META = 139264, L_TMP = 139776;
constexpr int NCAND = 128;
__device__ __forceinline__ void dma_ktile(LAS unsigned char* lds, const bf16* P, int t, int buf, int wid, int lane) {
#pragma unroll
    for (int i = 0; i < 2; ++i) { const int piece = wid * 2 + i, row = piece * 8 + (lane >> 3), pc = lane & 7, c = pc ^ ((row >> 1) & 7);
        __builtin_amdgcn_global_load_lds((const unsigned*)(P + (size_t)(128 * t + row) * PITCH + KIOFF + c * 8), (LAS unsigned*)(lds + L_KT + buf * 16384 + piece * 1024), 16, 0, 0); }
}
template <int PASS, bool FULL> __device__ __forceinline__ void score_tile(LAS unsigned char* lds, const LAS unsigned char* KT, int kb_, int key0, int u, int wid, int r, int hh, int qmaxw,
                                                                          const bf16x8 (&aq)[2][4], const float (&w)[2][16], int T0, int T1) {
    LAS unsigned* hist = (LAS unsigned*)(lds + L_HIST); LAS unsigned short* sel = (LAS unsigned short*)(lds + L_SEL);
    LAS float* cs = (LAS float*)(lds + L_CS); LAS unsigned short* ck = (LAS unsigned short*)(lds + L_CK); LAS int* meta = (LAS int*)(lds + L_META);
#pragma unroll
    for (int sp = 0; sp < 2; ++sp) {
        if (FULL || key0 + 64 * sp <= qmaxw) {
            bf16x8 bk[2][4];
#pragma unroll
            for (int s2 = 0; s2 < 2; ++s2)
#pragma unroll
                for (int ks = 0; ks < 4; ++ks) bk[s2][ks] = *(const LAS bf16x8*)(KT + (2 * sp + s2) * 4096 + (((2 * ks) ^ kb_) << 4));
            f32x16 acc[2][2];
#pragma unroll
            for (int s2 = 0; s2 < 2; ++s2)
#pragma unroll
                for (int p = 0; p < 2; ++p)
#pragma unroll
                    for (int i = 0; i < 16; ++i) acc[s2][p][i] = 0.f;
#pragma unroll
            for (int ks = 0; ks < 4; ++ks)
#pragma unroll
                for (int s2 = 0; s2 < 2; ++s2)
#pragma unroll
                    for (int p = 0; p < 2; ++p) acc[s2][p] = MFMA32(aq[p][ks], bk[s2][ks], acc[s2][p]);
#pragma unroll
            for (int s2 = 0; s2 < 2; ++s2)
#pragma unroll
                for (int p = 0; p < 2; ++p) {
                    float sc = 0.f;
#pragma unroll
                    for (int i = 0; i < 16; ++i) sc += fmaxf(acc[s2][p][i], 0.f) * w[p][i];
                    const int rl = 4 * wid + 2 * p + hh, key = key0 + 32 * (2 * sp + s2) + r;
                    int b = (int)((sc + 32.0f) * 8.0f); b = b < 0 ? 0 : (b > 511 ? 511 : b);
                    if (FULL || key <= 32 * u + rl) {
                        if (PASS == 1) (void)__hip_atomic_fetch_add(&hist[rl * 512 + b], 1u, __ATOMIC_RELAXED, __HIP_MEMORY_SCOPE_WORKGROUP);
                        else { const int T = p ? T1 : T0;
                            if (b > T) { const int pos = __hip_atomic_fetch_add(&meta[rl], 1, __ATOMIC_RELAXED, __HIP_MEMORY_SCOPE_WORKGROUP); if (pos < 256) sel[rl * 256 + pos] = (unsigned short)key; }
                            else if (b == T) { const int pos = __hip_atomic_fetch_add(&meta[32 + rl], 1, __ATOMIC_RELAXED, __HIP_MEMORY_SCOPE_WORKGROUP); if (pos < NCAND) { cs[rl * NCAND + pos] = sc; ck[rl * NCAND + pos] = (unsigned short)key; } } }
                    }
                }
        }
    }
}
template <int PASS> __device__ __forceinline__ void score_pass(LAS unsigned char* lds, const bf16* P, int u, int wid, int lane, const bf16x8 (&aq)[2][4], const float (&w)[2][16], int T0, int T1) {
    const int r = lane & 31, hh = lane >> 5;
    const int NT = (32 * u + 32 + 127) >> 7, qmaxw = 32 * u + 4 * wid + 3;
    const int kb0 = hh ^ ((r >> 1) & 7);
    dma_ktile(lds, P, 0, 0, wid, lane);
    VM_WAIT(); __syncthreads();
    for (int t = 0; t < NT; ++t) {
        const int buf = t & 1;
        if (t + 1 < NT) dma_ktile(lds, P, t + 1, buf ^ 1, wid, lane);
        int kb_ = kb0; asm volatile("" : "+v"(kb_));
        const LAS unsigned char* KT = lds + L_KT + buf * 16384 + r * 128;
        if (128 * t + 127 <= 32 * u) score_tile<PASS, true>(lds, KT, kb_, 128 * t, u, wid, r, hh, qmaxw, aq, w, T0, T1);
        else score_tile<PASS, false>(lds, KT, kb_, 128 * t, u, wid, r, hh, qmaxw, aq, w, T0, T1);
        VM_WAIT(); __syncthreads();
    }
}
__device__ __forceinline__ void index_phase(Frame& F, const bf16* P, unsigned short* SEL) {
    LAS unsigned char* lds = F.lds; const int tid = F.tid, lane = F.lane, wid = F.wave, r = lane & 31, hh = lane >> 5;
    LAS unsigned* hist = (LAS unsigned*)(lds + L_HIST); LAS unsigned short* sel = (LAS unsigned short*)(lds + L_SEL);
    LAS float* cs = (LAS float*)(lds + L_CS); LAS unsigned short* ck = (LAS unsigned short*)(lds + L_CK); LAS int* meta = (LAS int*)(lds + L_META);
    for (int ui = F.vcu; ui < 512; ui += F.G) {
        const int u = (ui < 256) ? ui : 767 - ui;
        __syncthreads();
        if (u < 8) {
            for (int e = tid; e < 32 * 256; e += 512) { const int q = 32 * u + (e >> 8), jj = e & 255; SEL[(size_t)q * 256 + jj] = (unsigned short)(jj <= q ? jj : 0); }
            continue;
        }
        { v4u z = {0u, 0u, 0u, 0u};
#pragma unroll
            for (int i = 0; i < 8; ++i) *(LAS v4u*)(lds + L_HIST + (tid + 512 * i) * 16) = z;
#pragma unroll
            for (int i = 0; i < 2; ++i) *(LAS v4u*)(lds + L_SEL + (tid + 512 * i) * 16) = z;
            if (tid < 128) meta[tid] = 0; }
        bf16x8 aq[2][4]; float w[2][16];
#pragma unroll
        for (int p = 0; p < 2; ++p) { const int qrow = 32 * u + 4 * wid + 2 * p + ((r >> 2) & 1), head = (r & 3) + 4 * (r >> 3);
#pragma unroll
            for (int ks = 0; ks < 4; ++ks) aq[p][ks] = *(const bf16x8*)(P + (size_t)qrow * PITCH + QIOFF + head * 64 + ks * 16 + hh * 8);
            const bf16* wp = P + (size_t)(32 * u + 4 * wid + 2 * p + hh) * PITCH + WIOFF;
            const bf16x8 w0 = *(const bf16x8*)wp, w1 = *(const bf16x8*)(wp + 8);
#pragma unroll
            for (int i = 0; i < 8; ++i) { w[p][i] = bf2f((unsigned short)w0[i]) * 0.125f; w[p][8 + i] = bf2f((unsigned short)w1[i]) * 0.125f; } }
        __syncthreads();
        score_pass<1>(lds, P, u, wid, lane, aq, w, 0, 0);
        LAS int* tmp = (LAS int*)(lds + L_TMP) + wid * 64;
        for (int rr = 0; rr < 4; ++rr) { const int rl = 4 * wid + rr;
            unsigned cw[8]; { const v4u a = *(const LAS v4u*)(hist + rl * 512 + 8 * lane), b = *(const LAS v4u*)(hist + rl * 512 + 8 * lane + 4);
                cw[0] = a.x; cw[1] = a.y; cw[2] = a.z; cw[3] = a.w; cw[4] = b.x; cw[5] = b.y; cw[6] = b.z; cw[7] = b.w; }
            int ls = 0;
#pragma unroll
            for (int i = 0; i < 8; ++i) ls += (int)cw[i];
            int suf = ls;
#pragma unroll
            for (int off = 1; off < 64; off <<= 1) { tmp[lane] = suf; LDS_WAIT(); const int o2 = lane + off; const int v = tmp[o2 < 64 ? o2 : 63]; LDS_WAIT(); suf += (o2 < 64) ? v : 0; }
            const unsigned long long bal = __ballot(suf >= 256);
            const int L = 63 - __builtin_clzll(bal | 1ull);
            if (lane == L) { int cum = suf - ls, T = 8 * L, cab = cum; bool found = false;
#pragma unroll
                for (int bb = 7; bb >= 0; --bb) { const int cnt = (int)cw[bb];
                    if (!found) { if (cum + cnt >= 256) { T = 8 * L + bb; cab = cum; found = true; } else cum += cnt; } }
                meta[64 + rl] = T; meta[96 + rl] = cab; }
            LDS_WAIT(); asm volatile("" ::: "memory"); }
        __syncthreads();
        const int T0 = meta[64 + 4 * wid + hh], T1 = meta[64 + 4 * wid + 2 + hh];
        score_pass<2>(lds, P, u, wid, lane, aq, w, T0, T1);
        for (int rr = 0; rr < 4; ++rr) { const int rl = 4 * wid + rr; const int cab = meta[96 + rl], need = 256 - cab; int m = meta[32 + rl]; m = m > NCAND ? NCAND : m;
#pragma unroll
            for (int half = 0; half < 2; ++half) { const int i = lane + 64 * half; const float si = cs[rl * NCAND + i]; const int ki = ck[rl * NCAND + i]; int rank = 0;
                for (int j2 = 0; j2 < m; ++j2) { const float sj = cs[rl * NCAND + j2]; const int kj = ck[rl * NCAND + j2]; rank += (sj > si || (sj == si && kj < ki)) ? 1 : 0; }
                if (i < m && rank < need) sel[rl * 256 + cab + rank] = (unsigned short)ki; }
            LDS_WAIT(); asm volatile("" ::: "memory");
            const v2u o = *(const LAS v2u*)(lds + L_SEL + rl * 512 + lane * 8);
            *(GAS v2u*)(SEL + (size_t)(32 * u + rl) * 256 + 4 * lane) = o; }
    }
}
constexpr int A_LUT = 0, A_SEL = 8448, A_V = 16384;
__device__ __forceinline__ void attn_phase(Frame& F, const bf16* P, const unsigned short* SEL, bf16* CAT, const float* rel) {
    LAS unsigned char* lds = F.lds; const int tid = F.tid, lane = F.lane, wid = F.wave;
    LAS float* lut = (LAS float*)(lds + A_LUT);
    __syncthreads();
    for (int e = tid; e < 129 * 16; e += 512) lut[e] = rel[REL_BUCKET[e >> 4] * 16 + (e & 15)] * LOG2E;
    __syncthreads();
    LAS unsigned short* sb = (LAS unsigned short*)(lds + A_SEL) + wid * 256; LAS unsigned char* vbuf = lds + A_V + wid * 8192;
    const int c16 = lane & 15, q4 = lane >> 4, qq = c16 >> 2, p4 = c16 & 3;
    const int rho = 4 * q4 + qq, vx0 = rho & 7, vbase = rho * 256 + (p4 & 1) * 8;
    const int gw = F.vcu * NWAVES + wid, NGW = F.G * NWAVES;
    for (int q = gw; q < S; q += NGW) {
        const int count = (q + 1 < 256) ? q + 1 : 256;
        *(LAS v2u*)(sb + 4 * lane) = *(const GAS v2u*)(SEL + (size_t)q * 256 + 4 * lane);
        LDS_WAIT(); asm volatile("" ::: "memory");
        for (int g = 0; g < 4; ++g) {
            const int head = 4 * g + (c16 & 3);
            bf16x8 qb[4];
#pragma unroll
            for (int ks = 0; ks < 4; ++ks) qb[ks] = *(const bf16x8*)(P + (size_t)q * PITCH + head * 128 + q4 * 32 + ks * 8);
            f32x4 s[16];
#pragma unroll
            for (int bt = 0; bt < 4; ++bt) {
                bf16x8 ak[4][4];
#pragma unroll
                for (int b2 = 0; b2 < 4; ++b2) { const int kpos = sb[16 * (4 * bt + b2) + c16]; const bf16* kp = P + (size_t)kpos * PITCH + KOFF + g * 128 + q4 * 32;
#pragma unroll
                    for (int ks = 0; ks < 4; ++ks) ak[b2][ks] = *(const bf16x8*)(kp + ks * 8); }
#pragma unroll
                for (int b2 = 0; b2 < 4; ++b2) { f32x4 a = {0.f, 0.f, 0.f, 0.f};
#pragma unroll
                    for (int ks = 0; ks < 4; ++ks) a = MFMA16(ak[b2][ks], qb[ks], a);
                    s[4 * bt + b2] = a; }
            }
            float mx = -INFINITY;
#pragma unroll
            for (int b = 0; b < 16; ++b) { const v2u kk2 = *(const LAS v2u*)(sb + 16 * b + 4 * q4);
#pragma unroll
                for (int i = 0; i < 4; ++i) { const int jj = 16 * b + 4 * q4 + i; const int kpos = (int)(((i & 2) ? kk2.y : kk2.x) >> ((i & 1) * 16)) & 0xffff;
                    int dist = q - kpos; dist = dist < 0 ? 0 : (dist > 128 ? 128 : dist);
                    (void)jj; s[b][i] += lut[dist * 16 + head]; } }
            if (count < 256) {
                int cnt = count - 4 * q4; asm volatile("" : "+v"(cnt));
#pragma unroll
                for (int b = 0; b < 16; ++b)
#pragma unroll
                    for (int i = 0; i < 4; ++i) if (16 * b + i >= cnt) s[b][i] = -INFINITY; }
#pragma unroll
            for (int b = 0; b < 16; ++b)
#pragma unroll
                for (int i = 0; i < 4; ++i) mx = fmaxf(mx, s[b][i]);
            mx = fmaxf(mx, swz_xor<16>(mx)); mx = max32(mx);
            float sum = 0.f;
#pragma unroll
            for (int b = 0; b < 16; ++b)
#pragma unroll
                for (int i = 0; i < 4; ++i) { const float pv = __builtin_amdgcn_exp2f(s[b][i] - mx); s[b][i] = pv; sum += pv; }
            sum += swz_xor<16>(sum); sum = sum32(sum);
            bf16x8 pb[8];
#pragma unroll
            for (int kk = 0; kk < 8; ++kk) { v4u wv; wv.x = cvtpk(s[2 * kk][0], s[2 * kk][1]); wv.y = cvtpk(s[2 * kk][2], s[2 * kk][3]); wv.z = cvtpk(s[2 * kk + 1][0], s[2 * kk + 1][1]); wv.w = cvtpk(s[2 * kk + 1][2], s[2 * kk + 1][3]);
                pb[kk] = __builtin_bit_cast(bf16x8, wv); }
            f32x4 O[8];
#pragma unroll
            for (int db = 0; db < 8; ++db) O[db] = (f32x4){0.f, 0.f, 0.f, 0.f};
#pragma unroll
            for (int kk = 0; kk < 8; ++kk) {
                LDS_WAIT();
#pragma unroll
                for (int pi = 0; pi < 8; ++pi) { const int row = 4 * pi + (lane >> 4), pc = lane & 15, c = pc ^ (2 * (row & 7)); const int kpos = sb[32 * kk + row];
                    __builtin_amdgcn_global_load_lds((const unsigned*)(P + (size_t)kpos * PITCH + VOFF + g * 128 + c * 8), (LAS unsigned*)(vbuf + pi * 1024), 16, 0, 0); }
                VM_WAIT();
                int vx = vx0; asm volatile("" : "+v"(vx));
#pragma unroll
                for (int db = 0; db < 8; ++db) { const LAS unsigned char* a0 = vbuf + vbase + (((((db ^ vx) << 1) | (p4 >> 1))) << 4);
                    const s16x4 lo = vtr(a0), hi = vtr(a0 + 4096);
                    const bf16x8 vf = (bf16x8){lo[0], lo[1], lo[2], lo[3], hi[0], hi[1], hi[2], hi[3]};
                    O[db] = MFMA16(vf, pb[kk], O[db]); }
            }
            if (c16 < 4) { const float inv = 1.0f / sum; GAS bf16* op = (GAS bf16*)CAT + (size_t)q * D + head * 128 + 4 * q4;
#pragma unroll
                for (int db = 0; db < 8; ++db) { v2u wv; wv.x = cvtpk(O[db][0] * inv, O[db][1] * inv); wv.y = cvtpk(O[db][2] * inv, O[db][3] * inv); *(GAS v2u*)(op + 16 * db) = wv; } }
        }
    }
}
}


struct Args;
__device__ __forceinline__ const float* in_ptr(const Args& a, int i);
struct Args { const float* in[19]; float* out; unsigned char* ws; int ph_lo, ph_hi; };
__device__ __forceinline__ const float* in_ptr(const Args& a, int i) { (void)a; extern __shared__ __attribute__((aligned(16))) unsigned char lds_all[];
    const unsigned long long v = ((const LAS unsigned long long*)((LAS unsigned char*)lds_all + INP_OFF))[i];
    const unsigned lo = __builtin_amdgcn_readfirstlane((unsigned)v), hi = __builtin_amdgcn_readfirstlane((unsigned)(v >> 32));
    return (const float*)(((unsigned long long)hi << 32) | lo); }
constexpr int N_PHASES = 45 + ((MK_DUP & 4) ? 2 : 0) + ((MK_DUP & 8) ? 2 : 0) + ((MK_DUP & 64) ? 8 : 0) + ((MK_DUP & 16) ? 1 : 0) + ((MK_DUP & 1) ? 2 : 0) + ((MK_DUP & 32) ? 8 : 0);
typedef pg8::StaticOrder SOrd;
#define GEMM_PHASE(EPI, g, E) do { int bx_ = (int)blockIdx.x, G_ = F.G; asm volatile("" : "+s"(bx_), "+s"(G_));   \
    SOrd S_; S_.init((g).M, (g).N, G_, bx_); pg8::gemm_phase<EPI, SOrd, true, true>(F.lds, (g), S_, (E)); } while (0)

__global__ void __launch_bounds__(NWAVES * 64, 2) fwd_kernel(Args args) {
    extern __shared__ __attribute__((aligned(16))) unsigned char lds[];
    Frame F;
    F.lds = (LAS unsigned char*)lds;
    F.tid = threadIdx.x; F.lane = F.tid & 63; F.wave = __builtin_amdgcn_readfirstlane(F.tid >> 6);
    F.G = gridDim.x; { const int bx = blockIdx.x; F.vcu = (F.G % 8 == 0) ? (bx % 8) * (F.G / 8) + bx / 8 : bx; }
    volatile LAS unsigned* MISC = (volatile LAS unsigned*)(F.lds + MISC_OFF);
    if (F.tid < 64) MISC[F.tid] = 0u;
    if (F.tid == 0) { LAS unsigned long long* ip = (LAS unsigned long long*)(F.lds + INP_OFF);
#pragma unroll
        for (int i = 0; i < 19; ++i) ip[i] = (unsigned long long)args.in[i]; }
    __syncthreads();
    const int lo = args.ph_lo, hi = args.ph_hi;
    XcdBarrier bar; bar.bar = (unsigned*)(args.ws + WS_CTL) + CW_BAR; bar.x = 0; bar.st = nullptr;
    if (hi - lo > 1) bar = xcd_barrier_post((unsigned*)(args.ws + WS_CTL) + CW_BAR, MISC + 8, F.wave);
    int ph = 0;
#define RUN() (lo <= ph && ph < hi)
#define SEAM() do { if (lo <= ph && ph + 1 < hi) { XcdBarrier b_ = bar; asm volatile("" : "+s"(b_.bar), "+s"(b_.x));   xcd_barrier(b_, F.wave); } ++ph; } while (0)

#define WSP() unsigned char* ws = args.ws; asm volatile("" : "+s"(ws)); \
    { int t_ = threadIdx.x; asm volatile("" : "+v"(t_)); F.tid = t_; F.lane = t_ & 63; }     \
    float* XRES = (float*)(ws + WS_XRES); bf16* XN = (bf16*)(ws + WS_XN); bf16* H = (bf16*)(ws + WS_H); bf16* PROJ = (bf16*)(ws + WS_PROJ); bf16* CAT = (bf16*)(ws + WS_CAT); \
    const float* NA = (const float*)(ws + WS_VEC); const float* NB = NA + 12 * 2048; const float* GT = NB + 12 * 2048; \
    (void)XRES; (void)XN; (void)H; (void)PROJ; (void)CAT; (void)NA; (void)NB; (void)GT;
#define INP(i) in_ptr(args, (i))

    if (RUN()) { WSP(); prologue_phase(F, args, ws); }
#if MK_DUP & 16
    SEAM(); if (RUN()) { WSP(); prologue_phase(F, args, ws); }
#endif
    SEAM();
    if (RUN()) { WSP(); vec_phase(F, args, ws); }
    SEAM();

    for (int s = 0; s < 8; ++s) {
        asm volatile("" : "+s"(F.wave), "+s"(F.vcu), "+s"(F.G));
        const int l = s >> 1, f = s & 1, jn = f ? 2 : 0;
        if (RUN()) { WSP(); const float* xsrc = (s == 0) ? INP(0) : XRES; norm_phase(F, xsrc, NA + (l * 3 + jn) * 2048, NB + (l * 3 + jn) * 2048, XN); }
        SEAM();
#if MK_DUP & 32
        if (RUN()) { WSP(); const float* xsrc = (s == 0) ? INP(0) : XRES; norm_phase(F, xsrc, NA + (l * 3 + jn) * 2048, NB + (l * 3 + jn) * 2048, XN); }
        SEAM();
#endif
        if (RUN()) { WSP(); pg8::Gemm g{XN, (const bf16*)(ws + WS_W1T) + (size_t)s * W1T_SZ, S, 2 * DFF, D}; pg8::EpiSwiglu E{H, DFF}; GEMM_PHASE(pg8::EpiSwiglu, g, E); }
        SEAM();
#if MK_DUP & 64
        if (RUN()) { WSP(); pg8::Gemm g{XN, (const bf16*)(ws + WS_W1T) + (size_t)s * W1T_SZ, S, 2 * DFF, D}; pg8::EpiSwiglu E{H, DFF}; GEMM_PHASE(pg8::EpiSwiglu, g, E); }
        SEAM();
#endif
        if (RUN()) { WSP(); const float* xsrc = (s == 0) ? INP(0) : XRES; pg8::Gemm g{H, (const bf16*)(ws + WS_W2T) + (size_t)s * W2T_SZ, S, D, DFF}; pg8::EpiResid E{xsrc, XRES, GT + (l * 3 + jn) * 2048, D}; GEMM_PHASE(pg8::EpiResid, g, E); }
        SEAM();
        if (f == 0) {
            if (RUN()) { WSP(); norm_phase(F, XRES, NA + (l * 3 + 1) * 2048, NB + (l * 3 + 1) * 2048, XN); }
            SEAM();
            const int j = l >> 1;
            if ((l & 1) == 0) {
                if (RUN()) { WSP(); pg8::Gemm g{XN, (const bf16*)(ws + WS_ABIN) + (size_t)j * ABIN_SZ, S, ABN, D}; pg8::EpiProj E{PROJ, ABN, 4, da::C2, 12}; GEMM_PHASE(pg8::EpiProj, g, E); }
                SEAM();
                if (RUN()) {
#if MK_AB
                    WSP();
                    const float* lp = INP(10) + j * 256;
                    const float s01 = wave_sum(lp[F.lane] * lp[64 + F.lane]), s23 = wave_sum(lp[128 + F.lane] * lp[192 + F.lane]);
                    const float lam_init = (j == 0) ? 0.2f : 0.4707130183435842f;
                    const float lam = expf(s01) - expf(s23) + lam_init;
                    for (int ui = F.vcu; ui < 1024; ui += F.G) { const int v = ui & 255, k = ui >> 8, h = v >> 5, p = v & 31;
                        const int qb = (k == 0) ? p : (k == 1) ? 127 - p : (k == 2) ? 63 - p : 64 + p;
                        da::unit(F.tid, F.lds, PROJ, CAT, h, qb, lam, 1.0f - lam_init, INP(11) + j * 128, INP(7)); }
                    for (int ui = F.vcu; ui < 1024; ui += F.G)
                        sgp::unit(F.tid, F.lds, PROJ, CAT, ui >> 3, ui & 7, INP(12) + j * 1024, INP(13) + j * 1024, INP(14) + (size_t)j * 8 * 128 * 128, INP(15) + j * 8 * 128);
#endif
                }
                SEAM();
#if MK_DUP & 1
                if (RUN()) {
#if MK_AB
                    WSP();
                    const float* lp = INP(10) + j * 256;
                    const float s01 = wave_sum(lp[F.lane] * lp[64 + F.lane]), s23 = wave_sum(lp[128 + F.lane] * lp[192 + F.lane]);
                    const float lam_init = (j == 0) ? 0.2f : 0.4707130183435842f;
                    const float lam = expf(s01) - expf(s23) + lam_init;
                    for (int ui = F.vcu; ui < 1024; ui += F.G) { const int v = ui & 255, k = ui >> 8, h = v >> 5, p = v & 31;
                        const int qb = (k == 0) ? p : (k == 1) ? 127 - p : (k == 2) ? 63 - p : 64 + p;
                        da::unit(F.tid, F.lds, PROJ, CAT, h, qb, lam, 1.0f - lam_init, INP(11) + j * 128, INP(7)); }
                    for (int ui = F.vcu; ui < 1024; ui += F.G)
                        sgp::unit(F.tid, F.lds, PROJ, CAT, ui >> 3, ui & 7, INP(12) + j * 1024, INP(13) + j * 1024, INP(14) + (size_t)j * 8 * 128 * 128, INP(15) + j * 8 * 128);
#endif
                }
                SEAM();
#endif
                if (RUN()) {
#if MK_AB
                    WSP(); pg8::Gemm g{CAT, (const bf16*)(ws + WS_ABOUT) + (size_t)j * SQ_SZ, S, D, D}; pg8::EpiResid E{XRES, XRES, GT + (l * 3 + 1) * 2048, D}; GEMM_PHASE(pg8::EpiResid, g, E);
#endif
                }
                SEAM();
            } else {
                if (RUN()) {
#if MK_DSA
                    WSP(); pg8::Gemm g{XN, (const bf16*)(ws + WS_DSAIN) + (size_t)j * DSAIN_SZ, S, CINP, D}; pg8::EpiProj E{PROJ, CINP, 8, dsa::CQ, 1000}; GEMM_PHASE(pg8::EpiProj, g, E);
#endif
                }
                SEAM();
                if (RUN()) {
#if MK_DSA
                    WSP(); dsa::index_phase(F, PROJ, (unsigned short*)(ws + WS_SEL));
#endif
                }
                SEAM();
#if MK_DUP & 4
                if (RUN()) { WSP(); dsa::index_phase(F, PROJ, (unsigned short*)(ws + WS_SEL)); }
                SEAM();
#endif
                if (RUN()) {
#if MK_DSA
                    WSP(); dsa::attn_phase(F, PROJ, (const unsigned short*)(ws + WS_SEL), CAT, INP(7));
#endif
                }
                SEAM();
#if MK_DUP & 8
                if (RUN()) { WSP(); dsa::attn_phase(F, PROJ, (const unsigned short*)(ws + WS_SEL), CAT, INP(7)); }
                SEAM();
#endif
                if (RUN()) {
#if MK_DSA
                    WSP(); pg8::Gemm g{CAT, (const bf16*)(ws + WS_DSAOUT) + (size_t)j * SQ_SZ, S, D, D}; pg8::EpiResid E{XRES, XRES, GT + (l * 3 + 1) * 2048, D}; GEMM_PHASE(pg8::EpiResid, g, E);
#endif
                }
                SEAM();
            }
        }
    }
    if (RUN()) { WSP(); final_norm_phase(F, XRES, INP(18), args.out); }
    ++ph;
#undef RUN
#undef SEAM
}


#if MK_DIAG
__device__ const int DG_ROWS[16] = {0, 129, 255, 256, 1000, 2500, 4097, 6000, 8191, 8192, 9500, 10000, 11111, 12287, 12345, 16383};
__device__ __forceinline__ void dg_max(unsigned* slot, float e) { if (!(e >= 0.f)) e = 1e9f; atomicMax(slot, __builtin_bit_cast(unsigned, e)); }
constexpr int DG_SLOT = 2048;
__global__ void __launch_bounds__(512) diag_check(Args args, int which, int j) {
    extern __shared__ __attribute__((aligned(16))) unsigned char lds[];
    unsigned char* ws = args.ws; unsigned* slot = (unsigned*)(ws + WS_CTL) + DG_SLOT;
    const float* NA = (const float*)(ws + WS_VEC); const float* NB = NA + 12 * 2048; const float* GT = NB + 12 * 2048;
    const bf16* XN = (const bf16*)(ws + WS_XN); const bf16* H = (const bf16*)(ws + WS_H); const float* XRES = (const float*)(ws + WS_XRES);
    const bf16* PROJ = (const bf16*)(ws + WS_PROJ); const bf16* CAT = (const bf16*)(ws + WS_CAT);
    const int tid = threadIdx.x; float* fl = (float*)lds;
    const int row = DG_ROWS[blockIdx.x & 15]; const int sub = blockIdx.x >> 4;
    float err = 0.f;
    if (which == 1) {
        const float* x = args.in[0] + (size_t)row * D; float ss = 0.f;
        for (int c = 0; c < D; ++c) ss += x[c] * x[c];
        const float rstd = 1.0f / sqrtf(ss / D + EPS);
        for (int c = tid; c < D; c += 512) err = fmaxf(err, fabsf(x[c] * rstd * NA[c] + NB[c] - bf2f(XN[(size_t)row * D + c])));
    } else if (which == 2) {
        const float* w1 = args.in[5] + (size_t)j * D * 2 * DFF;
        for (int c = tid; c < DFF; c += 512) { float g = 0.f, u = 0.f;
            for (int k = 0; k < D; ++k) { const float a = bf2f(XN[(size_t)row * D + k]); g += a * w1[(size_t)k * 2 * DFF + c]; u += a * w1[(size_t)k * 2 * DFF + DFF + c]; }
            const float ref = g / (1.0f + expf(-g)) * u; err = fmaxf(err, fabsf(ref - bf2f(H[(size_t)row * DFF + c]))); }
    } else if (which == 3) {
        const float* w2 = args.in[6] + (size_t)j * DFF * D; const float* x = (j == 0) ? args.in[0] : (const float*)(ws + WS_END);
        const float* gt = GT + ((j >> 1) * 3 + ((j & 1) ? 2 : 0)) * 2048;
        for (int c = tid; c < D; c += 512) { float a = 0.f;
            for (int k = 0; k < DFF; ++k) a += bf2f(H[(size_t)row * DFF + k]) * w2[(size_t)k * D + c];
            err = fmaxf(err, fabsf(x[(size_t)row * D + c] + gt[c] * a - XRES[(size_t)row * D + c])); }
    } else if (which == 4) {
        const float* w = args.in[8] + (size_t)j * D * ABN;
        for (int c = tid; c < ABN; c += 512) { float a = 0.f;
            for (int k = 0; k < D; ++k) a += bf2f(XN[(size_t)row * D + k]) * w[(size_t)k * ABN + c];
            if (c < 1024) a *= da::C2; if (c >= 3072) a = 0.5f * a * (1.0f + tanhf(0.7978845608028654f * (a + 0.044715f * a * a * a)));
            err = fmaxf(err, fabsf(a - bf2f(PROJ[(size_t)row * ABN + c]))); }
    } else if (which == 5) {
        const int h = sub;
        const float* lp = args.in[10] + j * 256; float s01 = 0.f, s23 = 0.f;
        for (int i = 0; i < 64; ++i) { s01 += lp[i] * lp[64 + i]; s23 += lp[128 + i] * lp[192 + i]; }
        const float lam_init = 0.8f - 0.6f * expf(-0.3f * (2 * j)), lam = expf(s01) - expf(s23) + lam_init;
        float* lg = fl;
        float* red = fl + 2 * 16384;
        for (int m = 0; m < 2; ++m) {
            for (int key = tid; key <= row; key += 512) { float a = 0.f;
                for (int d = 0; d < 64; ++d) a += bf2f(PROJ[(size_t)row * ABN + h * 128 + m * 64 + d]) * bf2f(PROJ[(size_t)key * ABN + 1024 + h * 128 + m * 64 + d]);
                const int dist = row - key; a += args.in[7][REL_BUCKET[dist > 128 ? 128 : dist] * 16 + h * 2 + m] * LOG2E; lg[m * 16384 + key] = a; }
        }
        __syncthreads();
        float mx[2], sm[2];
        for (int m = 0; m < 2; ++m) { float v = -INFINITY; for (int key = tid; key <= row; key += 512) v = fmaxf(v, lg[m * 16384 + key]);
            red[tid] = v; __syncthreads(); if (tid == 0) { float t = -INFINITY; for (int i = 0; i < 512; ++i) t = fmaxf(t, red[i]); red[512] = t; } __syncthreads(); mx[m] = red[512]; __syncthreads();
            float s = 0.f; for (int key = tid; key <= row; key += 512) s += exp2f(lg[m * 16384 + key] - mx[m]);
            red[tid] = s; __syncthreads(); if (tid == 0) { float t = 0.f; for (int i = 0; i < 512; ++i) t += red[i]; red[512] = t; } __syncthreads(); sm[m] = red[512]; __syncthreads(); }
        const int e = tid & 127, part = tid >> 7; float o = 0.f;
        for (int key = part; key <= row; key += 4) { const float p = exp2f(lg[key] - mx[0]) / sm[0] - lam * exp2f(lg[16384 + key] - mx[1]) / sm[1]; o += p * bf2f(PROJ[(size_t)key * ABN + 2048 + h * 128 + e]); }
        red[tid] = o; __syncthreads();
        if (tid < 128) { o = red[tid] + red[128 + tid] + red[256 + tid] + red[384 + tid]; red[512 + tid] = o * o; red[tid] = o; } __syncthreads();
        if (tid == 0) { float t = 0.f; for (int i = 0; i < 128; ++i) t += red[512 + i]; red[700] = t; } __syncthreads();
        if (tid < 128) { const float ref = red[tid] / sqrtf(red[700] / 128.0f + EPS) * args.in[11][j * 128 + tid] * (1.0f - lam_init);
            err = fabsf(ref - bf2f(CAT[(size_t)row * D + h * 128 + tid])); }
    } else if (which == 7) {
        const float* w2 = args.in[6]; const float* x = args.in[0]; const float* wo = args.in[9] + (size_t)j * D * D;
        for (int c = tid; c < D; c += 512) { float a = 0.f, b = 0.f;
            for (int k = 0; k < DFF; ++k) a += bf2f(H[(size_t)row * DFF + k]) * w2[(size_t)k * D + c];
            for (int k = 0; k < D; ++k) b += bf2f(CAT[(size_t)row * D + k]) * wo[(size_t)k * D + c];
            err = fmaxf(err, fabsf(x[(size_t)row * D + c] + GT[c] * a + GT[2048 + c] * b - XRES[(size_t)row * D + c])); }
    } else if (which == 8) {
        const int lj = sub, l = lj / 3, jj = lj % 3;
        if (tid < 8) { const int col = (DG_ROWS[blockIdx.x & 15] + 257 * tid) & 2047; float mv[3];
            for (int t = 0; t < 3; ++t) { const int n = (3 * jj + t) * 2048 + col; float a = args.in[4][l * NMODV + n];
                for (int k = 0; k < 2048; ++k) { const float cv = args.in[1][k]; a += cv / (1.0f + expf(-cv)) * args.in[3][((size_t)l * 2048 + k) * NMODV + n]; } mv[t] = a; }
            err = fmaxf(fabsf(args.in[2][lj * 2048 + col] * (1.0f + mv[1]) - NA[lj * 2048 + col]), fabsf(mv[0] - NB[lj * 2048 + col]));
            err = fmaxf(err, fabsf((jj == 1 ? 1.0f : 0.5f) * (1.0f + mv[2]) - GT[lj * 2048 + col])); }
    } else if (which == 9) {
        const float* x = XRES + (size_t)row * D; float ss = 0.f;
        for (int c = 0; c < D; ++c) ss += x[c] * x[c];
        const float rstd = 1.0f / sqrtf(ss / D + EPS);
        for (int c = tid; c < D; c += 512) err = fmaxf(err, fabsf(x[c] * rstd * args.in[18][c] - args.out[(size_t)row * D + c]));
    } else if (which == 6) {
        const int n = row >> 7, t = row & 127; float* st = fl;
        for (int s = tid; s <= t; s += 512) { const bf16* z = PROJ + (size_t)(n * 128 + s) * ABN + 4096; float m = 0.f; for (int c = 0; c < 1024; ++c) m += bf2f(z[c]); m /= 1024.0f;
            float q = 0.f; for (int c = 0; c < 1024; ++c) { const float d = bf2f(z[c]) - m; q += d * d; } st[2 * s] = m; st[2 * s + 1] = 1.0f / sqrtf(q / 1024.0f + EPS); }
        __syncthreads();
        for (int c = tid; c < 1024; c += 512) { const int g = c >> 7; float a = 0.f;
            for (int s = 0; s <= t; ++s) { const float zn = (bf2f(PROJ[(size_t)(n * 128 + s) * ABN + 4096 + c]) - st[2 * s]) * st[2 * s + 1] * args.in[12][j * 1024 + c] + args.in[13][j * 1024 + c];
                a += args.in[14][(((size_t)j * 8 + g) * 128 + t) * 128 + s] * zn; }
            a += args.in[15][(j * 8 + g) * 128 + t];
            const float ref = bf2f(PROJ[(size_t)row * ABN + 3072 + c]) * a; err = fmaxf(err, fabsf(ref - bf2f(CAT[(size_t)row * D + 1024 + c]))); }
    }
    dg_max(slot, err);
}
__global__ void diag_out(Args args) {
    const size_t i = (size_t)blockIdx.x * 256 + threadIdx.x; const unsigned* slot = (const unsigned*)(args.ws + WS_CTL) + DG_SLOT;
    if (i < (size_t)S * D) args.out[i] = (i == 0) ? 10.0f + 1.0e4f * __builtin_bit_cast(float, slot[0]) : 0.f;
}
#endif

extern "C" void kernel_launch(void* const* d_in, const int* in_sizes, int n_in, void* d_out, int out_size, void* d_ws, size_t ws_size, hipStream_t stream) {
    static int grid = 0;
    if (grid == 0) {
        if (n_in != 19 || in_sizes[0] != S * D || out_size != S * D || ws_size < WS_END) { fprintf(stderr, "kernel_launch: unexpected shapes (n_in %d, in0 %d, out %d, ws %zu); nothing launched\n", n_in, n_in > 0 ? in_sizes[0] : -1, out_size, ws_size); grid = -1; return; }
        int dev = 0, cus = 0, per_cu = 0;
        if (hipGetDevice(&dev) != hipSuccess || hipDeviceGetAttribute(&cus, hipDeviceAttributeMultiprocessorCount, dev) != hipSuccess) { grid = -1; return; }
        if (hipFuncSetAttribute((const void*)fwd_kernel, hipFuncAttributeMaxDynamicSharedMemorySize, LDS_BYTES) != hipSuccess) { fprintf(stderr, "kernel_launch: hipFuncSetAttribute failed\n"); grid = -1; return; }
        if (hipOccupancyMaxActiveBlocksPerMultiprocessor(&per_cu, (const void*)fwd_kernel, NWAVES * 64, LDS_BYTES) != hipSuccess || per_cu < 1)
            fprintf(stderr, "kernel_launch: note: occupancy query reports %d workgroups per CU\n", per_cu);
        (void)hipGetLastError();
        grid = cus;
    }
    if (grid < 0) return;
    if (hipMemsetAsync((char*)d_ws + WS_CTL, 0, CTL_ZERO_BYTES, stream) != hipSuccess) return;
    Args a{};
    for (int i = 0; i < 19; ++i) a.in[i] = (const float*)d_in[i];
    a.out = (float*)d_out; a.ws = (unsigned char*)d_ws;
#if MK_DIAG == 99
    {
        hipFuncSetAttribute((const void*)diag_check, hipFuncAttributeMaxDynamicSharedMemorySize, 143360);
        const int up_ph[8] = {3, 10, 13, 21, 24, 31, 34, 42}; int done = -1;
        for (int s = 1; s < 8; ++s) {
            for (int p = done + 1; p <= up_ph[s]; ++p) { a.ph_lo = p; a.ph_hi = p + 1; hipLaunchKernelGGL(fwd_kernel, dim3(grid), dim3(NWAVES * 64), LDS_BYTES, stream, a); }
            if (s == 1) hipLaunchKernelGGL(diag_check, dim3(16 * 12), dim3(512), 143360, stream, a, 8, 0);
            hipLaunchKernelGGL(diag_check, dim3(16), dim3(512), 143360, stream, a, 2, s);
            hipMemcpyAsync((char*)d_ws + WS_END, (char*)d_ws + WS_XRES, (size_t)S * D * 4, hipMemcpyDeviceToDevice, stream);
            a.ph_lo = up_ph[s] + 1; a.ph_hi = up_ph[s] + 2; hipLaunchKernelGGL(fwd_kernel, dim3(grid), dim3(NWAVES * 64), LDS_BYTES, stream, a);
            done = up_ph[s] + 1;
            hipLaunchKernelGGL(diag_check, dim3(16), dim3(512), 143360, stream, a, 3, s);
        }
        for (int p = done + 1; p < N_PHASES; ++p) { a.ph_lo = p; a.ph_hi = p + 1; hipLaunchKernelGGL(fwd_kernel, dim3(grid), dim3(NWAVES * 64), LDS_BYTES, stream, a); }
        hipLaunchKernelGGL(diag_check, dim3(16), dim3(512), 143360, stream, a, 9, 0);
        hipLaunchKernelGGL(diag_out, dim3((S * D + 255) / 256), dim3(256), 0, stream, a);
        return;
    }
#elif MK_DIAG
    {
        int digits[8], nd = 0; for (int v = MK_DIAG; v > 0; v /= 10) digits[nd++] = v % 10;
        hipFuncSetAttribute((const void*)diag_check, hipFuncAttributeMaxDynamicSharedMemorySize, 143360);
        int done = -1;
        for (int stage = 0; stage < 3; ++stage) {
            const int upto = ((stage == 0) ? 4 : (stage == 1) ? 7 : 8) + (MK_DIAGJ ? 21 : 0); bool any = false;
            for (int i = 0; i < nd; ++i) { const int w = digits[i]; const int st = (w <= 3) ? 0 : (w <= 6) ? 1 : 2; any |= (st == stage); }
            if (!any) continue;
            for (int p = done + 1; p <= upto; ++p) { a.ph_lo = p; a.ph_hi = p + 1; hipLaunchKernelGGL(fwd_kernel, dim3(grid), dim3(NWAVES * 64), LDS_BYTES, stream, a); }
            done = upto;
            for (int i = 0; i < nd; ++i) { const int w = digits[i]; const int st = (w <= 3) ? 0 : (w <= 6) ? 1 : 2; if (st == stage) hipLaunchKernelGGL(diag_check, dim3(w == 5 ? 128 : 16), dim3(512), 143360, stream, a, w, MK_DIAGJ); }
        }
        hipLaunchKernelGGL(diag_out, dim3((S * D + 255) / 256), dim3(256), 0, stream, a);
        return;
    }
#endif
#if MK_MULTI
    for (int p = 0; p < N_PHASES; ++p) { a.ph_lo = p; a.ph_hi = p + 1; hipLaunchKernelGGL(fwd_kernel, dim3(grid), dim3(NWAVES * 64), LDS_BYTES, stream, a); }
#else
    a.ph_lo = 0; a.ph_hi = N_PHASES;
    hipLaunchKernelGGL(fwd_kernel, dim3(grid), dim3(NWAVES * 64), LDS_BYTES, stream, a);
#endif
    const hipError_t le = hipPeekAtLastError();
    if (le != hipSuccess) fprintf(stderr, "kernel_launch: launch failed: %s\n", hipGetErrorName(le));
}
```

```cpp
#define MK_MULTI 0
#define MK_AB 1
#define MK_DSA 1
#include <hip/hip_runtime.h>
#include <cstdio>
#include <cstdint>
#ifndef MK_DIAG
#define MK_DIAG 0
#endif
#ifndef MK_DIAGJ
#define MK_DIAGJ 0
#endif
#ifndef MK_DUP
#define MK_DUP 0
#endif
#ifndef MK_MULTI
#define MK_MULTI 0
#endif

namespace pg8 {
#define PG8_LAS __attribute__((address_space(3)))
typedef unsigned short bf16_t;
typedef short bf16x8 __attribute__((ext_vector_type(8)));
typedef float f32x4 __attribute__((ext_vector_type(4)));
typedef unsigned u32x4 __attribute__((ext_vector_type(4)));
constexpr int BM = 256, BK = 64, HALF = 128, HTB = HALF * BK * 2  , STAGE_BYTES = 8 * HTB, NXCD = 8, WGM = 8;

__host__ __device__ __forceinline__ int lds_byte(int r, int c) { const int st = (r >> 4) * 2 + (c >> 5), rr = r & 15, cc = c & 31, ob = rr * 64 + cc * 2; return st * 1024 + (ob ^ (((ob >> 9) & 1) << 5)); }
__host__ __device__ __forceinline__ void stage_rc(int b, int& R, int& C) { const int st = b / 1024, sb = b % 1024, swz = sb ^ (((sb >> 9) & 1) << 5); R = (st >> 1) * 16 + swz / 64; C = (st & 1) * 32 + (swz % 64) / 2; }
__host__ __device__ __forceinline__ int perm32(int rho) { const int n = rho >> 4, i = rho & 15; return 8 * (i >> 2) + 4 * n + (i & 3); }

struct Unit { int pm, pn; };
struct Gemm { const bf16_t* A; const bf16_t* Bt; int M, N, K; };

struct StaticOrder {
    int nM, nN, nwg, G, c;
    __host__ __device__ void init(int M, int N, int G_, int c_) { nM = M / BM; nN = N / BM; nwg = nM * nN; G = G_; c = c_; }
    __host__ __device__ bool next(int i, Unit& u) const {
        const long L = (long)i * G + c; if (L >= nwg) return false;
        int wgid = (int)L; { const int q = nwg / NXCD, r = nwg % NXCD, xcd = wgid % NXCD, off = wgid / NXCD; wgid = (xcd < r ? xcd * (q + 1) : r * (q + 1) + (xcd - r) * q) + off; }
        const int nig = WGM * nN, gid = wgid / nig, fm = gid * WGM, gsz = (nM - fm) < WGM ? (nM - fm) : WGM;
        u.pm = fm + ((wgid % nig) % gsz); u.pn = (wgid % nig) / gsz; return true;
    }
    __device__ __forceinline__ void a_ready(const Unit&) const {}
    __device__ __forceinline__ void done(const Unit&) const {}
};

__device__ __forceinline__ unsigned cvt_pk_bf16(float lo, float hi) { unsigned r; asm volatile("v_cvt_pk_bf16_f32 %0, %1, %2" : "=v"(r) : "v"(lo), "v"(hi)); return r; }
typedef float f32x2 __attribute__((ext_vector_type(2)));

__device__ __forceinline__ float fast_sigmoid(float x) { return __builtin_amdgcn_rcpf(1.0f + __builtin_amdgcn_exp2f(-1.4426950408889634f * x)); }
struct EpiSwiglu {
    static constexpr bool PERM = true, AFTER_DRAIN = false;
    bf16_t* O; int ldc;
    __device__ __forceinline__ void operator()(const f32x4 (&acc)[2][2][4][2], const Unit& u, int wr, int wc, int fr, int fq) const {
        const int row0 = u.pm * BM + wr * 64 + fr, col0 = u.pn * HALF + wc * 32 + 8 * fq;
#pragma unroll
        for (int ai = 0; ai < 2; ++ai)
#pragma unroll
            for (int m = 0; m < 4; ++m) { bf16_t* rowp = O + (size_t)(row0 + ai * HALF + m * 16) * ldc + col0;
                const f32x4 g0 = acc[ai][0][m][0], g1 = acc[ai][0][m][1], u0 = acc[ai][1][m][0], u1 = acc[ai][1][m][1];
                float v[8];
#pragma unroll
                for (int j = 0; j < 4; ++j) { v[j] = g0[j] * fast_sigmoid(g0[j]) * u0[j]; v[4 + j] = g1[j] * fast_sigmoid(g1[j]) * u1[j]; }
                u32x4 w; w.x = cvt_pk_bf16(v[0], v[1]); w.y = cvt_pk_bf16(v[2], v[3]); w.z = cvt_pk_bf16(v[4], v[5]); w.w = cvt_pk_bf16(v[6], v[7]);
                *(u32x4*)rowp = w; }
    }
};
struct EpiResid {
    static constexpr bool PERM = false, AFTER_DRAIN = false;
    const float* base; float* out; const float* coef; int ldc;
    __device__ __forceinline__ void operator()(const f32x4 (&acc)[2][2][4][2], const Unit& u, int wr, int wc, int fr, int fq) const {
        const int row0 = u.pm * BM + wr * 64 + fr, col0 = u.pn * BM + wc * 32 + 4 * fq;
        f32x4 cv[2][2];
#pragma unroll
        for (int bj = 0; bj < 2; ++bj)
#pragma unroll
            for (int n = 0; n < 2; ++n) cv[bj][n] = *(const f32x4*)(coef + col0 + bj * HALF + n * 16);
#pragma unroll
        for (int ai = 0; ai < 2; ++ai)
#pragma unroll
            for (int m = 0; m < 4; ++m) { const size_t off = (size_t)(row0 + ai * HALF + m * 16) * ldc + col0;
#pragma unroll
                for (int bj = 0; bj < 2; ++bj)
#pragma unroll
                    for (int n = 0; n < 2; ++n) { const f32x4 b = *(const f32x4*)(base + off + bj * HALF + n * 16);
                        *(f32x4*)(out + off + bj * HALF + n * 16) = b + cv[bj][n] * acc[ai][bj][m][n]; } }
    }
};
struct EpiProj {
    static constexpr bool PERM = true, AFTER_DRAIN = false;
    bf16_t* O; int ldc; int nscale; float scale; int gelu_from;
    __device__ __forceinline__ void operator()(const f32x4 (&acc)[2][2][4][2], const Unit& u, int wr, int wc, int fr, int fq) const {
        const int row0 = u.pm * BM + wr * 64 + fr, col0 = u.pn * BM + wc * 32 + 8 * fq;
        const float sc = (u.pn < nscale) ? scale : 1.0f; const bool gl = (u.pn >= gelu_from);
#pragma unroll
        for (int ai = 0; ai < 2; ++ai)
#pragma unroll
            for (int m = 0; m < 4; ++m) { bf16_t* rowp = O + (size_t)(row0 + ai * HALF + m * 16) * ldc + col0;
#pragma unroll
                for (int bj = 0; bj < 2; ++bj) { f32x4 v0 = acc[ai][bj][m][0] * sc, v1 = acc[ai][bj][m][1] * sc;
                    if (gl) {
#pragma unroll
                        for (int j = 0; j < 4; ++j) { const float a = v0[j], b = v1[j];
                            v0[j] = a * fast_sigmoid(1.5957691216057308f * (a + 0.044715f * a * a * a));
                            v1[j] = b * fast_sigmoid(1.5957691216057308f * (b + 0.044715f * b * b * b)); } }
                    u32x4 w; w.x = cvt_pk_bf16(v0[0], v0[1]); w.y = cvt_pk_bf16(v0[2], v0[3]); w.z = cvt_pk_bf16(v1[0], v1[1]); w.w = cvt_pk_bf16(v1[2], v1[3]);
                    *(u32x4*)(rowp + bj * HALF) = w; } }
    }
};

template <class Epi, class Sched, bool ALIGN_EPI = false, bool SP2 = false>
__device__ __forceinline__ void gemm_phase(PG8_LAS unsigned char* lds, const Gemm g, const Sched& S, const Epi& E) {
    int tid_ = threadIdx.x; asm volatile("" : "+v"(tid_));
    const int tid = tid_, wid = __builtin_amdgcn_readfirstlane(tid >> 6), lane = tid & 63, wr = wid >> 2, wc = wid & 3, fr = lane & 15, fq = lane >> 4;
    const int K = g.K, nt = K / BK;
    unsigned voffA[2], voffB[2];
#pragma unroll
    for (int i = 0; i < 2; ++i) { int R, C; stage_rc(tid * 16 + i * 8192, R, C); const int Rb = Epi::PERM ? ((R & ~31) + perm32(R & 31)) : R;
        voffA[i] = (unsigned)(R * K + C) * 2u; voffB[i] = (unsigned)(Rb * K + C) * 2u; }
    const size_t kstep = (size_t)(BK * 2);
    const size_t hstep = (size_t)HALF * K * 2;
    const size_t tstep = 2 * hstep;
    const unsigned ldsw = (unsigned)wid * 1024u;
    const int aoff = lds_byte(wr * 64 + fr, fq * 8), boff = lds_byte(wc * 32 + fr, fq * 8);
#define PG8_SA(b, h) (((b) * 2 + (h)) * HTB)
#define PG8_SB(b, h) ((4 + (b) * 2 + (h)) * HTB)
#define PG8_STAGE(bufoff, gbase, voff) do { _Pragma("unroll") for (int _i = 0; _i < 2; ++_i) \
        __builtin_amdgcn_global_load_lds((const unsigned*)((const char*)(gbase) + (voff)[_i]), (PG8_LAS unsigned*)(lds + (bufoff) + ldsw + _i * 8192), 16, 0, 0); } while (0)
#define PG8_LDA(dst, b, h) do { _Pragma("unroll") for (int m = 0; m < 4; ++m) _Pragma("unroll") for (int k = 0; k < 2; ++k) dst[m][k] = *(const PG8_LAS bf16x8*)(lds + PG8_SA(b, h) + aoff + m * 2048 + k * 1024); } while (0)
#define PG8_LDB(dst, b, h) do { _Pragma("unroll") for (int n = 0; n < 2; ++n) _Pragma("unroll") for (int k = 0; k < 2; ++k) dst[n][k] = *(const PG8_LAS bf16x8*)(lds + PG8_SB(b, h) + boff + n * 2048 + k * 1024); } while (0)
#define PG8_MMA(ai, bj, At, Bt) do { __builtin_amdgcn_s_setprio(1); _Pragma("unroll") for (int m = 0; m < 4; ++m) _Pragma("unroll") for (int n = 0; n < 2; ++n) _Pragma("unroll") for (int k = 0; k < 2; ++k) \
        acc[ai][bj][m][n] = __builtin_amdgcn_mfma_f32_16x16x32_bf16(Bt[n][k], At[m][k], acc[ai][bj][m][n], 0, 0, 0); __builtin_amdgcn_s_setprio(0); } while (0)
#define PG8_WAIT_V(n) asm volatile("s_waitcnt vmcnt(" #n ")" ::: "memory")
#define PG8_WAIT_L(n) asm volatile("s_waitcnt lgkmcnt(" #n ")" ::: "memory")
#define PG8_BAR __builtin_amdgcn_s_barrier()
#define PG8_SCHED __builtin_amdgcn_sched_barrier(0)
    Unit cur, nxt; int ui = 0;
    if (!S.next(0, cur)) return;
    f32x4 acc[2][2][4][2];
#pragma unroll
    for (int a = 0; a < 2; ++a)
#pragma unroll
        for (int b = 0; b < 2; ++b)
#pragma unroll
            for (int m = 0; m < 4; ++m)
#pragma unroll
                for (int n = 0; n < 2; ++n) acc[a][b][m][n] = (f32x4){0.f, 0.f, 0.f, 0.f};
    bf16x8 At[4][2], B0[2][2], B1[2][2];
    const char* cA = (const char*)g.A + (size_t)cur.pm * tstep; const char* cB = (const char*)g.Bt + (size_t)cur.pn * tstep;
    S.a_ready(cur);
    if constexpr (SP2) {
        PG8_STAGE(PG8_SB(0, 0), cB, voffB); PG8_STAGE(PG8_SB(0, 1), cB + hstep, voffB); PG8_STAGE(PG8_SA(0, 0), cA, voffA); PG8_STAGE(PG8_SA(0, 1), cA + hstep, voffA);
        if (wr == 1) PG8_BAR;
        PG8_WAIT_V(2); PG8_BAR;
        PG8_STAGE(PG8_SB(1, 0), cB + kstep, voffB); PG8_STAGE(PG8_SA(1, 0), cA + kstep, voffA); PG8_STAGE(PG8_SB(1, 1), cB + hstep + kstep, voffB);
        PG8_WAIT_V(6); PG8_BAR;
    } else {
        PG8_STAGE(PG8_SB(0, 0), cB, voffB); PG8_STAGE(PG8_SA(0, 0), cA, voffA); PG8_STAGE(PG8_SB(0, 1), cB + hstep, voffB); PG8_STAGE(PG8_SA(0, 1), cA + hstep, voffA);
        if (wr == 1) PG8_BAR;
        PG8_WAIT_V(4); PG8_BAR;
        PG8_STAGE(PG8_SB(1, 0), cB + kstep, voffB); PG8_STAGE(PG8_SA(1, 0), cA + kstep, voffA); PG8_STAGE(PG8_SB(1, 1), cB + hstep + kstep, voffB);
        PG8_WAIT_V(6); PG8_BAR;
    }
    for (;;) {
        const bool has_next = S.next(ui + 1, nxt);
        const char* nA = has_next ? (const char*)g.A + (size_t)nxt.pm * tstep : cA; const char* nB = has_next ? (const char*)g.Bt + (size_t)nxt.pn * tstep : cB;
        for (int t = 0; t < nt; t += 2) {
            const bool last = (t == nt - 2);
            const char* a1 = cA + (size_t)(t + 1) * kstep;
            const char* a2 = last ? nA : cA + (size_t)(t + 2) * kstep; const char* b2 = last ? nB : cB + (size_t)(t + 2) * kstep;
            const char* a3 = a2 + kstep; const char* b3 = b2 + kstep;
            if (last && has_next) S.a_ready(nxt);
            if constexpr (SP2) {
            PG8_LDB(B0, 0, 0); PG8_LDB(B1, 0, 1); PG8_SCHED; PG8_LDA(At, 0, 0); PG8_STAGE(PG8_SA(1, 1), a1 + hstep, voffA);
            PG8_WAIT_V(8); PG8_WAIT_L(0); PG8_BAR; PG8_MMA(0, 0, At, B0); PG8_MMA(0, 1, At, B1); PG8_BAR; PG8_SCHED;
            PG8_LDA(At, 0, 1); PG8_STAGE(PG8_SB(0, 0), b2, voffB); PG8_STAGE(PG8_SB(0, 1), b2 + hstep, voffB); PG8_STAGE(PG8_SA(0, 0), a2, voffA);
            PG8_WAIT_V(8); PG8_WAIT_L(0); PG8_BAR; PG8_MMA(1, 0, At, B0); PG8_MMA(1, 1, At, B1); PG8_BAR; PG8_SCHED;
            PG8_LDB(B0, 1, 0); PG8_LDB(B1, 1, 1); PG8_SCHED; PG8_LDA(At, 1, 0); PG8_STAGE(PG8_SA(0, 1), a2 + hstep, voffA);
            PG8_WAIT_V(8); PG8_WAIT_L(0); PG8_BAR; PG8_MMA(0, 0, At, B0); PG8_MMA(0, 1, At, B1); PG8_BAR; PG8_SCHED;
            PG8_LDA(At, 1, 1); PG8_STAGE(PG8_SB(1, 0), b3, voffB); PG8_STAGE(PG8_SB(1, 1), b3 + hstep, voffB); PG8_STAGE(PG8_SA(1, 0), a3, voffA);
            PG8_WAIT_V(8); PG8_WAIT_L(0); PG8_BAR; PG8_MMA(1, 0, At, B0); PG8_MMA(1, 1, At, B1); PG8_BAR; PG8_SCHED;
            } else {
            PG8_LDB(B0, 0, 0); PG8_SCHED; PG8_LDA(At, 0, 0); PG8_STAGE(PG8_SA(1, 1), a1 + hstep, voffA);
            PG8_WAIT_L(8); PG8_BAR; PG8_WAIT_L(0); PG8_MMA(0, 0, At, B0); PG8_BAR; PG8_SCHED;
            PG8_LDB(B1, 0, 1); PG8_STAGE(PG8_SB(0, 0), b2, voffB);
            PG8_BAR; PG8_WAIT_L(0); PG8_MMA(0, 1, At, B1); PG8_BAR;
            PG8_LDA(At, 0, 1); PG8_STAGE(PG8_SA(0, 0), a2, voffA);
            PG8_BAR; PG8_WAIT_L(0); PG8_MMA(1, 0, At, B0); PG8_BAR; PG8_SCHED;
            PG8_STAGE(PG8_SB(0, 1), b2 + hstep, voffB);
            PG8_WAIT_V(6); PG8_BAR; PG8_MMA(1, 1, At, B1); PG8_BAR;
            PG8_LDB(B0, 1, 0); PG8_SCHED; PG8_LDA(At, 1, 0); PG8_STAGE(PG8_SA(0, 1), a2 + hstep, voffA);
            PG8_WAIT_L(8); PG8_BAR; PG8_WAIT_L(0); PG8_MMA(0, 0, At, B0); PG8_BAR; PG8_SCHED;
            PG8_LDB(B1, 1, 1); PG8_STAGE(PG8_SB(1, 0), b3, voffB);
            PG8_BAR; PG8_WAIT_L(0); PG8_MMA(0, 1, At, B1); PG8_BAR;
            PG8_LDA(At, 1, 1); PG8_STAGE(PG8_SA(1, 0), a3, voffA);
            PG8_BAR; PG8_WAIT_L(0); PG8_MMA(1, 0, At, B0); PG8_BAR; PG8_SCHED;
            PG8_STAGE(PG8_SB(1, 1), b3 + hstep, voffB);
            PG8_WAIT_V(6); PG8_BAR; PG8_MMA(1, 1, At, B1); PG8_BAR;
            }
        }
        if constexpr (ALIGN_EPI) { if (wr == 0) PG8_BAR; }
        if constexpr (!Epi::AFTER_DRAIN) { E(acc, cur, wr, wc, fr, fq); S.done(cur); }
        if (!has_next) break;
#pragma unroll
        for (int a = 0; a < 2; ++a)
#pragma unroll
            for (int b = 0; b < 2; ++b)
#pragma unroll
                for (int m = 0; m < 4; ++m)
#pragma unroll
                    for (int n = 0; n < 2; ++n) acc[a][b][m][n] = (f32x4){0.f, 0.f, 0.f, 0.f};
        cur = nxt; cA = nA; cB = nB; ++ui;
        if constexpr (ALIGN_EPI) { if (wr == 1) PG8_BAR; }
    }
    PG8_WAIT_V(0);
    if constexpr (!ALIGN_EPI) { if (wr == 0) PG8_BAR; }
    PG8_BAR;
    if constexpr (Epi::AFTER_DRAIN) { E.fused(acc, cur, wr, wc, fr, fq, lds, wid, lane); S.done(cur); }
#undef PG8_SA
#undef PG8_SB
#undef PG8_STAGE
#undef PG8_LDA
#undef PG8_LDB
#undef PG8_MMA
#undef PG8_WAIT_V
#undef PG8_WAIT_L
#undef PG8_BAR
#undef PG8_SCHED
}
}

constexpr int S = 16384, D = 2048, DEPTH = 4, DFF = 5504, NMODV = 9 * 2048;
constexpr int ABN = 5120, CIN = 4176, CINP = 4352;
constexpr float EPS = 1e-6f, LOG2E = 1.4426950408889634f;
constexpr int NWAVES = 8;
constexpr size_t MiB = 1u << 20;
constexpr size_t WS_CTL = 0, CTL_ZERO_BYTES = 1 * MiB;
constexpr size_t WS_PART = 1 * MiB, WS_VEC = 3 * MiB;
constexpr size_t WS_W1T = 4 * MiB, WS_W2T = 348 * MiB, WS_ABIN = 520 * MiB, WS_ABOUT = 560 * MiB, WS_DSAIN = 576 * MiB, WS_DSAOUT = 610 * MiB;
constexpr size_t WS_XRES = 626 * MiB, WS_XN = 754 * MiB, WS_H = 818 * MiB, WS_PROJ = 990 * MiB, WS_CAT = 1150 * MiB, WS_SEL = 1214 * MiB, WS_END = 1222 * MiB;
constexpr size_t W1T_SZ = (size_t)2 * DFF * D, W2T_SZ = (size_t)D * DFF, ABIN_SZ = (size_t)ABN * D, SQ_SZ = (size_t)D * D, DSAIN_SZ = (size_t)CINP * D;
static_assert(WS_W1T + 8 * W1T_SZ * 2 <= WS_W2T && WS_W2T + 8 * W2T_SZ * 2 <= WS_ABIN && WS_ABIN + 2 * ABIN_SZ * 2 <= WS_ABOUT && WS_ABOUT + 2 * SQ_SZ * 2 <= WS_DSAIN &&
              WS_DSAIN + 2 * DSAIN_SZ * 2 <= WS_DSAOUT && WS_DSAOUT + 2 * SQ_SZ * 2 <= WS_XRES && WS_XRES + (size_t)S * D * 4 <= WS_XN && WS_XN + (size_t)S * D * 2 <= WS_H &&
              WS_H + (size_t)S * DFF * 2 <= WS_PROJ && WS_PROJ + (size_t)S * ABN * 2 <= WS_CAT && WS_CAT + (size_t)S * D * 2 <= WS_SEL && WS_SEL + (size_t)S * 256 * 2 <= WS_END, "d_ws map");
constexpr int CW_BAR = 4096;
constexpr int RING_BYTES = 147456;
constexpr int MISC_OFF = RING_BYTES;
constexpr int INP_OFF = RING_BYTES + 256;
constexpr int LDS_BYTES = RING_BYTES + 512;

#define GAS __attribute__((address_space(1)))
#define LAS __attribute__((address_space(3)))
typedef unsigned short bf16;
typedef unsigned v4u __attribute__((ext_vector_type(4)));
typedef unsigned v2u __attribute__((ext_vector_type(2)));
typedef float f32x4 __attribute__((ext_vector_type(4)));
typedef float f32x16 __attribute__((ext_vector_type(16)));
typedef short bf16x8 __attribute__((ext_vector_type(8)));
typedef short s16x4 __attribute__((ext_vector_type(4)));
typedef GAS unsigned gu32;
#define LDS_WAIT() asm volatile("s_waitcnt lgkmcnt(0)" ::: "memory")
#define VM_WAIT() asm volatile("s_waitcnt vmcnt(0)" ::: "memory")
__device__ __forceinline__ unsigned f2bf(float f) { unsigned u = __builtin_bit_cast(unsigned, f); return (u + 0x7fffu + ((u >> 16) & 1u)) >> 16; }
__device__ __forceinline__ unsigned pk2(float lo, float hi) { return f2bf(lo) | (f2bf(hi) << 16); }
__device__ __forceinline__ float bf2f(unsigned short b) { return __builtin_bit_cast(float, (unsigned)b << 16); }
typedef float f32x2_t __attribute__((ext_vector_type(2))); typedef __bf16 bf16x2_t __attribute__((ext_vector_type(2)));
__device__ __forceinline__ unsigned cvtpk(float lo, float hi) { f32x2_t v = {lo, hi}; bf16x2_t b = __builtin_convertvector(v, bf16x2_t); return __builtin_bit_cast(unsigned, b); }
__device__ __forceinline__ int crow(int i, int hh) { return (i & 3) + 8 * (i >> 2) + 4 * hh; }
template <int K> __device__ __forceinline__ float swz_xor(float v) { return __builtin_bit_cast(float, __builtin_amdgcn_ds_swizzle(__builtin_bit_cast(int, v), (K << 10) | 0x1f)); }
__device__ __forceinline__ float sum32(float v) { const unsigned u = __builtin_bit_cast(unsigned, v); auto rr = __builtin_amdgcn_permlane32_swap(u, u, false, false); return __builtin_bit_cast(float, (unsigned)rr[0]) + __builtin_bit_cast(float, (unsigned)rr[1]); }
__device__ __forceinline__ float max32(float v) { const unsigned u = __builtin_bit_cast(unsigned, v); auto rr = __builtin_amdgcn_permlane32_swap(u, u, false, false); return fmaxf(__builtin_bit_cast(float, (unsigned)rr[0]), __builtin_bit_cast(float, (unsigned)rr[1])); }
__device__ __forceinline__ float wave_sum(float v) {
    v += swz_xor<1>(v); v += swz_xor<2>(v); v += swz_xor<4>(v); v += swz_xor<8>(v); v += swz_xor<16>(v);
    return sum32(v);
}
__device__ __forceinline__ void glds16(const void* gsrc, unsigned lds_dst) { unsigned keep;
    asm volatile("s_mov_b32 %0, m0\n\ts_mov_b32 m0, %2\n\ts_nop 0\n\tglobal_load_lds_dwordx4 %1, off\n\ts_mov_b32 m0, %0" : "=&s"(keep) : "v"(gsrc), "s"(lds_dst) : "memory"); }
__device__ __forceinline__ unsigned lds_addr(const LAS unsigned char* p) { return (unsigned)(size_t)p; }
#define MFMA32(a, b, c) __builtin_amdgcn_mfma_f32_32x32x16_bf16((a), (b), (c), 0, 0, 0)
typedef short v4i16_t __attribute__((ext_vector_type(4)));
__device__ __forceinline__ s16x4 vtr(const LAS unsigned char* p) { return __builtin_bit_cast(s16x4, __builtin_amdgcn_ds_read_tr16_b64_v4i16((LAS v4i16_t*)p)); }
__device__ const unsigned char REL_BUCKET[129] = {
    0, 1, 2, 3, 4, 5, 6, 7, 8, 9, 10, 11, 12, 13, 14, 15,
    16, 16, 16, 17, 17, 18, 18, 18, 19, 19, 19, 20, 20, 20, 20, 21,
    21, 21, 21, 22, 22, 22, 22, 22, 23, 23, 23, 23, 23, 23, 24, 24,
    24, 24, 24, 24, 25, 25, 25, 25, 25, 25, 25, 26, 26, 26, 26, 26,
    26, 26, 26, 27, 27, 27, 27, 27, 27, 27, 27, 27, 27, 28, 28, 28,
    28, 28, 28, 28, 28, 28, 28, 29, 29, 29, 29, 29, 29, 29, 29, 29,
    29, 29, 29, 30, 30, 30, 30, 30, 30, 30, 30, 30, 30, 30, 30, 30,
    30, 31, 31, 31, 31, 31, 31, 31, 31, 31, 31, 31, 31, 31, 31, 31,
    31
};

#define XB_TMO      128
#define XB_XCNT(j)  (256  + 64 * (j))
#define XB_XSUB(j)  (1280 + 64 * (j))
#define XB_XGEN(j)  (2304 + 64 * (j))
#define XB_TOP      3328
#define XB_TOPGEN   3392
#define XCD_BAR_WORDS 3456
#define XB_SPIN_CAP (1u << 22)

__device__ __forceinline__ unsigned xb_ld(unsigned* p)              { return __hip_atomic_load(p, __ATOMIC_RELAXED, __HIP_MEMORY_SCOPE_AGENT); }
__device__ __forceinline__ unsigned xb_add(unsigned* p, unsigned v) { return __hip_atomic_fetch_add(p, v, __ATOMIC_RELAXED, __HIP_MEMORY_SCOPE_AGENT); }
__device__ __forceinline__ unsigned xb_xcc_id() { return (unsigned)__builtin_amdgcn_s_getreg((3 << 11) | 20) & 0xFu; }
#define XB_SPIN(cond, bar) do { unsigned _sp = 0; while (cond) { __builtin_amdgcn_s_sleep(1); \
    if ((++_sp & 255u) == 0u) { if (xb_ld(&(bar)[XB_TMO])) break; if (_sp > XB_SPIN_CAP) { atomicAdd(&(bar)[XB_TMO], 1u); break; } } } } while (0)

struct XcdBarrier {
    unsigned* bar; unsigned x;
    volatile LAS unsigned* st;
};

__device__ __forceinline__ bool xb_thread0(int wave) { unsigned z = 0u; asm volatile("" : "+v"(z)); return wave == 0 && __builtin_amdgcn_mbcnt_hi(~0u, __builtin_amdgcn_mbcnt_lo(~0u, z)) == 0u; }
__device__ __forceinline__ XcdBarrier xcd_barrier_post(unsigned* bar, volatile LAS unsigned* st, int wave) {
    XcdBarrier b; b.bar = bar; b.x = xb_xcc_id(); b.st = st;
    if (xb_thread0(wave)) (void)xb_add(&bar[XB_XCNT(b.x)], 1u);
    return b;
}
__device__ __forceinline__ void xcd_barrier_complete(unsigned* bar, unsigned x, unsigned& nloc, unsigned& nx) {
    const unsigned G = gridDim.x * gridDim.y * gridDim.z;
    unsigned sum, cnt, mine, sp = 0u;
    for (;;) {
        sum = 0u; cnt = 0u; mine = 0u;
#pragma unroll
        for (unsigned j = 0; j < 16; ++j) { const unsigned c = xb_ld(&bar[XB_XCNT(j)]); sum += c; cnt += (c > 0u) ? 1u : 0u; mine = (j == x) ? c : mine; }
        if (sum == G) break;
        __builtin_amdgcn_s_sleep(1);
        if ((++sp & 255u) == 0u) { if (xb_ld(&bar[XB_TMO])) break; if (sp > XB_SPIN_CAP) { atomicAdd(&bar[XB_TMO], 1u); break; } }
    }
    nloc = mine > 0u ? mine : 1u; nx = cnt > 0u ? cnt : 1u;
}

__device__ __forceinline__ void xcd_barrier(const XcdBarrier& b, int wave) {
    asm volatile("s_waitcnt vmcnt(0)" ::: "memory");
    __syncthreads();
    if (xb_thread0(wave)) {
        unsigned* bar = b.bar;
        __builtin_amdgcn_s_waitcnt(0);
        unsigned nloc = b.st[0], nx = b.st[1];
        if (nloc == 0u) { xcd_barrier_complete(bar, b.x, nloc, nx); b.st[0] = nloc; b.st[1] = nx; }
        const unsigned old = xb_add(&bar[XB_XSUB(b.x)], 1u);
        const unsigned gen = old / nloc;
        if (old + 1u == (gen + 1u) * nloc) {
            __builtin_amdgcn_fence(__ATOMIC_RELEASE, "agent");
            asm volatile("s_waitcnt vmcnt(0)" ::: "memory");
            const unsigned og = xb_add(&bar[XB_TOP], 1u);
            const unsigned tg = og / nx;
            if (og + 1u == (tg + 1u) * nx) xb_add(&bar[XB_TOPGEN], 1u);
            else XB_SPIN(xb_ld(&bar[XB_TOPGEN]) == tg, bar);
            __builtin_amdgcn_fence(__ATOMIC_ACQUIRE, "agent");
            xb_add(&bar[XB_XGEN(b.x)], 1u);
            asm volatile("s_waitcnt vmcnt(0)" ::: "memory");
        } else {
            XB_SPIN(xb_ld(&bar[XB_XGEN(b.x)]) == gen, bar);
            __builtin_amdgcn_fence(__ATOMIC_ACQUIRE, "agent");
            asm volatile("s_waitcnt vmcnt(0)" ::: "memory");
        }
    }
    __syncthreads();
}

struct Frame {
    LAS unsigned char* lds;
    int tid, lane, wave, vcu, G;
};

__device__ __forceinline__ void tr_item(const float* W, int K, int N, int ncols, bf16* WT, int out_row0, LAS float* scr, int k0, int n0, int lane) {
    const int col = n0 + (lane & 31); const bool ok = col < ncols;
    float tv[32];
    const float* wp = W + (size_t)(k0 + (lane >> 5)) * N + (ok ? col : 0);
#pragma unroll
    for (int i = 0; i < 32; ++i) tv[i] = wp[(size_t)(2 * i) * N];
#pragma unroll
    for (int i = 0; i < 32; ++i) scr[(2 * i + (lane >> 5)) * 33 + (lane & 31)] = ok ? tv[i] : 0.f;
    LDS_WAIT(); asm volatile("" ::: "memory");
    const int c = lane & 7;
#pragma unroll
    for (int j = 0; j < 4; ++j) { const int n = (lane >> 3) + 8 * j; const LAS float* s = scr + (8 * c) * 33 + n;
        v4u o; o.x = pk2(s[0 * 33], s[1 * 33]); o.y = pk2(s[2 * 33], s[3 * 33]); o.z = pk2(s[4 * 33], s[5 * 33]); o.w = pk2(s[6 * 33], s[7 * 33]);
        *(GAS v4u*)(WT + (size_t)(out_row0 + n) * K + k0 + 8 * c) = o; }
    LDS_WAIT(); asm volatile("" ::: "memory");
}
constexpr int I_W1 = 32 * 344, I_W2 = 86 * 64, I_ABI = 32 * 160, I_SQ = 32 * 64, I_DSI = 32 * 136;
constexpr int N_TR_ITEMS = 8 * I_W1 + 8 * I_W2 + 2 * I_ABI + 2 * I_SQ + 2 * I_DSI + 2 * I_SQ;
constexpr int N_GEMV_UNITS = 4 * 72 * 4;
struct Args; __device__ __forceinline__ const float* in_ptr(const Args& a, int i);
__device__ __forceinline__ void prologue_phase(Frame& F, const Args& A, unsigned char* ws) {
    const float* c = in_ptr(A, 1); const float* mod_w = in_ptr(A, 3); float* PART = (float*)(ws + WS_PART);
    for (int unit = F.vcu; unit < N_GEMV_UNITS; unit += F.G) {
        const int l = unit / 288, rem = unit % 288, cb = rem >> 2, kq = rem & 3;
        LAS float* sc = (LAS float*)F.lds + F.wave * 64;
        const int k0 = kq * 512 + F.wave * 64;
        { const float cv = c[k0 + F.lane]; sc[F.lane] = cv * pg8::fast_sigmoid(cv); }
        LDS_WAIT(); asm volatile("" ::: "memory");
        const float* W = mod_w + ((size_t)l * 2048 + k0) * NMODV + cb * 256 + 4 * F.lane;
        f32x4 acc = {0.f, 0.f, 0.f, 0.f};
#pragma unroll 16
        for (int kk = 0; kk < 64; ++kk) acc += sc[kk] * *(const f32x4*)(W + (size_t)kk * NMODV);
        *((LAS f32x4*)(F.lds + 4096) + F.wave * 64 + F.lane) = acc;
        __syncthreads();
        if (F.tid < 256) { float s = 0.f;
#pragma unroll
            for (int w = 0; w < 8; ++w) s += ((LAS float*)(F.lds + 4096))[w * 256 + F.tid];
            PART[(size_t)(kq * 4 + l) * NMODV + cb * 256 + F.tid] = s; }
        __syncthreads();
    }
    LAS float* scr = (LAS float*)(F.lds + 16384 + F.wave * 8704);
    const int gw = F.vcu * NWAVES + F.wave, NGW = F.G * NWAVES;
    for (int it = gw; it < N_TR_ITEMS; it += NGW) {
        int r = it;
        if (r < 8 * I_W1) { const int mi = r / I_W1, q = r % I_W1, kb = q / 344, nb = q % 344, n0 = nb * 32;
            const int orow = (n0 < DFF) ? (n0 / 128) * 256 + (n0 % 128) : ((n0 - DFF) / 128) * 256 + 128 + ((n0 - DFF) % 128);
            tr_item(in_ptr(A, 5) + (size_t)mi * D * 2 * DFF, D, 2 * DFF, 2 * DFF, (bf16*)(ws + WS_W1T) + (size_t)mi * W1T_SZ, orow, scr, kb * 64, n0, F.lane); continue; } r -= 8 * I_W1;
        if (r < 8 * I_W2) { const int mi = r / I_W2, q = r % I_W2, kb = q / 64, nb = q % 64;
            tr_item(in_ptr(A, 6) + (size_t)mi * DFF * D, DFF, D, D, (bf16*)(ws + WS_W2T) + (size_t)mi * W2T_SZ, nb * 32, scr, kb * 64, nb * 32, F.lane); continue; } r -= 8 * I_W2;
        if (r < 2 * I_ABI) { const int mi = r / I_ABI, q = r % I_ABI, kb = q / 160, nb = q % 160;
            tr_item(in_ptr(A, 8) + (size_t)mi * D * ABN, D, ABN, ABN, (bf16*)(ws + WS_ABIN) + (size_t)mi * ABIN_SZ, nb * 32, scr, kb * 64, nb * 32, F.lane); continue; } r -= 2 * I_ABI;
        if (r < 2 * I_SQ) { const int mi = r / I_SQ, q = r % I_SQ, kb = q / 64, nb = q % 64;
            tr_item(in_ptr(A, 9) + (size_t)mi * SQ_SZ, D, D, D, (bf16*)(ws + WS_ABOUT) + (size_t)mi * SQ_SZ, nb * 32, scr, kb * 64, nb * 32, F.lane); continue; } r -= 2 * I_SQ;
        if (r < 2 * I_DSI) { const int mi = r / I_DSI, q = r % I_DSI, kb = q / 136, nb = q % 136;
            tr_item(in_ptr(A, 16) + (size_t)mi * D * CIN, D, CIN, CIN, (bf16*)(ws + WS_DSAIN) + (size_t)mi * DSAIN_SZ, nb * 32, scr, kb * 64, nb * 32, F.lane); continue; } r -= 2 * I_DSI;
        { const int mi = r / I_SQ, q = r % I_SQ, kb = q / 64, nb = q % 64;
            tr_item(in_ptr(A, 17) + (size_t)mi * SQ_SZ, D, D, D, (bf16*)(ws + WS_DSAOUT) + (size_t)mi * SQ_SZ, nb * 32, scr, kb * 64, nb * 32, F.lane); }
    }
}
__device__ __forceinline__ void vec_phase(Frame& F, const Args& A, unsigned char* ws) {
    const float* PART = (const float*)(ws + WS_PART); const float* mod_b = in_ptr(A, 4); const float* norm_g = in_ptr(A, 2);
    float* NA = (float*)(ws + WS_VEC); float* NB = NA + 12 * 2048; float* GT = NB + 12 * 2048;
    for (int idx = F.vcu * 512 + F.tid; idx < 12 * 2048; idx += F.G * 512) {
        const int lj = idx >> 11, col = idx & 2047, l = lj / 3, j = lj % 3;
        float mv[3];
#pragma unroll
        for (int t = 0; t < 3; ++t) { const int n = (3 * j + t) * 2048 + col; float s = mod_b[l * NMODV + n];
#pragma unroll
            for (int kq = 0; kq < 4; ++kq) s += PART[(size_t)(kq * 4 + l) * NMODV + n];
            mv[t] = s; }
        NA[idx] = norm_g[idx] * (1.0f + mv[1]); NB[idx] = mv[0]; GT[idx] = (j == 1 ? 1.0f : 0.5f) * (1.0f + mv[2]);
    }
}
__device__ __forceinline__ void norm_phase(Frame& F, const float* src, const float* na, const float* nb, bf16* dst) {
    const int gw = F.vcu * NWAVES + F.wave, NGW = F.G * NWAVES;
    for (int m = gw; m < S; m += NGW) {
        const GAS f32x4* xr = (const GAS f32x4*)(src + (size_t)m * D) + F.lane;
        f32x4 v[8]; float ss = 0.f;
#pragma unroll
        for (int j = 0; j < 8; ++j) { v[j] = xr[64 * j]; ss += (v[j].x * v[j].x + v[j].y * v[j].y) + (v[j].z * v[j].z + v[j].w * v[j].w); }
        const float rstd = 1.0f / sqrtf(wave_sum(ss) * (1.0f / D) + EPS);
        GAS v2u* o8 = (GAS v2u*)(dst + (size_t)m * D) + F.lane;
#pragma unroll
        for (int j = 0; j < 8; ++j) { const f32x4 a = ((const f32x4*)na)[64 * j + F.lane], b = ((const f32x4*)nb)[64 * j + F.lane]; const f32x4 o = v[j] * rstd * a + b;
            v2u w; w.x = cvtpk(o.x, o.y); w.y = cvtpk(o.z, o.w); o8[64 * j] = w; }
    }
}
__device__ __forceinline__ void final_norm_phase(Frame& F, const float* src, const float* g, float* out) {
    const int gw = F.vcu * NWAVES + F.wave, NGW = F.G * NWAVES;
    for (int m = gw; m < S; m += NGW) {
        const GAS f32x4* xr = (const GAS f32x4*)(src + (size_t)m * D) + F.lane;
        f32x4 v[8]; float ss = 0.f;
#pragma unroll
        for (int j = 0; j < 8; ++j) { v[j] = xr[64 * j]; ss += (v[j].x * v[j].x + v[j].y * v[j].y) + (v[j].z * v[j].z + v[j].w * v[j].w); }
        const float rstd = 1.0f / sqrtf(wave_sum(ss) * (1.0f / D) + EPS);
        GAS f32x4* o = (GAS f32x4*)(out + (size_t)m * D) + F.lane;
#pragma unroll
        for (int j = 0; j < 8; ++j) o[64 * j] = v[j] * rstd * ((const f32x4*)g)[64 * j + F.lane];
    }
}

namespace da {
constexpr int PITCH = ABN, KOFF = 1024, VOFF = 2048;
constexpr float C2 = 0.125f * LOG2E;
constexpr int NBUF = 4, LDS_LUT = NBUF * 32768;
#define DA_WAIT_BAR(N) asm volatile("s_waitcnt vmcnt(" #N ") lgkmcnt(0)\n\ts_barrier" ::: "memory")
constexpr float THR = 8.0f;
__device__ __forceinline__ void dma_tile(LAS unsigned char* lds, const bf16* P, int h, int k0, int buf, int wid, int lane) {
#pragma unroll
    for (int i = 0; i < 2; ++i) {
        const int piece = wid * 2 + i, row = piece * 4 + (lane >> 4), pc = lane & 15;
        const int ck = pc ^ (row & 15), cv = pc ^ (2 * (row & 7));
        const bf16* rp = P + (size_t)(k0 + row) * PITCH + h * 128;
        glds16(rp + KOFF + ck * 8, (unsigned)__builtin_amdgcn_readfirstlane(lds_addr(lds) + buf * 32768 + piece * 1024));
        glds16(rp + VOFF + cv * 8, (unsigned)__builtin_amdgcn_readfirstlane(lds_addr(lds) + buf * 32768 + 16384 + piece * 1024));
    }
}
__device__ __forceinline__ float max3_asm(float a, float b, float c) { float r; asm("v_max3_f32 %0, %1, %2, %3" : "=v"(r) : "v"(a), "v"(b), "v"(c)); return r; }
__device__ __forceinline__ void unit(int tid, LAS unsigned char* lds, const bf16* P, bf16* CAT, int h, int qb, float lam, float oscale, const float* subg, const float* rel) {
    const int lane = tid & 63, wid = __builtin_amdgcn_readfirstlane(tid >> 6), r = lane & 31, hh = lane >> 5;
    const int rb = wid >> 1, m = wid & 1;
    const int q0w = qb * 128 + rb * 32, qpos = q0w + r;
    LAS float* lut = (LAS float*)(lds + LDS_LUT);
    __syncthreads();
    if (tid < 258) { const int mm = tid / 129, d = tid % 129; const int b = REL_BUCKET[d];
        lut[mm * 132 + d] = (rel[b * 16 + h * 2 + mm] - rel[31 * 16 + h * 2 + mm]) * LOG2E; }
    const int NT = 2 * qb + 2;
    bf16x8 qf[4];
#pragma unroll
    for (int ks = 0; ks < 4; ++ks) qf[ks] = *(const bf16x8*)(P + (size_t)qpos * PITCH + h * 128 + m * 64 + ks * 16 + hh * 8);
    asm volatile("s_waitcnt vmcnt(0)" : "+v"(qf[0]), "+v"(qf[1]), "+v"(qf[2]), "+v"(qf[3]) :: "memory");
    dma_tile(lds, P, h, 0, 0, wid, lane); dma_tile(lds, P, h, 64, 1, wid, lane);
    if (NT > 2) dma_tile(lds, P, h, 128, 2, wid, lane);
    f32x16 O[4];
#pragma unroll
    for (int e = 0; e < 4; ++e)
#pragma unroll
        for (int i = 0; i < 16; ++i) O[e][i] = 0.f;
    float mref = 0.f, ls4[4] = {0.f, 0.f, 0.f, 0.f};
    f32x16 negm;
#pragma unroll
    for (int i = 0; i < 16; ++i) negm[i] = 0.f;
    const int klane = r * 256, kbits0 = (8 * m + hh) ^ (r & 15);
    const int l16 = lane & 15, qq = l16 >> 2, p4 = l16 & 3, G4 = lane >> 4;
    const int x0 = 4 * hh + qq, lanev20 = (2 * (G4 & 1) + (p4 >> 1)) ^ (2 * x0), vlane = x0 * 256 + (p4 & 1) * 8;
    if (NT > 2) DA_WAIT_BAR(8); else DA_WAIT_BAR(4);
    for (int t = 0; t < NT; ++t) {
        const int buf = t & 3, k0 = t * 64;
        if (t + 3 < NT) dma_tile(lds, P, h, k0 + 192, (t + 3) & 3, wid, lane);
        int kbits = kbits0, lanev2 = lanev20; asm volatile("" : "+v"(kbits), "+v"(lanev2));
        if (k0 <= q0w + 31) {
            const LAS unsigned char* Kb = lds + buf * 32768; const LAS unsigned char* Vb = Kb + 16384;
            const bool two = (k0 + 32 <= q0w + 31);
            bf16x8 kf[2][4];
#pragma unroll
            for (int kb = 0; kb < 2; ++kb)
#pragma unroll
                for (int ks = 0; ks < 4; ++ks) kf[kb][ks] = *(const LAS bf16x8*)(Kb + kb * 8192 + klane + (((2 * ks) ^ kbits) << 4));
            __builtin_amdgcn_sched_barrier(0);
            f32x16 s0 = negm, s1 = negm;
#pragma unroll
            for (int ks = 0; ks < 4; ++ks) { s0 = MFMA32(kf[0][ks], qf[ks], s0); s1 = MFMA32(kf[1][ks], qf[ks], s1); }
            asm volatile("s_nop 15\n\ts_nop 7" : "+v"(s0), "+v"(s1));
            if (k0 + 191 > q0w) {
#pragma unroll
                for (int i = 0; i < 16; ++i) { const int d0 = qpos - (k0 + crow(i, hh)), d1 = d0 - 32;
                    s0[i] = d0 < 0 ? -INFINITY : s0[i] + lut[m * 132 + (d0 > 128 ? 128 : d0)];
                    s1[i] = d1 < 0 ? -INFINITY : s1[i] + lut[m * 132 + (d1 > 128 ? 128 : d1)]; }
            }
            float mx = max3_asm(s0[0], s0[1], s0[2]), my = max3_asm(s1[0], s1[1], s1[2]);
#pragma unroll
            for (int i = 3; i < 15; i += 2) { mx = max3_asm(mx, s0[i], s0[i + 1]); my = max3_asm(my, s1[i], s1[i + 1]); }
            mx = max3_asm(mx, s0[15], my); mx = fmaxf(mx, s1[15]);
            mx = max32(mx);
            if (__any(mx > THR)) {
                const float dl = fmaxf(mx, 0.f), alpha = __builtin_amdgcn_exp2f(-dl);
                mref += dl;
#pragma unroll
                for (int i = 0; i < 16; ++i) { s0[i] -= dl; s1[i] -= dl; negm[i] = -mref; }
#pragma unroll
                for (int j = 0; j < 4; ++j) ls4[j] *= alpha;
#pragma unroll
                for (int e = 0; e < 4; ++e)
#pragma unroll
                    for (int i = 0; i < 16; ++i) O[e][i] *= alpha;
            }
#pragma unroll
            for (int i = 0; i < 16; ++i) { s0[i] = __builtin_amdgcn_exp2f(s0[i]); s1[i] = __builtin_amdgcn_exp2f(s1[i]); }
#pragma unroll
            for (int i = 0; i < 16; ++i) { ls4[i & 3] += s0[i]; }
#pragma unroll
            for (int i = 0; i < 16; ++i) { ls4[i & 3] += s1[i]; }
            bf16x8 pk[4];
#pragma unroll
            for (int s2 = 0; s2 < 2; ++s2) { v4u w0, w1;
                w0.x = cvtpk(s0[8 * s2], s0[8 * s2 + 1]); w0.y = cvtpk(s0[8 * s2 + 2], s0[8 * s2 + 3]); w0.z = cvtpk(s0[8 * s2 + 4], s0[8 * s2 + 5]); w0.w = cvtpk(s0[8 * s2 + 6], s0[8 * s2 + 7]);
                w1.x = cvtpk(s1[8 * s2], s1[8 * s2 + 1]); w1.y = cvtpk(s1[8 * s2 + 2], s1[8 * s2 + 3]); w1.z = cvtpk(s1[8 * s2 + 4], s1[8 * s2 + 5]); w1.w = cvtpk(s1[8 * s2 + 6], s1[8 * s2 + 7]);
                pk[s2] = __builtin_bit_cast(bf16x8, w0); pk[2 + s2] = __builtin_bit_cast(bf16x8, w1); }
#pragma unroll
            for (int kk = 0; kk < 4; ++kk) {
                if (kk < 2 || two) {
#pragma unroll
                    for (int e = 0; e < 4; ++e) {
                        const LAS unsigned char* a0 = Vb + (16 * kk) * 256 + vlane + (((4 * e) ^ lanev2) << 4);
                        const s16x4 lo = vtr(a0), hi = vtr(a0 + 2048);
                        const bf16x8 vf = (bf16x8){lo[0], lo[1], lo[2], lo[3], hi[0], hi[1], hi[2], hi[3]};
                        O[e] = MFMA32(vf, pk[kk], O[e]);
                    }
                }
            }
        }
        if (t + 3 < NT) DA_WAIT_BAR(8); else if (t + 2 < NT) DA_WAIT_BAR(4); else DA_WAIT_BAR(0);
    }
    float lsum = sum32((ls4[0] + ls4[1]) + (ls4[2] + ls4[3]));
    LAS float* xch = (LAS float*)lds + rb * 4096 + lane;
    if (m == 1) { const float i1 = lam / lsum;
#pragma unroll
        for (int e = 0; e < 4; ++e)
#pragma unroll
            for (int i = 0; i < 16; ++i) xch[(e * 16 + i) * 64] = O[e][i] * i1; }
    __syncthreads();
    if (m == 0) {
        const float i0 = 1.0f / lsum; float ss = 0.f;
#pragma unroll
        for (int e = 0; e < 4; ++e)
#pragma unroll
            for (int i = 0; i < 16; ++i) { const float o = O[e][i] * i0 - xch[(e * 16 + i) * 64]; O[e][i] = o; ss += o * o; }
        ss = sum32(ss);
        const float rs = oscale / sqrtf(ss * (1.0f / 128.0f) + EPS);
        GAS bf16* orow = (GAS bf16*)CAT + (size_t)qpos * D + h * 128;
#pragma unroll
        for (int e = 0; e < 4; ++e)
#pragma unroll
            for (int g4 = 0; g4 < 4; ++g4) { const int ecol = 32 * e + 8 * g4 + 4 * hh; const f32x4 gv = *(const f32x4*)(subg + ecol);
                v2u w; w.x = cvtpk(O[e][4 * g4] * rs * gv.x, O[e][4 * g4 + 1] * rs * gv.y); w.y = cvtpk(O[e][4 * g4 + 2] * rs * gv.z, O[e][4 * g4 + 3] * rs * gv.w);
                *(GAS v2u*)(orow + ecol) = w; }
    }
}
}

namespace sgp {
constexpr int PITCH = ABN, UOFF = 3072, ZOFF = 4096;
constexpr int L_ST = 0, L_W = 1024, L_Z = 1024 + 128 * 272, RS = 272;
__device__ __forceinline__ void unit(int tid, LAS unsigned char* lds, const bf16* P, bf16* CAT, int n, int g, const float* lng, const float* lnb, const float* sgw, const float* sgb) {
    const int lane = tid & 63, wid = __builtin_amdgcn_readfirstlane(tid >> 6), r = lane & 31, hh = lane >> 5;
    const int R0 = n * 128;
    LAS float* st = (LAS float*)(lds + L_ST);
    __syncthreads();
    for (int rr = 0; rr < 16; ++rr) { const int rl = wid * 16 + rr; const bf16* zp = P + (size_t)(R0 + rl) * PITCH + ZOFF + lane * 16;
        const bf16x8 a = *(const bf16x8*)zp, b = *(const bf16x8*)(zp + 8);
        float x[16]; float s = 0.f;
#pragma unroll
        for (int i = 0; i < 8; ++i) { x[i] = bf2f((unsigned short)a[i]); x[8 + i] = bf2f((unsigned short)b[i]); }
#pragma unroll
        for (int i = 0; i < 16; ++i) s += x[i];
        const float mean = wave_sum(s) * (1.0f / 1024.0f); float q = 0.f;
#pragma unroll
        for (int i = 0; i < 16; ++i) { const float d = x[i] - mean; q += d * d; }
        const float rstd = 1.0f / sqrtf(wave_sum(q) * (1.0f / 1024.0f) + EPS);
        if (lane == 0) { st[2 * rl] = mean; st[2 * rl + 1] = rstd; } }
    __syncthreads();
    LAS bf16* ZT = (LAS bf16*)(lds + L_Z); LAS bf16* WT = (LAS bf16*)(lds + L_W);
#pragma unroll
    for (int i = 0; i < 4; ++i) { const int item = tid + 512 * i, sr = item >> 4, ch = item & 15;
        const bf16x8 z = *(const bf16x8*)(P + (size_t)(R0 + sr) * PITCH + ZOFF + g * 128 + ch * 8);
        const float mean = st[2 * sr], rstd = st[2 * sr + 1];
#pragma unroll
        for (int e = 0; e < 8; ++e) { const int c = ch * 8 + e; const float zn = (bf2f((unsigned short)z[e]) - mean) * rstd * lng[g * 128 + c] + lnb[g * 128 + c];
            ZT[c * (RS / 2) + sr] = (bf16)f2bf(zn); } }
#pragma unroll
    for (int i = 0; i < 4; ++i) { const int item = tid + 512 * i, t = item >> 4, sch = item & 15;
        const float* wp = sgw + ((size_t)g * 128 + t) * 128 + sch * 8; const f32x4 a = *(const f32x4*)wp, b = *(const f32x4*)(wp + 4);
        float w[8] = {a.x, a.y, a.z, a.w, b.x, b.y, b.z, b.w};
#pragma unroll
        for (int e = 0; e < 8; ++e) if (sch * 8 + e > t) w[e] = 0.f;
        v4u o; o.x = pk2(w[0], w[1]); o.y = pk2(w[2], w[3]); o.z = pk2(w[4], w[5]); o.w = pk2(w[6], w[7]);
        *(LAS v4u*)(lds + L_W + t * RS + sch * 16) = o; }
    __syncthreads();
    const int tb = wid >> 1, cbp = (wid & 1) * 2;
    f32x16 acc[2];
#pragma unroll
    for (int cc = 0; cc < 2; ++cc)
#pragma unroll
        for (int i = 0; i < 16; ++i) acc[cc][i] = 0.f;
#pragma unroll
    for (int ks = 0; ks < 8; ++ks) {
        if (16 * ks <= 32 * tb + 31) {
            const bf16x8 a = *(const LAS bf16x8*)(lds + L_W + (32 * tb + r) * RS + (16 * ks + 8 * hh) * 2);
#pragma unroll
            for (int cc = 0; cc < 2; ++cc) { const bf16x8 b = *(const LAS bf16x8*)(lds + L_Z + (32 * (cbp + cc) + r) * RS + (16 * ks + 8 * hh) * 2); acc[cc] = MFMA32(a, b, acc[cc]); }
        }
    }
#pragma unroll
    for (int cc = 0; cc < 2; ++cc) { const int c = g * 128 + 32 * (cbp + cc) + r;
#pragma unroll
        for (int i = 0; i < 16; ++i) { const int t = 32 * tb + crow(i, hh); const size_t row = (size_t)(R0 + t);
            const float u = bf2f(P[row * PITCH + UOFF + c]); CAT[row * D + 1024 + c] = (bf16)f2bf(u * (acc[cc][i] + sgb[g * 128 + t])); } }
}
}


namespace dsa {
constexpr int PITCH = CINP, KOFF = 2048, VOFF = 2560, QIOFF = 3072, KIOFF = 4096, WIOFF = 4160;
constexpr float CQ = 0.08838834764831845f * LOG2E;
#define MFMA16(a, b, c) __builtin_amdgcn_mfma_f32_16x16x32_bf16((a), (b), (c), 0, 0, 0)
__device__ __forceinline__ float relu_asm(float x) { float r; asm("v_max_f32_e32 %0, 0, %1" : "=v"(r) : "v"(x)); return r; }
constexpr int L_HIST = 0, L_SEL = 0, L_CS = 16384, L_CK = 32768, L_KT = 65536, L_META = 131072, L_TMP = 131584;
#define IDX_WAIT_BAR(N) asm volatile("s_waitcnt vmcnt(" #N ") lgkmcnt(0)\n\ts_barrier" ::: "memory")
constexpr int NCAND = 128;
__device__ __forceinline__ void dma_ktile(LAS unsigned char* lds, const bf16* P, int t, int buf, int wid, int lane) {
#pragma unroll
    for (int i = 0; i < 2; ++i) { const int piece = wid * 2 + i, row = piece * 8 + (lane >> 3), pc = lane & 7, c = pc ^ ((row >> 1) & 7);
        glds16(P + (size_t)(128 * t + row) * PITCH + KIOFF + c * 8, (unsigned)__builtin_amdgcn_readfirstlane(lds_addr(lds) + L_KT + buf * 16384 + piece * 1024)); }
}
template <int PASS, bool FULL> __device__ __forceinline__ void score_tile(LAS unsigned char* lds, const LAS unsigned char* KT, int kb_, int key0, int u, int wid, int r, int hh, int qmaxw,
                                                                          const bf16x8 (&aq)[2][4], const float (&w)[2][16], int T0, int T1) {
    LAS unsigned* hist = (LAS unsigned*)(lds + L_HIST); LAS unsigned short* sel = (LAS unsigned short*)(lds + L_SEL);
    LAS float* cs = (LAS float*)(lds + L_CS); LAS unsigned short* ck = (LAS unsigned short*)(lds + L_CK); LAS int* meta = (LAS int*)(lds + L_META);
    bf16x8 bk[2][4];
#pragma unroll
    for (int ks = 0; ks < 4; ++ks) bk[0][ks] = *(const LAS bf16x8*)(KT + (((2 * ks) ^ kb_) << 4));
#pragma unroll
    for (int sb = 0; sb < 4; ++sb) {
        if (sb < 3) {
#pragma unroll
            for (int ks = 0; ks < 4; ++ks) bk[(sb + 1) & 1][ks] = *(const LAS bf16x8*)(KT + (sb + 1) * 4096 + (((2 * ks) ^ kb_) << 4));
        }
        __builtin_amdgcn_sched_barrier(0);
        if (FULL || key0 + 32 * sb <= qmaxw) {
            f32x16 acc[2];
#pragma unroll
            for (int p = 0; p < 2; ++p)
#pragma unroll
                for (int i = 0; i < 16; ++i) acc[p][i] = 0.f;
#pragma unroll
            for (int ks = 0; ks < 4; ++ks)
#pragma unroll
                for (int p = 0; p < 2; ++p) acc[p] = MFMA32(aq[p][ks], bk[sb & 1][ks], acc[p]);
            asm volatile("s_nop 15\n\ts_nop 7" : "+v"(acc[0]), "+v"(acc[1]));
#pragma unroll
            for (int p = 0; p < 2; ++p) {
                float s4[4] = {0.f, 0.f, 0.f, 0.f};
#pragma unroll
                for (int i = 0; i < 16; ++i) s4[i & 3] += relu_asm(acc[p][i]) * w[p][i];
                const float sc = (s4[0] + s4[1]) + (s4[2] + s4[3]);
                const int rl = 4 * wid + 2 * p + hh, key = key0 + 32 * sb + r;
                int b = (int)((sc + 32.0f) * 8.0f); b = b < 0 ? 0 : (b > 511 ? 511 : b);
                if (FULL || key <= 32 * u + rl) {
                    if (PASS == 1) (void)__hip_atomic_fetch_add(&hist[rl * 512 + b], 1u, __ATOMIC_RELAXED, __HIP_MEMORY_SCOPE_WORKGROUP);
                    else { const int T = p ? T1 : T0;
                        if (b > T) { const int pos = __hip_atomic_fetch_add(&meta[rl], 1, __ATOMIC_RELAXED, __HIP_MEMORY_SCOPE_WORKGROUP); if (pos < 256) sel[rl * 256 + pos] = (unsigned short)key; }
                        else if (b == T) { const int pos = __hip_atomic_fetch_add(&meta[32 + rl], 1, __ATOMIC_RELAXED, __HIP_MEMORY_SCOPE_WORKGROUP); if (pos < NCAND) { cs[rl * NCAND + pos] = sc; ck[rl * NCAND + pos] = (unsigned short)key; } } }
                }
            }
        }
    }
}
template <int PASS> __device__ __forceinline__ void score_pass(LAS unsigned char* lds, const bf16* P, int u, int wid, int lane, const bf16x8 (&aq)[2][4], const float (&w)[2][16], int T0, int T1) {
    const int r = lane & 31, hh = lane >> 5;
    const int NT = (32 * u + 32 + 127) >> 7, qmaxw = 32 * u + 4 * wid + 3;
    const int kb0 = hh ^ ((r >> 1) & 7);
    VM_WAIT();
    dma_ktile(lds, P, 0, 0, wid, lane);
    if (NT > 1) dma_ktile(lds, P, 1, 1, wid, lane);
    if (NT > 2) dma_ktile(lds, P, 2, 2, wid, lane);
    if (NT > 2) IDX_WAIT_BAR(4); else if (NT > 1) IDX_WAIT_BAR(2); else IDX_WAIT_BAR(0);
    for (int t = 0; t < NT; ++t) {
        const int buf = t & 3;
        if (t + 3 < NT) dma_ktile(lds, P, t + 3, (t + 3) & 3, wid, lane);
        int kb_ = kb0; asm volatile("" : "+v"(kb_));
        const LAS unsigned char* KT = lds + L_KT + buf * 16384 + r * 128;
        if (128 * t + 127 <= 32 * u) score_tile<PASS, true>(lds, KT, kb_, 128 * t, u, wid, r, hh, qmaxw, aq, w, T0, T1);
        else score_tile<PASS, false>(lds, KT, kb_, 128 * t, u, wid, r, hh, qmaxw, aq, w, T0, T1);
        if (t + 3 < NT) IDX_WAIT_BAR(4); else if (t + 2 < NT) IDX_WAIT_BAR(2); else IDX_WAIT_BAR(0);
    }
}
__device__ __forceinline__ void index_phase(Frame& F, const bf16* P, unsigned short* SEL) {
    LAS unsigned char* lds = F.lds; const int wid = F.wave;
    LAS unsigned* hist = (LAS unsigned*)(lds + L_HIST); LAS unsigned short* sel = (LAS unsigned short*)(lds + L_SEL);
    LAS float* cs = (LAS float*)(lds + L_CS); LAS unsigned short* ck = (LAS unsigned short*)(lds + L_CK); LAS int* meta = (LAS int*)(lds + L_META);
    for (int ui = F.vcu; ui < 512; ui += F.G) {
        int tid = F.tid; asm volatile("" : "+v"(tid));
        const int lane = tid & 63, r = lane & 31, hh = lane >> 5;
        const int u = (ui < 256) ? ui : 767 - ui;
        __syncthreads();
        if (u < 8) {
            for (int e = tid; e < 32 * 256; e += 512) { const int q = 32 * u + (e >> 8), jj = e & 255; SEL[(size_t)q * 256 + jj] = (unsigned short)(jj <= q ? jj : 0); }
            continue;
        }
        { v4u z = {0u, 0u, 0u, 0u};
#pragma unroll
            for (int i = 0; i < 8; ++i) *(LAS v4u*)(lds + L_HIST + (tid + 512 * i) * 16) = z;
            if (tid < 128) meta[tid] = 0; }
        bf16x8 aq[2][4]; float w[2][16];
#pragma unroll
        for (int p = 0; p < 2; ++p) { const int qrow = 32 * u + 4 * wid + 2 * p + ((r >> 2) & 1), head = (r & 3) + 4 * (r >> 3);
#pragma unroll
            for (int ks = 0; ks < 4; ++ks) aq[p][ks] = *(const bf16x8*)(P + (size_t)qrow * PITCH + QIOFF + head * 64 + ks * 16 + hh * 8);
            const bf16* wp = P + (size_t)(32 * u + 4 * wid + 2 * p + hh) * PITCH + WIOFF;
            const bf16x8 w0 = *(const bf16x8*)wp, w1 = *(const bf16x8*)(wp + 8);
#pragma unroll
            for (int i = 0; i < 8; ++i) { w[p][i] = bf2f((unsigned short)w0[i]) * 0.125f; w[p][8 + i] = bf2f((unsigned short)w1[i]) * 0.125f; } }
        __syncthreads();
        score_pass<1>(lds, P, u, wid, lane, aq, w, 0, 0);
        LAS int* tmp = (LAS int*)(lds + L_TMP) + wid * 64;
        for (int rr = 0; rr < 4; ++rr) { const int rl = 4 * wid + rr;
            unsigned cw[8]; { const v4u a = *(const LAS v4u*)(hist + rl * 512 + 8 * lane), b = *(const LAS v4u*)(hist + rl * 512 + 8 * lane + 4);
                cw[0] = a.x; cw[1] = a.y; cw[2] = a.z; cw[3] = a.w; cw[4] = b.x; cw[5] = b.y; cw[6] = b.z; cw[7] = b.w; }
            int ls = 0;
#pragma unroll
            for (int i = 0; i < 8; ++i) ls += (int)cw[i];
            int suf = ls;
#pragma unroll
            for (int off = 1; off < 64; off <<= 1) { tmp[lane] = suf; LDS_WAIT(); const int o2 = lane + off; const int v = tmp[o2 < 64 ? o2 : 63]; LDS_WAIT(); suf += (o2 < 64) ? v : 0; }
            const unsigned long long bal = __ballot(suf >= 256);
            const int L = 63 - __builtin_clzll(bal | 1ull);
            if (lane == L) { int cum = suf - ls, T = 8 * L, cab = cum; bool found = false;
#pragma unroll
                for (int bb = 7; bb >= 0; --bb) { const int cnt = (int)cw[bb];
                    if (!found) { if (cum + cnt >= 256) { T = 8 * L + bb; cab = cum; found = true; } else cum += cnt; } }
                meta[64 + rl] = T; meta[96 + rl] = cab; }
            LDS_WAIT(); asm volatile("" ::: "memory"); }
        __syncthreads();
        { v4u z = {0u, 0u, 0u, 0u};
#pragma unroll
            for (int i = 0; i < 2; ++i) *(LAS v4u*)(lds + L_SEL + (tid + 512 * i) * 16) = z; }
        const int T0 = meta[64 + 4 * wid + hh], T1 = meta[64 + 4 * wid + 2 + hh];
        score_pass<2>(lds, P, u, wid, lane, aq, w, T0, T1);
        for (int rr = 0; rr < 4; ++rr) { const int rl = 4 * wid + rr; const int cab = meta[96 + rl], need = 256 - cab; int m = meta[32 + rl]; m = m > NCAND ? NCAND : m;
#pragma unroll
            for (int half = 0; half < 2; ++half) { const int i = lane + 64 * half; const float si = cs[rl * NCAND + i]; const int ki = ck[rl * NCAND + i]; int rank = 0;
                for (int j2 = 0; j2 < m; ++j2) { const float sj = cs[rl * NCAND + j2]; const int kj = ck[rl * NCAND + j2]; rank += (sj > si || (sj == si && kj < ki)) ? 1 : 0; }
                if (i < m && rank < need) sel[rl * 256 + cab + rank] = (unsigned short)ki; }
            LDS_WAIT(); asm volatile("" ::: "memory");
            const v2u o = *(const LAS v2u*)(lds + L_SEL + rl * 512 + lane * 8);
            *(GAS v2u*)(SEL + (size_t)(32 * u + rl) * 256 + 4 * lane) = o; }
#if MK_DUP & 128
        __syncthreads(); score_pass<1>(lds, P, u, wid, lane, aq, w, 0, 0);
#endif
#if MK_DUP & 256
        __syncthreads(); score_pass<2>(lds, P, u, wid, lane, aq, w, T0 + 512, T1 + 512);
#endif
    }
}
constexpr int A_LUT = 0, A_SEL = 8448, A_V = 16384;
__device__ __forceinline__ void attn_phase(Frame& F, const bf16* P, const unsigned short* SEL, bf16* CAT, const float* rel) {
    LAS unsigned char* lds = F.lds; const int tid = F.tid, lane = F.lane, wid = F.wave;
    LAS float* lut = (LAS float*)(lds + A_LUT);
    __syncthreads();
    for (int e = tid; e < 129 * 16; e += 512) lut[e] = rel[REL_BUCKET[e >> 4] * 16 + (e & 15)] * LOG2E;
    __syncthreads();
    LAS unsigned short* sb = (LAS unsigned short*)(lds + A_SEL) + wid * 256; LAS unsigned char* vbuf = lds + A_V + wid * 8192;
    const int c16 = lane & 15, q4 = lane >> 4, qq = c16 >> 2, p4 = c16 & 3;
    const int rho = 4 * q4 + qq, vx0 = rho & 7, vbase = rho * 256 + (p4 & 1) * 8;
    const int gw = F.vcu * NWAVES + wid, NGW = F.G * NWAVES;
    for (int q = gw; q < S; q += NGW) {
        const int count = (q + 1 < 256) ? q + 1 : 256;
        *(LAS v2u*)(sb + 4 * lane) = *(const GAS v2u*)(SEL + (size_t)q * 256 + 4 * lane);
        LDS_WAIT(); asm volatile("" ::: "memory");
        for (int g = 0; g < 4; ++g) {
            const int head = 4 * g + (c16 & 3);
            bf16x8 qb[4];
#pragma unroll
            for (int ks = 0; ks < 4; ++ks) qb[ks] = *(const bf16x8*)(P + (size_t)q * PITCH + head * 128 + q4 * 32 + ks * 8);
            f32x4 s[16];
#pragma unroll
            for (int bt = 0; bt < 4; ++bt) {
                bf16x8 ak[4][4];
#pragma unroll
                for (int b2 = 0; b2 < 4; ++b2) { const int kpos = sb[16 * (4 * bt + b2) + c16]; const bf16* kp = P + (size_t)kpos * PITCH + KOFF + g * 128 + q4 * 32;
#pragma unroll
                    for (int ks = 0; ks < 4; ++ks) ak[b2][ks] = *(const bf16x8*)(kp + ks * 8); }
#pragma unroll
                for (int b2 = 0; b2 < 4; ++b2) { f32x4 a = {0.f, 0.f, 0.f, 0.f};
#pragma unroll
                    for (int ks = 0; ks < 4; ++ks) a = MFMA16(ak[b2][ks], qb[ks], a);
                    s[4 * bt + b2] = a; }
            }
            float mx = -INFINITY;
#pragma unroll
            for (int b = 0; b < 16; ++b) { const v2u kk2 = *(const LAS v2u*)(sb + 16 * b + 4 * q4);
#pragma unroll
                for (int i = 0; i < 4; ++i) { const int jj = 16 * b + 4 * q4 + i; const int kpos = (int)(((i & 2) ? kk2.y : kk2.x) >> ((i & 1) * 16)) & 0xffff;
                    int dist = q - kpos; dist = dist < 0 ? 0 : (dist > 128 ? 128 : dist);
                    (void)jj; s[b][i] += lut[dist * 16 + head]; } }
            if (count < 256) {
                int cnt = count - 4 * q4; asm volatile("" : "+v"(cnt));
#pragma unroll
                for (int b = 0; b < 16; ++b)
#pragma unroll
                    for (int i = 0; i < 4; ++i) if (16 * b + i >= cnt) s[b][i] = -INFINITY; }
#pragma unroll
            for (int b = 0; b < 16; ++b)
#pragma unroll
                for (int i = 0; i < 4; ++i) mx = fmaxf(mx, s[b][i]);
            mx = fmaxf(mx, swz_xor<16>(mx)); mx = max32(mx);
            float sum = 0.f;
#pragma unroll
            for (int b = 0; b < 16; ++b)
#pragma unroll
                for (int i = 0; i < 4; ++i) { const float pv = __builtin_amdgcn_exp2f(s[b][i] - mx); s[b][i] = pv; sum += pv; }
            sum += swz_xor<16>(sum); sum = sum32(sum);
            bf16x8 pb[8];
#pragma unroll
            for (int kk = 0; kk < 8; ++kk) { v4u wv; wv.x = cvtpk(s[2 * kk][0], s[2 * kk][1]); wv.y = cvtpk(s[2 * kk][2], s[2 * kk][3]); wv.z = cvtpk(s[2 * kk + 1][0], s[2 * kk + 1][1]); wv.w = cvtpk(s[2 * kk + 1][2], s[2 * kk + 1][3]);
                pb[kk] = __builtin_bit_cast(bf16x8, wv); }
            f32x4 O[8];
#pragma unroll
            for (int db = 0; db < 8; ++db) O[db] = (f32x4){0.f, 0.f, 0.f, 0.f};
#pragma unroll
            for (int kk = 0; kk < 8; ++kk) {
                LDS_WAIT();
#pragma unroll
                for (int pi = 0; pi < 8; ++pi) { const int row = 4 * pi + (lane >> 4), pc = lane & 15, c = pc ^ (2 * (row & 7)); const int kpos = sb[32 * kk + row];
                    __builtin_amdgcn_global_load_lds((const unsigned*)(P + (size_t)kpos * PITCH + VOFF + g * 128 + c * 8), (LAS unsigned*)(vbuf + pi * 1024), 16, 0, 0); }
                VM_WAIT();
                int vx = vx0; asm volatile("" : "+v"(vx));
#pragma unroll
                for (int db = 0; db < 8; ++db) { const LAS unsigned char* a0 = vbuf + vbase + (((((db ^ vx) << 1) | (p4 >> 1))) << 4);
                    const s16x4 lo = vtr(a0), hi = vtr(a0 + 4096);
                    const bf16x8 vf = (bf16x8){lo[0], lo[1], lo[2], lo[3], hi[0], hi[1], hi[2], hi[3]};
                    O[db] = MFMA16(vf, pb[kk], O[db]); }
            }
            if (c16 < 4) { const float inv = 1.0f / sum; GAS bf16* op = (GAS bf16*)CAT + (size_t)q * D + head * 128 + 4 * q4;
#pragma unroll
                for (int db = 0; db < 8; ++db) { v2u wv; wv.x = cvtpk(O[db][0] * inv, O[db][1] * inv); wv.y = cvtpk(O[db][2] * inv, O[db][3] * inv); *(GAS v2u*)(op + 16 * db) = wv; } }
        }
    }
}
}


struct Args;
__device__ __forceinline__ const float* in_ptr(const Args& a, int i);
struct Args { const float* in[19]; float* out; unsigned char* ws; int ph_lo, ph_hi; };
__device__ __forceinline__ const float* in_ptr(const Args& a, int i) { (void)a; extern __shared__ __attribute__((aligned(16))) unsigned char lds_all[];
    const unsigned long long v = ((const LAS unsigned long long*)((LAS unsigned char*)lds_all + INP_OFF))[i];
    const unsigned lo = __builtin_amdgcn_readfirstlane((unsigned)v), hi = __builtin_amdgcn_readfirstlane((unsigned)(v >> 32));
    return (const float*)(((unsigned long long)hi << 32) | lo); }
constexpr int N_PHASES = 45 + ((MK_DUP & 4) ? 2 : 0) + ((MK_DUP & 8) ? 2 : 0) + ((MK_DUP & 64) ? 8 : 0) + ((MK_DUP & 16) ? 1 : 0) + ((MK_DUP & 1) ? 2 : 0) + ((MK_DUP & 2) ? 2 : 0) + ((MK_DUP & 32) ? 8 : 0);
typedef pg8::StaticOrder SOrd;
#define GEMM_PHASE(EPI, g, E) do { int bx_ = (int)blockIdx.x, G_ = F.G; asm volatile("" : "+s"(bx_), "+s"(G_));   \
    SOrd S_; S_.init((g).M, (g).N, G_, bx_); pg8::gemm_phase<EPI, SOrd, true, true>(F.lds, (g), S_, (E)); } while (0)

__global__ void __launch_bounds__(NWAVES * 64, 2) fwd_kernel(Args args) {
    extern __shared__ __attribute__((aligned(16))) unsigned char lds[];
    Frame F;
    F.lds = (LAS unsigned char*)lds;
    F.tid = threadIdx.x; F.lane = F.tid & 63; F.wave = __builtin_amdgcn_readfirstlane(F.tid >> 6);
    F.G = gridDim.x; { const int bx = blockIdx.x; F.vcu = (F.G % 8 == 0) ? (bx % 8) * (F.G / 8) + bx / 8 : bx; }
    volatile LAS unsigned* MISC = (volatile LAS unsigned*)(F.lds + MISC_OFF);
    if (F.tid < 64) MISC[F.tid] = 0u;
    if (F.tid == 0) { LAS unsigned long long* ip = (LAS unsigned long long*)(F.lds + INP_OFF);
#pragma unroll
        for (int i = 0; i < 19; ++i) ip[i] = (unsigned long long)args.in[i]; }
    __syncthreads();
    const int lo = args.ph_lo, hi = args.ph_hi;
    XcdBarrier bar; bar.bar = (unsigned*)(args.ws + WS_CTL) + CW_BAR; bar.x = 0; bar.st = nullptr;
    if (hi - lo > 1) bar = xcd_barrier_post((unsigned*)(args.ws + WS_CTL) + CW_BAR, MISC + 8, F.wave);
    int ph = 0;
#define RUN() (lo <= ph && ph < hi)
#define SEAM() do { if (lo <= ph && ph + 1 < hi) { XcdBarrier b_ = bar; asm volatile("" : "+s"(b_.bar), "+s"(b_.x));   xcd_barrier(b_, F.wave); } ++ph; } while (0)

#define WSP() unsigned char* ws = args.ws; asm volatile("" : "+s"(ws)); \
    { int t_ = threadIdx.x; asm volatile("" : "+v"(t_)); F.tid = t_; F.lane = t_ & 63; }     \
    float* XRES = (float*)(ws + WS_XRES); bf16* XN = (bf16*)(ws + WS_XN); bf16* H = (bf16*)(ws + WS_H); bf16* PROJ = (bf16*)(ws + WS_PROJ); bf16* CAT = (bf16*)(ws + WS_CAT); \
    const float* NA = (const float*)(ws + WS_VEC); const float* NB = NA + 12 * 2048; const float* GT = NB + 12 * 2048; \
    (void)XRES; (void)XN; (void)H; (void)PROJ; (void)CAT; (void)NA; (void)NB; (void)GT;
#define INP(i) in_ptr(args, (i))

    if (RUN()) { WSP(); prologue_phase(F, args, ws); }
#if MK_DUP & 16
    SEAM(); if (RUN()) { WSP(); prologue_phase(F, args, ws); }
#endif
    SEAM();
    if (RUN()) { WSP(); vec_phase(F, args, ws); }
    SEAM();

    for (int s = 0; s < 8; ++s) {
        asm volatile("" : "+s"(F.wave), "+s"(F.vcu), "+s"(F.G));
        const int l = s >> 1, f = s & 1, jn = f ? 2 : 0;
        if (RUN()) { WSP(); const float* xsrc = (s == 0) ? INP(0) : XRES; norm_phase(F, xsrc, NA + (l * 3 + jn) * 2048, NB + (l * 3 + jn) * 2048, XN); }
        SEAM();
#if MK_DUP & 32
        if (RUN()) { WSP(); const float* xsrc = (s == 0) ? INP(0) : XRES; norm_phase(F, xsrc, NA + (l * 3 + jn) * 2048, NB + (l * 3 + jn) * 2048, XN); }
        SEAM();
#endif
        if (RUN()) { WSP(); pg8::Gemm g{XN, (const bf16*)(ws + WS_W1T) + (size_t)s * W1T_SZ, S, 2 * DFF, D}; pg8::EpiSwiglu E{H, DFF}; GEMM_PHASE(pg8::EpiSwiglu, g, E); }
        SEAM();
#if MK_DUP & 64
        if (RUN()) { WSP(); pg8::Gemm g{XN, (const bf16*)(ws + WS_W1T) + (size_t)s * W1T_SZ, S, 2 * DFF, D}; pg8::EpiSwiglu E{H, DFF}; GEMM_PHASE(pg8::EpiSwiglu, g, E); }
        SEAM();
#endif
        if (RUN()) { WSP(); const float* xsrc = (s == 0) ? INP(0) : XRES; pg8::Gemm g{H, (const bf16*)(ws + WS_W2T) + (size_t)s * W2T_SZ, S, D, DFF}; pg8::EpiResid E{xsrc, XRES, GT + (l * 3 + jn) * 2048, D}; GEMM_PHASE(pg8::EpiResid, g, E); }
        SEAM();
        if (f == 0) {
            if (RUN()) { WSP(); norm_phase(F, XRES, NA + (l * 3 + 1) * 2048, NB + (l * 3 + 1) * 2048, XN); }
            SEAM();
            const int j = l >> 1;
            if ((l & 1) == 0) {
                if (RUN()) { WSP(); pg8::Gemm g{XN, (const bf16*)(ws + WS_ABIN) + (size_t)j * ABIN_SZ, S, ABN, D}; pg8::EpiProj E{PROJ, ABN, 4, da::C2, 12}; GEMM_PHASE(pg8::EpiProj, g, E); }
                SEAM();
                if (RUN()) {
#if MK_AB
                    WSP();
                    const float* lp = INP(10) + j * 256;
                    const float s01 = wave_sum(lp[F.lane] * lp[64 + F.lane]), s23 = wave_sum(lp[128 + F.lane] * lp[192 + F.lane]);
                    const float lam_init = (j == 0) ? 0.2f : 0.4707130183435842f;
                    const float lam = expf(s01) - expf(s23) + lam_init;
                    for (int ui = F.vcu; ui < 1024; ui += F.G) { const int v = ui & 255, k = ui >> 8, h = v >> 5, p = v & 31;
                        const int qb = (k == 0) ? p : (k == 1) ? 127 - p : (k == 2) ? 63 - p : 64 + p;
                        da::unit(F.tid, F.lds, PROJ, CAT, h, qb, lam, 1.0f - lam_init, INP(11) + j * 128, INP(7)); }
                    for (int ui = F.vcu; ui < 1024; ui += F.G)
                        sgp::unit(F.tid, F.lds, PROJ, CAT, ui >> 3, ui & 7, INP(12) + j * 1024, INP(13) + j * 1024, INP(14) + (size_t)j * 8 * 128 * 128, INP(15) + j * 8 * 128);
#endif
                }
                SEAM();
#if MK_DUP & 2
                if (RUN()) { WSP();
                    for (int ui = F.vcu; ui < 1024; ui += F.G)
                        sgp::unit(F.tid, F.lds, PROJ, CAT, ui >> 3, ui & 7, INP(12) + j * 1024, INP(13) + j * 1024, INP(14) + (size_t)j * 8 * 128 * 128, INP(15) + j * 8 * 128); }
                SEAM();
#endif
#if MK_DUP & 1
                if (RUN()) {
#if MK_AB
                    WSP();
                    const float* lp = INP(10) + j * 256;
                    const float s01 = wave_sum(lp[F.lane] * lp[64 + F.lane]), s23 = wave_sum(lp[128 + F.lane] * lp[192 + F.lane]);
                    const float lam_init = (j == 0) ? 0.2f : 0.4707130183435842f;
                    const float lam = expf(s01) - expf(s23) + lam_init;
                    for (int ui = F.vcu; ui < 1024; ui += F.G) { const int v = ui & 255, k = ui >> 8, h = v >> 5, p = v & 31;
                        const int qb = (k == 0) ? p : (k == 1) ? 127 - p : (k == 2) ? 63 - p : 64 + p;
                        da::unit(F.tid, F.lds, PROJ, CAT, h, qb, lam, 1.0f - lam_init, INP(11) + j * 128, INP(7)); }
                    for (int ui = F.vcu; ui < 1024; ui += F.G)
                        sgp::unit(F.tid, F.lds, PROJ, CAT, ui >> 3, ui & 7, INP(12) + j * 1024, INP(13) + j * 1024, INP(14) + (size_t)j * 8 * 128 * 128, INP(15) + j * 8 * 128);
#endif
                }
                SEAM();
#endif
                if (RUN()) {
#if MK_AB
                    WSP(); pg8::Gemm g{CAT, (const bf16*)(ws + WS_ABOUT) + (size_t)j * SQ_SZ, S, D, D}; pg8::EpiResid E{XRES, XRES, GT + (l * 3 + 1) * 2048, D}; GEMM_PHASE(pg8::EpiResid, g, E);
#endif
                }
                SEAM();
            } else {
                if (RUN()) {
#if MK_DSA
                    WSP(); pg8::Gemm g{XN, (const bf16*)(ws + WS_DSAIN) + (size_t)j * DSAIN_SZ, S, CINP, D}; pg8::EpiProj E{PROJ, CINP, 8, dsa::CQ, 1000}; GEMM_PHASE(pg8::EpiProj, g, E);
#endif
                }
                SEAM();
                if (RUN()) {
#if MK_DSA
                    WSP(); dsa::index_phase(F, PROJ, (unsigned short*)(ws + WS_SEL));
#endif
                }
                SEAM();
#if MK_DUP & 4
                if (RUN()) { WSP(); dsa::index_phase(F, PROJ, (unsigned short*)(ws + WS_SEL)); }
                SEAM();
#endif
                if (RUN()) {
#if MK_DSA
                    WSP(); dsa::attn_phase(F, PROJ, (const unsigned short*)(ws + WS_SEL), CAT, INP(7));
#endif
                }
                SEAM();
#if MK_DUP & 8
                if (RUN()) { WSP(); dsa::attn_phase(F, PROJ, (const unsigned short*)(ws + WS_SEL), CAT, INP(7)); }
                SEAM();
#endif
                if (RUN()) {
#if MK_DSA
                    WSP(); pg8::Gemm g{CAT, (const bf16*)(ws + WS_DSAOUT) + (size_t)j * SQ_SZ, S, D, D}; pg8::EpiResid E{XRES, XRES, GT + (l * 3 + 1) * 2048, D}; GEMM_PHASE(pg8::EpiResid, g, E);
#endif
                }
                SEAM();
            }
        }
    }
    if (RUN()) { WSP(); final_norm_phase(F, XRES, INP(18), args.out); }
    ++ph;
#undef RUN
#undef SEAM
}


#if MK_DIAG
__device__ const int DG_ROWS[16] = {0, 129, 255, 256, 1000, 2500, 4097, 6000, 8191, 8192, 9500, 10000, 11111, 12287, 12345, 16383};
__device__ __forceinline__ void dg_max(unsigned* slot, float e) { if (!(e >= 0.f)) e = 1e9f; atomicMax(slot, __builtin_bit_cast(unsigned, e)); }
constexpr int DG_SLOT = 2048;
__global__ void __launch_bounds__(512) diag_check(Args args, int which, int j) {
    extern __shared__ __attribute__((aligned(16))) unsigned char lds[];
    unsigned char* ws = args.ws; unsigned* slot = (unsigned*)(ws + WS_CTL) + DG_SLOT;
    const float* NA = (const float*)(ws + WS_VEC); const float* NB = NA + 12 * 2048; const float* GT = NB + 12 * 2048;
    const bf16* XN = (const bf16*)(ws + WS_XN); const bf16* H = (const bf16*)(ws + WS_H); const float* XRES = (const float*)(ws + WS_XRES);
    const bf16* PROJ = (const bf16*)(ws + WS_PROJ); const bf16* CAT = (const bf16*)(ws + WS_CAT);
    const int tid = threadIdx.x; float* fl = (float*)lds;
    const int row = DG_ROWS[blockIdx.x & 15]; const int sub = blockIdx.x >> 4;
    float err = 0.f;
    if (which == 1) {
        const float* x = args.in[0] + (size_t)row * D; float ss = 0.f;
        for (int c = 0; c < D; ++c) ss += x[c] * x[c];
        const float rstd = 1.0f / sqrtf(ss / D + EPS);
        for (int c = tid; c < D; c += 512) err = fmaxf(err, fabsf(x[c] * rstd * NA[c] + NB[c] - bf2f(XN[(size_t)row * D + c])));
    } else if (which == 2) {
        const float* w1 = args.in[5] + (size_t)j * D * 2 * DFF;
        for (int c = tid; c < DFF; c += 512) { float g = 0.f, u = 0.f;
            for (int k = 0; k < D; ++k) { const float a = bf2f(XN[(size_t)row * D + k]); g += a * w1[(size_t)k * 2 * DFF + c]; u += a * w1[(size_t)k * 2 * DFF + DFF + c]; }
            const float ref = g / (1.0f + expf(-g)) * u; err = fmaxf(err, fabsf(ref - bf2f(H[(size_t)row * DFF + c]))); }
    } else if (which == 3) {
        const float* w2 = args.in[6] + (size_t)j * DFF * D; const float* x = (j == 0) ? args.in[0] : (const float*)(ws + WS_END);
        const float* gt = GT + ((j >> 1) * 3 + ((j & 1) ? 2 : 0)) * 2048;
        for (int c = tid; c < D; c += 512) { float a = 0.f;
            for (int k = 0; k < DFF; ++k) a += bf2f(H[(size_t)row * DFF + k]) * w2[(size_t)k * D + c];
            err = fmaxf(err, fabsf(x[(size_t)row * D + c] + gt[c] * a - XRES[(size_t)row * D + c])); }
    } else if (which == 4) {
        const float* w = args.in[8] + (size_t)j * D * ABN;
        for (int c = tid; c < ABN; c += 512) { float a = 0.f;
            for (int k = 0; k < D; ++k) a += bf2f(XN[(size_t)row * D + k]) * w[(size_t)k * ABN + c];
            if (c < 1024) a *= da::C2; if (c >= 3072) a = 0.5f * a * (1.0f + tanhf(0.7978845608028654f * (a + 0.044715f * a * a * a)));
            err = fmaxf(err, fabsf(a - bf2f(PROJ[(size_t)row * ABN + c]))); }
    } else if (which == 5) {
        const int h = sub;
        const float* lp = args.in[10] + j * 256; float s01 = 0.f, s23 = 0.f;
        for (int i = 0; i < 64; ++i) { s01 += lp[i] * lp[64 + i]; s23 += lp[128 + i] * lp[192 + i]; }
        const float lam_init = 0.8f - 0.6f * expf(-0.3f * (2 * j)), lam = expf(s01) - expf(s23) + lam_init;
        float* lg = fl;
        float* red = fl + 2 * 16384;
        for (int m = 0; m < 2; ++m) {
            for (int key = tid; key <= row; key += 512) { float a = 0.f;
                for (int d = 0; d < 64; ++d) a += bf2f(PROJ[(size_t)row * ABN + h * 128 + m * 64 + d]) * bf2f(PROJ[(size_t)key * ABN + 1024 + h * 128 + m * 64 + d]);
                const int dist = row - key; a += args.in[7][REL_BUCKET[dist > 128 ? 128 : dist] * 16 + h * 2 + m] * LOG2E; lg[m * 16384 + key] = a; }
        }
        __syncthreads();
        float mx[2], sm[2];
        for (int m = 0; m < 2; ++m) { float v = -INFINITY; for (int key = tid; key <= row; key += 512) v = fmaxf(v, lg[m * 16384 + key]);
            red[tid] = v; __syncthreads(); if (tid == 0) { float t = -INFINITY; for (int i = 0; i < 512; ++i) t = fmaxf(t, red[i]); red[512] = t; } __syncthreads(); mx[m] = red[512]; __syncthreads();
            float s = 0.f; for (int key = tid; key <= row; key += 512) s += exp2f(lg[m * 16384 + key] - mx[m]);
            red[tid] = s; __syncthreads(); if (tid == 0) { float t = 0.f; for (int i = 0; i < 512; ++i) t += red[i]; red[512] = t; } __syncthreads(); sm[m] = red[512]; __syncthreads(); }
        const int e = tid & 127, part = tid >> 7; float o = 0.f;
        for (int key = part; key <= row; key += 4) { const float p = exp2f(lg[key] - mx[0]) / sm[0] - lam * exp2f(lg[16384 + key] - mx[1]) / sm[1]; o += p * bf2f(PROJ[(size_t)key * ABN + 2048 + h * 128 + e]); }
        red[tid] = o; __syncthreads();
        if (tid < 128) { o = red[tid] + red[128 + tid] + red[256 + tid] + red[384 + tid]; red[512 + tid] = o * o; red[tid] = o; } __syncthreads();
        if (tid == 0) { float t = 0.f; for (int i = 0; i < 128; ++i) t += red[512 + i]; red[700] = t; } __syncthreads();
        if (tid < 128) { const float ref = red[tid] / sqrtf(red[700] / 128.0f + EPS) * args.in[11][j * 128 + tid] * (1.0f - lam_init);
            err = fabsf(ref - bf2f(CAT[(size_t)row * D + h * 128 + tid])); }
    } else if (which == 7) {
        const float* w2 = args.in[6]; const float* x = args.in[0]; const float* wo = args.in[9] + (size_t)j * D * D;
        for (int c = tid; c < D; c += 512) { float a = 0.f, b = 0.f;
            for (int k = 0; k < DFF; ++k) a += bf2f(H[(size_t)row * DFF + k]) * w2[(size_t)k * D + c];
            for (int k = 0; k < D; ++k) b += bf2f(CAT[(size_t)row * D + k]) * wo[(size_t)k * D + c];
            err = fmaxf(err, fabsf(x[(size_t)row * D + c] + GT[c] * a + GT[2048 + c] * b - XRES[(size_t)row * D + c])); }
    } else if (which == 8) {
        const int lj = sub, l = lj / 3, jj = lj % 3;
        if (tid < 8) { const int col = (DG_ROWS[blockIdx.x & 15] + 257 * tid) & 2047; float mv[3];
            for (int t = 0; t < 3; ++t) { const int n = (3 * jj + t) * 2048 + col; float a = args.in[4][l * NMODV + n];
                for (int k = 0; k < 2048; ++k) { const float cv = args.in[1][k]; a += cv / (1.0f + expf(-cv)) * args.in[3][((size_t)l * 2048 + k) * NMODV + n]; } mv[t] = a; }
            err = fmaxf(fabsf(args.in[2][lj * 2048 + col] * (1.0f + mv[1]) - NA[lj * 2048 + col]), fabsf(mv[0] - NB[lj * 2048 + col]));
            err = fmaxf(err, fabsf((jj == 1 ? 1.0f : 0.5f) * (1.0f + mv[2]) - GT[lj * 2048 + col])); }
    } else if (which == 9) {
        const float* x = XRES + (size_t)row * D; float ss = 0.f;
        for (int c = 0; c < D; ++c) ss += x[c] * x[c];
        const float rstd = 1.0f / sqrtf(ss / D + EPS);
        for (int c = tid; c < D; c += 512) err = fmaxf(err, fabsf(x[c] * rstd * args.in[18][c] - args.out[(size_t)row * D + c]));
    } else if (which == 6) {
        const int n = row >> 7, t = row & 127; float* st = fl;
        for (int s = tid; s <= t; s += 512) { const bf16* z = PROJ + (size_t)(n * 128 + s) * ABN + 4096; float m = 0.f; for (int c = 0; c < 1024; ++c) m += bf2f(z[c]); m /= 1024.0f;
            float q = 0.f; for (int c = 0; c < 1024; ++c) { const float d = bf2f(z[c]) - m; q += d * d; } st[2 * s] = m; st[2 * s + 1] = 1.0f / sqrtf(q / 1024.0f + EPS); }
        __syncthreads();
        for (int c = tid; c < 1024; c += 512) { const int g = c >> 7; float a = 0.f;
            for (int s = 0; s <= t; ++s) { const float zn = (bf2f(PROJ[(size_t)(n * 128 + s) * ABN + 4096 + c]) - st[2 * s]) * st[2 * s + 1] * args.in[12][j * 1024 + c] + args.in[13][j * 1024 + c];
                a += args.in[14][(((size_t)j * 8 + g) * 128 + t) * 128 + s] * zn; }
            a += args.in[15][(j * 8 + g) * 128 + t];
            const float ref = bf2f(PROJ[(size_t)row * ABN + 3072 + c]) * a; err = fmaxf(err, fabsf(ref - bf2f(CAT[(size_t)row * D + 1024 + c]))); }
    }
    dg_max(slot, err);
}
__global__ void diag_out(Args args) {
    const size_t i = (size_t)blockIdx.x * 256 + threadIdx.x; const unsigned* slot = (const unsigned*)(args.ws + WS_CTL) + DG_SLOT;
    if (i < (size_t)S * D) args.out[i] = (i == 0) ? 10.0f + 1.0e4f * __builtin_bit_cast(float, slot[0]) : 0.f;
}
#endif

extern "C" void kernel_launch(void* const* d_in, const int* in_sizes, int n_in, void* d_out, int out_size, void* d_ws, size_t ws_size, hipStream_t stream) {
    static int grid = 0;
    if (grid == 0) {
        if (n_in != 19 || in_sizes[0] != S * D || out_size != S * D || ws_size < WS_END) { fprintf(stderr, "kernel_launch: unexpected shapes (n_in %d, in0 %d, out %d, ws %zu); nothing launched\n", n_in, n_in > 0 ? in_sizes[0] : -1, out_size, ws_size); grid = -1; return; }
        int dev = 0, cus = 0, per_cu = 0;
        if (hipGetDevice(&dev) != hipSuccess || hipDeviceGetAttribute(&cus, hipDeviceAttributeMultiprocessorCount, dev) != hipSuccess) { grid = -1; return; }
        if (hipFuncSetAttribute((const void*)fwd_kernel, hipFuncAttributeMaxDynamicSharedMemorySize, LDS_BYTES) != hipSuccess) { fprintf(stderr, "kernel_launch: hipFuncSetAttribute failed\n"); grid = -1; return; }
        if (hipOccupancyMaxActiveBlocksPerMultiprocessor(&per_cu, (const void*)fwd_kernel, NWAVES * 64, LDS_BYTES) != hipSuccess || per_cu < 1)
            fprintf(stderr, "kernel_launch: note: occupancy query reports %d workgroups per CU\n", per_cu);
        (void)hipGetLastError();
        grid = cus;
    }
    if (grid < 0) return;
    if (hipMemsetAsync((char*)d_ws + WS_CTL, 0, CTL_ZERO_BYTES, stream) != hipSuccess) return;
    Args a{};
    for (int i = 0; i < 19; ++i) a.in[i] = (const float*)d_in[i];
    a.out = (float*)d_out; a.ws = (unsigned char*)d_ws;
#if MK_DIAG == 99
    {
        hipFuncSetAttribute((const void*)diag_check, hipFuncAttributeMaxDynamicSharedMemorySize, 143360);
        const int up_ph[8] = {3, 10, 13, 21, 24, 31, 34, 42}; int done = -1;
        for (int s = 1; s < 8; ++s) {
            for (int p = done + 1; p <= up_ph[s]; ++p) { a.ph_lo = p; a.ph_hi = p + 1; hipLaunchKernelGGL(fwd_kernel, dim3(grid), dim3(NWAVES * 64), LDS_BYTES, stream, a); }
            if (s == 1) hipLaunchKernelGGL(diag_check, dim3(16 * 12), dim3(512), 143360, stream, a, 8, 0);
            hipLaunchKernelGGL(diag_check, dim3(16), dim3(512), 143360, stream, a, 2, s);
            hipMemcpyAsync((char*)d_ws + WS_END, (char*)d_ws + WS_XRES, (size_t)S * D * 4, hipMemcpyDeviceToDevice, stream);
            a.ph_lo = up_ph[s] + 1; a.ph_hi = up_ph[s] + 2; hipLaunchKernelGGL(fwd_kernel, dim3(grid), dim3(NWAVES * 64), LDS_BYTES, stream, a);
            done = up_ph[s] + 1;
            hipLaunchKernelGGL(diag_check, dim3(16), dim3(512), 143360, stream, a, 3, s);
        }
        for (int p = done + 1; p < N_PHASES; ++p) { a.ph_lo = p; a.ph_hi = p + 1; hipLaunchKernelGGL(fwd_kernel, dim3(grid), dim3(NWAVES * 64), LDS_BYTES, stream, a); }
        hipLaunchKernelGGL(diag_check, dim3(16), dim3(512), 143360, stream, a, 9, 0);
        hipLaunchKernelGGL(diag_out, dim3((S * D + 255) / 256), dim3(256), 0, stream, a);
        return;
    }
#elif MK_DIAG
    {
        int digits[8], nd = 0; for (int v = MK_DIAG; v > 0; v /= 10) digits[nd++] = v % 10;
        hipFuncSetAttribute((const void*)diag_check, hipFuncAttributeMaxDynamicSharedMemorySize, 143360);
        int done = -1;
        for (int stage = 0; stage < 3; ++stage) {
            const int upto = ((stage == 0) ? 4 : (stage == 1) ? 7 : 8) + (MK_DIAGJ ? 21 : 0); bool any = false;
            for (int i = 0; i < nd; ++i) { const int w = digits[i]; const int st = (w <= 3) ? 0 : (w <= 6) ? 1 : 2; any |= (st == stage); }
            if (!any) continue;
            for (int p = done + 1; p <= upto; ++p) { a.ph_lo = p; a.ph_hi = p + 1; hipLaunchKernelGGL(fwd_kernel, dim3(grid), dim3(NWAVES * 64), LDS_BYTES, stream, a); }
            done = upto;
            for (int i = 0; i < nd; ++i) { const int w = digits[i]; const int st = (w <= 3) ? 0 : (w <= 6) ? 1 : 2; if (st == stage) hipLaunchKernelGGL(diag_check, dim3(w == 5 ? 128 : 16), dim3(512), 143360, stream, a, w, MK_DIAGJ); }
        }
        hipLaunchKernelGGL(diag_out, dim3((S * D + 255) / 256), dim3(256), 0, stream, a);
        return;
    }
#endif
#if MK_MULTI
    for (int p = 0; p < N_PHASES; ++p) { a.ph_lo = p; a.ph_hi = p + 1; hipLaunchKernelGGL(fwd_kernel, dim3(grid), dim3(NWAVES * 64), LDS_BYTES, stream, a); }
#else
    a.ph_lo = 0; a.ph_hi = N_PHASES;
    hipLaunchKernelGGL(fwd_kernel, dim3(grid), dim3(NWAVES * 64), LDS_BYTES, stream, a);
#endif
    const hipError_t le = hipPeekAtLastError();
    if (le != hipSuccess) fprintf(stderr, "kernel_launch: launch failed: %s\n", hipGetErrorName(le));
}
```

```cpp
#define MK_MULTI 0
#define MK_AB 1
#define MK_DSA 1
#include <hip/hip_runtime.h>
#include <cstdio>
#include <cstdint>
#ifndef MK_DIAG
#define MK_DIAG 0
#endif
#ifndef MK_DIAGJ
#define MK_DIAGJ 0
#endif
#ifndef MK_DUP
#define MK_DUP 0
#endif
#ifndef MK_SP2
#define MK_SP2 true
#endif
#ifndef MK_ALIGN
#define MK_ALIGN true
#endif
#ifndef MK_WGM_UP
#define MK_WGM_UP 4
#endif
#ifndef MK_WGM_DN
#define MK_WGM_DN 2
#endif
#ifndef MK_WGM_IN
#define MK_WGM_IN 4
#endif
#ifndef MK_WGM_OUT
#define MK_WGM_OUT 4
#endif
#ifndef MK_MULTI
#define MK_MULTI 0
#endif

namespace pg8 {
#define PG8_LAS __attribute__((address_space(3)))
typedef unsigned short bf16_t;
typedef short bf16x8 __attribute__((ext_vector_type(8)));
typedef float f32x4 __attribute__((ext_vector_type(4)));
typedef unsigned u32x4 __attribute__((ext_vector_type(4)));
constexpr int BM = 256, BK = 64, HALF = 128, HTB = HALF * BK * 2  , STAGE_BYTES = 8 * HTB, NXCD = 8;

__host__ __device__ __forceinline__ int lds_byte(int r, int c) { const int st = (r >> 4) * 2 + (c >> 5), rr = r & 15, cc = c & 31, ob = rr * 64 + cc * 2; return st * 1024 + (ob ^ (((ob >> 9) & 1) << 5)); }
__host__ __device__ __forceinline__ void stage_rc(int b, int& R, int& C) { const int st = b / 1024, sb = b % 1024, swz = sb ^ (((sb >> 9) & 1) << 5); R = (st >> 1) * 16 + swz / 64; C = (st & 1) * 32 + (swz % 64) / 2; }
__host__ __device__ __forceinline__ int perm32(int rho) { const int n = rho >> 4, i = rho & 15; return 8 * (i >> 2) + 4 * n + (i & 3); }

struct Unit { int pm, pn; };
struct Gemm { const bf16_t* A; const bf16_t* Bt; int M, N, K; int atile; };

struct StaticOrder {
    int nM, nN, nwg, G, c, WGM;
    __host__ __device__ void init(int M, int N, int G_, int c_, int wgm) { nM = M / BM; nN = N / BM; nwg = nM * nN; G = G_; c = c_; WGM = wgm; }
    __host__ __device__ bool next(int i, Unit& u) const {
        const long L = (long)i * G + c; if (L >= nwg) return false;
        int wgid = (int)L; { const int q = nwg / NXCD, r = nwg % NXCD, xcd = wgid % NXCD, off = wgid / NXCD; wgid = (xcd < r ? xcd * (q + 1) : r * (q + 1) + (xcd - r) * q) + off; }
        const int nig = WGM * nN, gid = wgid / nig, fm = gid * WGM, gsz = (nM - fm) < WGM ? (nM - fm) : WGM;
        u.pm = fm + ((wgid % nig) % gsz); u.pn = (wgid % nig) / gsz; return true;
    }
    __device__ __forceinline__ void a_ready(const Unit&) const {}
    __device__ __forceinline__ void done(const Unit&) const {}
};

__device__ __forceinline__ unsigned cvt_pk_bf16(float lo, float hi) { unsigned r; asm volatile("v_cvt_pk_bf16_f32 %0, %1, %2" : "=v"(r) : "v"(lo), "v"(hi)); return r; }
typedef float f32x2 __attribute__((ext_vector_type(2)));

__device__ __forceinline__ float fast_sigmoid(float x) { return __builtin_amdgcn_rcpf(1.0f + __builtin_amdgcn_exp2f(-1.4426950408889634f * x)); }
struct EpiSwiglu {
    static constexpr bool PERM = true, AFTER_DRAIN = false;
    bf16_t* O; int ldc;
    __device__ __forceinline__ void operator()(const f32x4 (&acc)[2][2][4][2], const Unit& u, int wr, int wc, int fr, int fq) const {
        const int rl0 = wr * 64 + fr, col0 = u.pn * HALF + wc * 32 + 8 * fq, kt = col0 >> 6, c = col0 & 63;
        bf16_t* tile = O + ((size_t)u.pm * (ldc >> 6) + kt) * (BM * BK) + c;
#pragma unroll
        for (int ai = 0; ai < 2; ++ai)
#pragma unroll
            for (int m = 0; m < 4; ++m) { bf16_t* rowp = tile + (size_t)(rl0 + ai * HALF + m * 16) * BK;
                const f32x4 g0 = acc[ai][0][m][0], g1 = acc[ai][0][m][1], u0 = acc[ai][1][m][0], u1 = acc[ai][1][m][1];
                float v[8];
#pragma unroll
                for (int j = 0; j < 4; ++j) { v[j] = g0[j] * fast_sigmoid(g0[j]) * u0[j]; v[4 + j] = g1[j] * fast_sigmoid(g1[j]) * u1[j]; }
                u32x4 w; w.x = cvt_pk_bf16(v[0], v[1]); w.y = cvt_pk_bf16(v[2], v[3]); w.z = cvt_pk_bf16(v[4], v[5]); w.w = cvt_pk_bf16(v[6], v[7]);
                *(u32x4*)rowp = w; }
    }
};
struct EpiResid {
    static constexpr bool PERM = false, AFTER_DRAIN = false;
    const float* base; float* out; const float* coef; int ldc;
    __device__ __forceinline__ void operator()(const f32x4 (&acc)[2][2][4][2], const Unit& u, int wr, int wc, int fr, int fq) const {
        const int row0 = u.pm * BM + wr * 64 + fr, col0 = u.pn * BM + wc * 32 + 4 * fq;
        f32x4 cv[2][2];
#pragma unroll
        for (int bj = 0; bj < 2; ++bj)
#pragma unroll
            for (int n = 0; n < 2; ++n) cv[bj][n] = *(const f32x4*)(coef + col0 + bj * HALF + n * 16);
#pragma unroll
        for (int ai = 0; ai < 2; ++ai)
#pragma unroll
            for (int m = 0; m < 4; ++m) { const size_t off = (size_t)(row0 + ai * HALF + m * 16) * ldc + col0;
#pragma unroll
                for (int bj = 0; bj < 2; ++bj)
#pragma unroll
                    for (int n = 0; n < 2; ++n) { const f32x4 b = *(const f32x4*)(base + off + bj * HALF + n * 16);
                        *(f32x4*)(out + off + bj * HALF + n * 16) = b + cv[bj][n] * acc[ai][bj][m][n]; } }
    }
};
struct EpiProj {
    static constexpr bool PERM = true, AFTER_DRAIN = false;
    bf16_t* O; int ldc; int nscale; float scale; int gelu_from;
    __device__ __forceinline__ void operator()(const f32x4 (&acc)[2][2][4][2], const Unit& u, int wr, int wc, int fr, int fq) const {
        const int row0 = u.pm * BM + wr * 64 + fr, col0 = u.pn * BM + wc * 32 + 8 * fq;
        const float sc = (u.pn < nscale) ? scale : 1.0f; const bool gl = (u.pn >= gelu_from);
#pragma unroll
        for (int ai = 0; ai < 2; ++ai)
#pragma unroll
            for (int m = 0; m < 4; ++m) { bf16_t* rowp = O + (size_t)(row0 + ai * HALF + m * 16) * ldc + col0;
#pragma unroll
                for (int bj = 0; bj < 2; ++bj) { f32x4 v0 = acc[ai][bj][m][0] * sc, v1 = acc[ai][bj][m][1] * sc;
                    if (gl) {
#pragma unroll
                        for (int j = 0; j < 4; ++j) { const float a = v0[j], b = v1[j];
                            v0[j] = a * fast_sigmoid(1.5957691216057308f * (a + 0.044715f * a * a * a));
                            v1[j] = b * fast_sigmoid(1.5957691216057308f * (b + 0.044715f * b * b * b)); } }
                    u32x4 w; w.x = cvt_pk_bf16(v0[0], v0[1]); w.y = cvt_pk_bf16(v0[2], v0[3]); w.z = cvt_pk_bf16(v1[0], v1[1]); w.w = cvt_pk_bf16(v1[2], v1[3]);
                    *(u32x4*)(rowp + bj * HALF) = w; } }
    }
};

template <class Epi, class Sched, bool ALIGN_EPI = false, bool SP2 = false>
__device__ __forceinline__ void gemm_phase(PG8_LAS unsigned char* lds, const Gemm g, const Sched& S, const Epi& E) {
    int tid_ = threadIdx.x; asm volatile("" : "+v"(tid_));
    const int tid = tid_, wid = __builtin_amdgcn_readfirstlane(tid >> 6), lane = tid & 63, wr = wid >> 2, wc = wid & 3, fr = lane & 15, fq = lane >> 4;
    const int K = g.K, nt = K / BK;
    unsigned voffA[2], voffB[2];
#pragma unroll
    for (int i = 0; i < 2; ++i) { int R, C; stage_rc(tid * 16 + i * 8192, R, C); const int Rb = Epi::PERM ? ((R & ~31) + perm32(R & 31)) : R;
        voffA[i] = g.atile ? (unsigned)(R * BK + C) * 2u : (unsigned)(R * K + C) * 2u; voffB[i] = (unsigned)(Rb * K + C) * 2u; }
    const size_t kstep = (size_t)(BK * 2);
    const size_t hstep = (size_t)HALF * K * 2;
    const size_t tstep = 2 * hstep;
    const size_t kstepA = g.atile ? (size_t)(BM * BK * 2) : kstep, hstepA = g.atile ? (size_t)(HALF * BK * 2) : hstep, tstepA = g.atile ? (size_t)nt * (BM * BK * 2) : tstep;
    const unsigned ldsw = (unsigned)wid * 1024u;
    const int aoff = lds_byte(wr * 64 + fr, fq * 8), boff = lds_byte(wc * 32 + fr, fq * 8);
#define PG8_SA(b, h) (((b) * 2 + (h)) * HTB)
#define PG8_SB(b, h) ((4 + (b) * 2 + (h)) * HTB)
#define PG8_STAGE(bufoff, gbase, voff) do { _Pragma("unroll") for (int _i = 0; _i < 2; ++_i) \
        __builtin_amdgcn_global_load_lds((const unsigned*)((const char*)(gbase) + (voff)[_i]), (PG8_LAS unsigned*)(lds + (bufoff) + ldsw + _i * 8192), 16, 0, 0); } while (0)
#define PG8_LDA(dst, b, h) do { _Pragma("unroll") for (int m = 0; m < 4; ++m) _Pragma("unroll") for (int k = 0; k < 2; ++k) dst[m][k] = *(const PG8_LAS bf16x8*)(lds + PG8_SA(b, h) + aoff + m * 2048 + k * 1024); } while (0)
#define PG8_LDB(dst, b, h) do { _Pragma("unroll") for (int n = 0; n < 2; ++n) _Pragma("unroll") for (int k = 0; k < 2; ++k) dst[n][k] = *(const PG8_LAS bf16x8*)(lds + PG8_SB(b, h) + boff + n * 2048 + k * 1024); } while (0)
#define PG8_MMA(ai, bj, At, Bt) do { __builtin_amdgcn_s_setprio(1); _Pragma("unroll") for (int m = 0; m < 4; ++m) _Pragma("unroll") for (int n = 0; n < 2; ++n) _Pragma("unroll") for (int k = 0; k < 2; ++k) \
        acc[ai][bj][m][n] = __builtin_amdgcn_mfma_f32_16x16x32_bf16(Bt[n][k], At[m][k], acc[ai][bj][m][n], 0, 0, 0); __builtin_amdgcn_s_setprio(0); } while (0)
#define PG8_WAIT_V(n) asm volatile("s_waitcnt vmcnt(" #n ")" ::: "memory")
#define PG8_WAIT_L(n) asm volatile("s_waitcnt lgkmcnt(" #n ")" ::: "memory")
#define PG8_BAR __builtin_amdgcn_s_barrier()
#define PG8_SCHED __builtin_amdgcn_sched_barrier(0)
    Unit cur, nxt; int ui = 0;
    if (!S.next(0, cur)) return;
    f32x4 acc[2][2][4][2];
#pragma unroll
    for (int a = 0; a < 2; ++a)
#pragma unroll
        for (int b = 0; b < 2; ++b)
#pragma unroll
            for (int m = 0; m < 4; ++m)
#pragma unroll
                for (int n = 0; n < 2; ++n) acc[a][b][m][n] = (f32x4){0.f, 0.f, 0.f, 0.f};
    bf16x8 At[4][2], B0[2][2], B1[2][2];
    const char* cA = (const char*)g.A + (size_t)cur.pm * tstepA; const char* cB = (const char*)g.Bt + (size_t)cur.pn * tstep;
    S.a_ready(cur);
    if constexpr (SP2) {
        PG8_STAGE(PG8_SB(0, 0), cB, voffB); PG8_STAGE(PG8_SB(0, 1), cB + hstep, voffB); PG8_STAGE(PG8_SA(0, 0), cA, voffA); PG8_STAGE(PG8_SA(0, 1), cA + hstepA, voffA);
        if (wr == 1) PG8_BAR;
        PG8_WAIT_V(2); PG8_BAR;
        PG8_STAGE(PG8_SB(1, 0), cB + kstep, voffB); PG8_STAGE(PG8_SA(1, 0), cA + kstepA, voffA); PG8_STAGE(PG8_SB(1, 1), cB + hstep + kstep, voffB);
        PG8_WAIT_V(6); PG8_BAR;
    } else {
        PG8_STAGE(PG8_SB(0, 0), cB, voffB); PG8_STAGE(PG8_SA(0, 0), cA, voffA); PG8_STAGE(PG8_SB(0, 1), cB + hstep, voffB); PG8_STAGE(PG8_SA(0, 1), cA + hstepA, voffA);
        if (wr == 1) PG8_BAR;
        PG8_WAIT_V(4); PG8_BAR;
        PG8_STAGE(PG8_SB(1, 0), cB + kstep, voffB); PG8_STAGE(PG8_SA(1, 0), cA + kstepA, voffA); PG8_STAGE(PG8_SB(1, 1), cB + hstep + kstep, voffB);
        PG8_WAIT_V(6); PG8_BAR;
    }
    for (;;) {
        const bool has_next = S.next(ui + 1, nxt);
        const char* nA = has_next ? (const char*)g.A + (size_t)nxt.pm * tstepA : cA; const char* nB = has_next ? (const char*)g.Bt + (size_t)nxt.pn * tstep : cB;
        for (int t = 0; t < nt; t += 2) {
            const bool last = (t == nt - 2);
            const char* a1 = cA + (size_t)(t + 1) * kstepA;
            const char* a2 = last ? nA : cA + (size_t)(t + 2) * kstepA; const char* b2 = last ? nB : cB + (size_t)(t + 2) * kstep;
            const char* a3 = a2 + kstepA; const char* b3 = b2 + kstep;
            if (last && has_next) S.a_ready(nxt);
            if constexpr (SP2) {
            PG8_LDB(B0, 0, 0); PG8_LDB(B1, 0, 1); PG8_SCHED; PG8_LDA(At, 0, 0); PG8_STAGE(PG8_SA(1, 1), a1 + hstepA, voffA);
            PG8_WAIT_V(8); PG8_WAIT_L(0); PG8_BAR; PG8_MMA(0, 0, At, B0); PG8_MMA(0, 1, At, B1); PG8_BAR; PG8_SCHED;
            PG8_LDA(At, 0, 1); PG8_STAGE(PG8_SB(0, 0), b2, voffB); PG8_STAGE(PG8_SB(0, 1), b2 + hstep, voffB); PG8_STAGE(PG8_SA(0, 0), a2, voffA);
            PG8_WAIT_V(8); PG8_WAIT_L(0); PG8_BAR; PG8_MMA(1, 0, At, B0); PG8_MMA(1, 1, At, B1); PG8_BAR; PG8_SCHED;
            PG8_LDB(B0, 1, 0); PG8_LDB(B1, 1, 1); PG8_SCHED; PG8_LDA(At, 1, 0); PG8_STAGE(PG8_SA(0, 1), a2 + hstepA, voffA);
            PG8_WAIT_V(8); PG8_WAIT_L(0); PG8_BAR; PG8_MMA(0, 0, At, B0); PG8_MMA(0, 1, At, B1); PG8_BAR; PG8_SCHED;
            PG8_LDA(At, 1, 1); PG8_STAGE(PG8_SB(1, 0), b3, voffB); PG8_STAGE(PG8_SB(1, 1), b3 + hstep, voffB); PG8_STAGE(PG8_SA(1, 0), a3, voffA);
            PG8_WAIT_V(8); PG8_WAIT_L(0); PG8_BAR; PG8_MMA(1, 0, At, B0); PG8_MMA(1, 1, At, B1); PG8_BAR; PG8_SCHED;
            } else {
            PG8_LDB(B0, 0, 0); PG8_SCHED; PG8_LDA(At, 0, 0); PG8_STAGE(PG8_SA(1, 1), a1 + hstepA, voffA);
            PG8_WAIT_L(8); PG8_BAR; PG8_WAIT_L(0); PG8_MMA(0, 0, At, B0); PG8_BAR; PG8_SCHED;
            PG8_LDB(B1, 0, 1); PG8_STAGE(PG8_SB(0, 0), b2, voffB);
            PG8_BAR; PG8_WAIT_L(0); PG8_MMA(0, 1, At, B1); PG8_BAR;
            PG8_LDA(At, 0, 1); PG8_STAGE(PG8_SA(0, 0), a2, voffA);
            PG8_BAR; PG8_WAIT_L(0); PG8_MMA(1, 0, At, B0); PG8_BAR; PG8_SCHED;
            PG8_STAGE(PG8_SB(0, 1), b2 + hstep, voffB);
            PG8_WAIT_V(6); PG8_BAR; PG8_MMA(1, 1, At, B1); PG8_BAR;
            PG8_LDB(B0, 1, 0); PG8_SCHED; PG8_LDA(At, 1, 0); PG8_STAGE(PG8_SA(0, 1), a2 + hstepA, voffA);
            PG8_WAIT_L(8); PG8_BAR; PG8_WAIT_L(0); PG8_MMA(0, 0, At, B0); PG8_BAR; PG8_SCHED;
            PG8_LDB(B1, 1, 1); PG8_STAGE(PG8_SB(1, 0), b3, voffB);
            PG8_BAR; PG8_WAIT_L(0); PG8_MMA(0, 1, At, B1); PG8_BAR;
            PG8_LDA(At, 1, 1); PG8_STAGE(PG8_SA(1, 0), a3, voffA);
            PG8_BAR; PG8_WAIT_L(0); PG8_MMA(1, 0, At, B0); PG8_BAR; PG8_SCHED;
            PG8_STAGE(PG8_SB(1, 1), b3 + hstep, voffB);
            PG8_WAIT_V(6); PG8_BAR; PG8_MMA(1, 1, At, B1); PG8_BAR;
            }
        }
        if constexpr (ALIGN_EPI) { if (wr == 0) PG8_BAR; }
        if constexpr (!Epi::AFTER_DRAIN) { E(acc, cur, wr, wc, fr, fq); S.done(cur); }
        if (!has_next) break;
#pragma unroll
        for (int a = 0; a < 2; ++a)
#pragma unroll
            for (int b = 0; b < 2; ++b)
#pragma unroll
                for (int m = 0; m < 4; ++m)
#pragma unroll
                    for (int n = 0; n < 2; ++n) acc[a][b][m][n] = (f32x4){0.f, 0.f, 0.f, 0.f};
        cur = nxt; cA = nA; cB = nB; ++ui;
        if constexpr (ALIGN_EPI) { if (wr == 1) PG8_BAR; }
    }
    PG8_WAIT_V(0);
    if constexpr (!ALIGN_EPI) { if (wr == 0) PG8_BAR; }
    PG8_BAR;
    if constexpr (Epi::AFTER_DRAIN) { E.fused(acc, cur, wr, wc, fr, fq, lds, wid, lane); S.done(cur); }
#undef PG8_SA
#undef PG8_SB
#undef PG8_STAGE
#undef PG8_LDA
#undef PG8_LDB
#undef PG8_MMA
#undef PG8_WAIT_V
#undef PG8_WAIT_L
#undef PG8_BAR
#undef PG8_SCHED
}
}

constexpr int S = 16384, D = 2048, DEPTH = 4, DFF = 5504, NMODV = 9 * 2048;
constexpr int ABN = 5120, CIN = 4176, CINP = 4352;
constexpr float EPS = 1e-6f, LOG2E = 1.4426950408889634f;
constexpr int NWAVES = 8;
constexpr size_t MiB = 1u << 20;
constexpr size_t WS_CTL = 0, CTL_ZERO_BYTES = 1 * MiB;
constexpr size_t WS_PART = 1 * MiB, WS_VEC = 3 * MiB;
constexpr size_t WS_W1T = 4 * MiB, WS_W2T = 348 * MiB, WS_ABIN = 520 * MiB, WS_ABOUT = 560 * MiB, WS_DSAIN = 576 * MiB, WS_DSAOUT = 610 * MiB;
constexpr size_t WS_XRES = 626 * MiB, WS_XN = 754 * MiB, WS_H = 818 * MiB, WS_PROJ = 990 * MiB, WS_CAT = 1150 * MiB, WS_SEL = 1214 * MiB, WS_END = 1222 * MiB;
constexpr size_t W1T_SZ = (size_t)2 * DFF * D, W2T_SZ = (size_t)D * DFF, ABIN_SZ = (size_t)ABN * D, SQ_SZ = (size_t)D * D, DSAIN_SZ = (size_t)CINP * D;
static_assert(WS_W1T + 8 * W1T_SZ * 2 <= WS_W2T && WS_W2T + 8 * W2T_SZ * 2 <= WS_ABIN && WS_ABIN + 2 * ABIN_SZ * 2 <= WS_ABOUT && WS_ABOUT + 2 * SQ_SZ * 2 <= WS_DSAIN &&
              WS_DSAIN + 2 * DSAIN_SZ * 2 <= WS_DSAOUT && WS_DSAOUT + 2 * SQ_SZ * 2 <= WS_XRES && WS_XRES + (size_t)S * D * 4 <= WS_XN && WS_XN + (size_t)S * D * 2 <= WS_H &&
              WS_H + (size_t)S * DFF * 2 <= WS_PROJ && WS_PROJ + (size_t)S * ABN * 2 <= WS_CAT && WS_CAT + (size_t)S * D * 2 <= WS_SEL && WS_SEL + (size_t)S * 256 * 2 <= WS_END, "d_ws map");
constexpr int CW_BAR = 4096;
constexpr int RING_BYTES = 147456;
constexpr int MISC_OFF = RING_BYTES;
constexpr int INP_OFF = RING_BYTES + 256;
constexpr int LDS_BYTES = RING_BYTES + 512;

#define GAS __attribute__((address_space(1)))
#define LAS __attribute__((address_space(3)))
typedef unsigned short bf16;
typedef unsigned v4u __attribute__((ext_vector_type(4)));
typedef unsigned v2u __attribute__((ext_vector_type(2)));
typedef float f32x4 __attribute__((ext_vector_type(4)));
typedef float f32x16 __attribute__((ext_vector_type(16)));
typedef short bf16x8 __attribute__((ext_vector_type(8)));
typedef short s16x4 __attribute__((ext_vector_type(4)));
typedef GAS unsigned gu32;
#define LDS_WAIT() asm volatile("s_waitcnt lgkmcnt(0)" ::: "memory")
#define VM_WAIT() asm volatile("s_waitcnt vmcnt(0)" ::: "memory")
__device__ __forceinline__ unsigned f2bf(float f) { unsigned u = __builtin_bit_cast(unsigned, f); return (u + 0x7fffu + ((u >> 16) & 1u)) >> 16; }
__device__ __forceinline__ unsigned pk2(float lo, float hi) { return f2bf(lo) | (f2bf(hi) << 16); }
__device__ __forceinline__ float bf2f(unsigned short b) { return __builtin_bit_cast(float, (unsigned)b << 16); }
typedef float f32x2_t __attribute__((ext_vector_type(2))); typedef __bf16 bf16x2_t __attribute__((ext_vector_type(2)));
__device__ __forceinline__ unsigned cvtpk(float lo, float hi) { f32x2_t v = {lo, hi}; bf16x2_t b = __builtin_convertvector(v, bf16x2_t); return __builtin_bit_cast(unsigned, b); }
__device__ __forceinline__ int crow(int i, int hh) { return (i & 3) + 8 * (i >> 2) + 4 * hh; }
template <int K> __device__ __forceinline__ float swz_xor(float v) { return __builtin_bit_cast(float, __builtin_amdgcn_ds_swizzle(__builtin_bit_cast(int, v), (K << 10) | 0x1f)); }
__device__ __forceinline__ float sum32(float v) { const unsigned u = __builtin_bit_cast(unsigned, v); auto rr = __builtin_amdgcn_permlane32_swap(u, u, false, false); return __builtin_bit_cast(float, (unsigned)rr[0]) + __builtin_bit_cast(float, (unsigned)rr[1]); }
__device__ __forceinline__ float max32(float v) { const unsigned u = __builtin_bit_cast(unsigned, v); auto rr = __builtin_amdgcn_permlane32_swap(u, u, false, false); return fmaxf(__builtin_bit_cast(float, (unsigned)rr[0]), __builtin_bit_cast(float, (unsigned)rr[1])); }
__device__ __forceinline__ float wave_sum(float v) {
    v += swz_xor<1>(v); v += swz_xor<2>(v); v += swz_xor<4>(v); v += swz_xor<8>(v); v += swz_xor<16>(v);
    return sum32(v);
}
__device__ __forceinline__ void glds16(const void* gsrc, unsigned lds_dst) { unsigned keep;
    asm volatile("s_mov_b32 %0, m0\n\ts_mov_b32 m0, %2\n\ts_nop 0\n\tglobal_load_lds_dwordx4 %1, off\n\ts_mov_b32 m0, %0" : "=&s"(keep) : "v"(gsrc), "s"(lds_dst) : "memory"); }
__device__ __forceinline__ unsigned lds_addr(const LAS unsigned char* p) { return (unsigned)(size_t)p; }
#define MFMA32(a, b, c) __builtin_amdgcn_mfma_f32_32x32x16_bf16((a), (b), (c), 0, 0, 0)
typedef short v4i16_t __attribute__((ext_vector_type(4)));
__device__ __forceinline__ s16x4 vtr(const LAS unsigned char* p) { return __builtin_bit_cast(s16x4, __builtin_amdgcn_ds_read_tr16_b64_v4i16((LAS v4i16_t*)p)); }
__device__ const unsigned char REL_BUCKET[129] = {
    0, 1, 2, 3, 4, 5, 6, 7, 8, 9, 10, 11, 12, 13, 14, 15,
    16, 16, 16, 17, 17, 18, 18, 18, 19, 19, 19, 20, 20, 20, 20, 21,
    21, 21, 21, 22, 22, 22, 22, 22, 23, 23, 23, 23, 23, 23, 24, 24,
    24, 24, 24, 24, 25, 25, 25, 25, 25, 25, 25, 26, 26, 26, 26, 26,
    26, 26, 26, 27, 27, 27, 27, 27, 27, 27, 27, 27, 27, 28, 28, 28,
    28, 28, 28, 28, 28, 28, 28, 29, 29, 29, 29, 29, 29, 29, 29, 29,
    29, 29, 29, 30, 30, 30, 30, 30, 30, 30, 30, 30, 30, 30, 30, 30,
    30, 31, 31, 31, 31, 31, 31, 31, 31, 31, 31, 31, 31, 31, 31, 31,
    31
};

#define XB_TMO      128
#define XB_XCNT(j)  (256  + 64 * (j))
#define XB_XSUB(j)  (1280 + 64 * (j))
#define XB_XGEN(j)  (2304 + 64 * (j))
#define XB_TOP      3328
#define XB_TOPGEN   3392
#define XCD_BAR_WORDS 3456
#define XB_SPIN_CAP (1u << 22)

__device__ __forceinline__ unsigned xb_ld(unsigned* p)              { return __hip_atomic_load(p, __ATOMIC_RELAXED, __HIP_MEMORY_SCOPE_AGENT); }
__device__ __forceinline__ unsigned xb_add(unsigned* p, unsigned v) { return __hip_atomic_fetch_add(p, v, __ATOMIC_RELAXED, __HIP_MEMORY_SCOPE_AGENT); }
__device__ __forceinline__ unsigned xb_xcc_id() { return (unsigned)__builtin_amdgcn_s_getreg((3 << 11) | 20) & 0xFu; }
#define XB_SPIN(cond, bar) do { unsigned _sp = 0; while (cond) { __builtin_amdgcn_s_sleep(1); \
    if ((++_sp & 255u) == 0u) { if (xb_ld(&(bar)[XB_TMO])) break; if (_sp > XB_SPIN_CAP) { atomicAdd(&(bar)[XB_TMO], 1u); break; } } } } while (0)

struct XcdBarrier {
    unsigned* bar; unsigned x;
    volatile LAS unsigned* st;
};

__device__ __forceinline__ bool xb_thread0(int wave) { unsigned z = 0u; asm volatile("" : "+v"(z)); return wave == 0 && __builtin_amdgcn_mbcnt_hi(~0u, __builtin_amdgcn_mbcnt_lo(~0u, z)) == 0u; }
__device__ __forceinline__ XcdBarrier xcd_barrier_post(unsigned* bar, volatile LAS unsigned* st, int wave) {
    XcdBarrier b; b.bar = bar; b.x = xb_xcc_id(); b.st = st;
    if (xb_thread0(wave)) (void)xb_add(&bar[XB_XCNT(b.x)], 1u);
    return b;
}
__device__ __forceinline__ void xcd_barrier_complete(unsigned* bar, unsigned x, unsigned& nloc, unsigned& nx) {
    const unsigned G = gridDim.x * gridDim.y * gridDim.z;
    unsigned sum, cnt, mine, sp = 0u;
    for (;;) {
        sum = 0u; cnt = 0u; mine = 0u;
#pragma unroll
        for (unsigned j = 0; j < 16; ++j) { const unsigned c = xb_ld(&bar[XB_XCNT(j)]); sum += c; cnt += (c > 0u) ? 1u : 0u; mine = (j == x) ? c : mine; }
        if (sum == G) break;
        __builtin_amdgcn_s_sleep(1);
        if ((++sp & 255u) == 0u) { if (xb_ld(&bar[XB_TMO])) break; if (sp > XB_SPIN_CAP) { atomicAdd(&bar[XB_TMO], 1u); break; } }
    }
    nloc = mine > 0u ? mine : 1u; nx = cnt > 0u ? cnt : 1u;
}

__device__ __forceinline__ void xcd_barrier(const XcdBarrier& b, int wave) {
    asm volatile("s_waitcnt vmcnt(0)" ::: "memory");
    __syncthreads();
    if (xb_thread0(wave)) {
        unsigned* bar = b.bar;
        __builtin_amdgcn_s_waitcnt(0);
        unsigned nloc = b.st[0], nx = b.st[1];
        if (nloc == 0u) { xcd_barrier_complete(bar, b.x, nloc, nx); b.st[0] = nloc; b.st[1] = nx; }
        const unsigned old = xb_add(&bar[XB_XSUB(b.x)], 1u);
        const unsigned gen = old / nloc;
        if (old + 1u == (gen + 1u) * nloc) {
            __builtin_amdgcn_fence(__ATOMIC_RELEASE, "agent");
            asm volatile("s_waitcnt vmcnt(0)" ::: "memory");
            const unsigned og = xb_add(&bar[XB_TOP], 1u);
            const unsigned tg = og / nx;
            if (og + 1u == (tg + 1u) * nx) xb_add(&bar[XB_TOPGEN], 1u);
            else XB_SPIN(xb_ld(&bar[XB_TOPGEN]) == tg, bar);
            __builtin_amdgcn_fence(__ATOMIC_ACQUIRE, "agent");
            xb_add(&bar[XB_XGEN(b.x)], 1u);
            asm volatile("s_waitcnt vmcnt(0)" ::: "memory");
        } else {
            XB_SPIN(xb_ld(&bar[XB_XGEN(b.x)]) == gen, bar);
            __builtin_amdgcn_fence(__ATOMIC_ACQUIRE, "agent");
            asm volatile("s_waitcnt vmcnt(0)" ::: "memory");
        }
    }
    __syncthreads();
}

struct Frame {
    LAS unsigned char* lds;
    int tid, lane, wave, vcu, G;
};

__device__ __forceinline__ void tr_item(const float* W, int K, int N, int ncols, bf16* WT, int out_row0, LAS float* scr, int k0, int n0, int lane) {
    const int col = n0 + (lane & 31); const bool ok = col < ncols;
    float tv[32];
    const float* wp = W + (size_t)(k0 + (lane >> 5)) * N + (ok ? col : 0);
#pragma unroll
    for (int i = 0; i < 32; ++i) tv[i] = wp[(size_t)(2 * i) * N];
#pragma unroll
    for (int i = 0; i < 32; ++i) scr[(2 * i + (lane >> 5)) * 33 + (lane & 31)] = ok ? tv[i] : 0.f;
    LDS_WAIT(); asm volatile("" ::: "memory");
    const int c = lane & 7;
#pragma unroll
    for (int j = 0; j < 4; ++j) { const int n = (lane >> 3) + 8 * j; const LAS float* s = scr + (8 * c) * 33 + n;
        v4u o; o.x = pk2(s[0 * 33], s[1 * 33]); o.y = pk2(s[2 * 33], s[3 * 33]); o.z = pk2(s[4 * 33], s[5 * 33]); o.w = pk2(s[6 * 33], s[7 * 33]);
        *(GAS v4u*)(WT + (size_t)(out_row0 + n) * K + k0 + 8 * c) = o; }
    LDS_WAIT(); asm volatile("" ::: "memory");
}
constexpr int I_W1 = 32 * 344, I_W2 = 86 * 64, I_ABI = 32 * 160, I_SQ = 32 * 64, I_DSI = 32 * 136;
constexpr int N_TR_ITEMS = 8 * I_W1 + 8 * I_W2 + 2 * I_ABI + 2 * I_SQ + 2 * I_DSI + 2 * I_SQ;
constexpr int N_GEMV_UNITS = 4 * 72 * 4;
struct Args; __device__ __forceinline__ const float* in_ptr(const Args& a, int i);
__device__ __forceinline__ void prologue_phase(Frame& F, const Args& A, unsigned char* ws) {
    const float* c = in_ptr(A, 1); const float* mod_w = in_ptr(A, 3); float* PART = (float*)(ws + WS_PART);
    for (int unit = F.vcu; unit < N_GEMV_UNITS; unit += F.G) {
        const int l = unit / 288, rem = unit % 288, cb = rem >> 2, kq = rem & 3;
        LAS float* sc = (LAS float*)F.lds + F.wave * 64;
        const int k0 = kq * 512 + F.wave * 64;
        { const float cv = c[k0 + F.lane]; sc[F.lane] = cv * pg8::fast_sigmoid(cv); }
        LDS_WAIT(); asm volatile("" ::: "memory");
        const float* W = mod_w + ((size_t)l * 2048 + k0) * NMODV + cb * 256 + 4 * F.lane;
        f32x4 acc = {0.f, 0.f, 0.f, 0.f};
#pragma unroll 16
        for (int kk = 0; kk < 64; ++kk) acc += sc[kk] * *(const f32x4*)(W + (size_t)kk * NMODV);
        *((LAS f32x4*)(F.lds + 4096) + F.wave * 64 + F.lane) = acc;
        __syncthreads();
        if (F.tid < 256) { float s = 0.f;
#pragma unroll
            for (int w = 0; w < 8; ++w) s += ((LAS float*)(F.lds + 4096))[w * 256 + F.tid];
            PART[(size_t)(kq * 4 + l) * NMODV + cb * 256 + F.tid] = s; }
        __syncthreads();
    }
    LAS float* scr = (LAS float*)(F.lds + 16384 + F.wave * 8704);
    const int gw = F.vcu * NWAVES + F.wave, NGW = F.G * NWAVES;
    for (int it = gw; it < N_TR_ITEMS; it += NGW) {
        int r = it;
        if (r < 8 * I_W1) { const int mi = r / I_W1, q = r % I_W1, kb = q / 344, nb = q % 344, n0 = nb * 32;
            const int orow = (n0 < DFF) ? (n0 / 128) * 256 + (n0 % 128) : ((n0 - DFF) / 128) * 256 + 128 + ((n0 - DFF) % 128);
            tr_item(in_ptr(A, 5) + (size_t)mi * D * 2 * DFF, D, 2 * DFF, 2 * DFF, (bf16*)(ws + WS_W1T) + (size_t)mi * W1T_SZ, orow, scr, kb * 64, n0, F.lane); continue; } r -= 8 * I_W1;
        if (r < 8 * I_W2) { const int mi = r / I_W2, q = r % I_W2, kb = q / 64, nb = q % 64;
            tr_item(in_ptr(A, 6) + (size_t)mi * DFF * D, DFF, D, D, (bf16*)(ws + WS_W2T) + (size_t)mi * W2T_SZ, nb * 32, scr, kb * 64, nb * 32, F.lane); continue; } r -= 8 * I_W2;
        if (r < 2 * I_ABI) { const int mi = r / I_ABI, q = r % I_ABI, kb = q / 160, nb = q % 160;
            tr_item(in_ptr(A, 8) + (size_t)mi * D * ABN, D, ABN, ABN, (bf16*)(ws + WS_ABIN) + (size_t)mi * ABIN_SZ, nb * 32, scr, kb * 64, nb * 32, F.lane); continue; } r -= 2 * I_ABI;
        if (r < 2 * I_SQ) { const int mi = r / I_SQ, q = r % I_SQ, kb = q / 64, nb = q % 64;
            tr_item(in_ptr(A, 9) + (size_t)mi * SQ_SZ, D, D, D, (bf16*)(ws + WS_ABOUT) + (size_t)mi * SQ_SZ, nb * 32, scr, kb * 64, nb * 32, F.lane); continue; } r -= 2 * I_SQ;
        if (r < 2 * I_DSI) { const int mi = r / I_DSI, q = r % I_DSI, kb = q / 136, nb = q % 136;
            tr_item(in_ptr(A, 16) + (size_t)mi * D * CIN, D, CIN, CIN, (bf16*)(ws + WS_DSAIN) + (size_t)mi * DSAIN_SZ, nb * 32, scr, kb * 64, nb * 32, F.lane); continue; } r -= 2 * I_DSI;
        { const int mi = r / I_SQ, q = r % I_SQ, kb = q / 64, nb = q % 64;
            tr_item(in_ptr(A, 17) + (size_t)mi * SQ_SZ, D, D, D, (bf16*)(ws + WS_DSAOUT) + (size_t)mi * SQ_SZ, nb * 32, scr, kb * 64, nb * 32, F.lane); }
    }
}
__device__ __forceinline__ void vec_phase(Frame& F, const Args& A, unsigned char* ws) {
    const float* PART = (const float*)(ws + WS_PART); const float* mod_b = in_ptr(A, 4); const float* norm_g = in_ptr(A, 2);
    float* NA = (float*)(ws + WS_VEC); float* NB = NA + 12 * 2048; float* GT = NB + 12 * 2048;
    for (int idx = F.vcu * 512 + F.tid; idx < 12 * 2048; idx += F.G * 512) {
        const int lj = idx >> 11, col = idx & 2047, l = lj / 3, j = lj % 3;
        float mv[3];
#pragma unroll
        for (int t = 0; t < 3; ++t) { const int n = (3 * j + t) * 2048 + col; float s = mod_b[l * NMODV + n];
#pragma unroll
            for (int kq = 0; kq < 4; ++kq) s += PART[(size_t)(kq * 4 + l) * NMODV + n];
            mv[t] = s; }
        NA[idx] = norm_g[idx] * (1.0f + mv[1]); NB[idx] = mv[0]; GT[idx] = (j == 1 ? 1.0f : 0.5f) * (1.0f + mv[2]);
    }
}
__device__ __forceinline__ void norm_phase(Frame& F, const float* src, const float* na, const float* nb, bf16* dst) {
    const int gw = F.vcu * NWAVES + F.wave, NGW = F.G * NWAVES;
    for (int m = gw; m < S; m += NGW) {
        const GAS f32x4* xr = (const GAS f32x4*)(src + (size_t)m * D) + F.lane;
        f32x4 v[8]; float ss = 0.f;
#pragma unroll
        for (int j = 0; j < 8; ++j) { v[j] = xr[64 * j]; ss += (v[j].x * v[j].x + v[j].y * v[j].y) + (v[j].z * v[j].z + v[j].w * v[j].w); }
        const float rstd = 1.0f / sqrtf(wave_sum(ss) * (1.0f / D) + EPS);
        GAS v2u* o8 = (GAS v2u*)(dst + (size_t)m * D) + F.lane;
#pragma unroll
        for (int j = 0; j < 8; ++j) { const f32x4 a = ((const f32x4*)na)[64 * j + F.lane], b = ((const f32x4*)nb)[64 * j + F.lane]; const f32x4 o = v[j] * rstd * a + b;
            v2u w; w.x = cvtpk(o.x, o.y); w.y = cvtpk(o.z, o.w); o8[64 * j] = w; }
    }
}
__device__ __forceinline__ void final_norm_phase(Frame& F, const float* src, const float* g, float* out) {
    const int gw = F.vcu * NWAVES + F.wave, NGW = F.G * NWAVES;
    for (int m = gw; m < S; m += NGW) {
        const GAS f32x4* xr = (const GAS f32x4*)(src + (size_t)m * D) + F.lane;
        f32x4 v[8]; float ss = 0.f;
#pragma unroll
        for (int j = 0; j < 8; ++j) { v[j] = xr[64 * j]; ss += (v[j].x * v[j].x + v[j].y * v[j].y) + (v[j].z * v[j].z + v[j].w * v[j].w); }
        const float rstd = 1.0f / sqrtf(wave_sum(ss) * (1.0f / D) + EPS);
        GAS f32x4* o = (GAS f32x4*)(out + (size_t)m * D) + F.lane;
#pragma unroll
        for (int j = 0; j < 8; ++j) o[64 * j] = v[j] * rstd * ((const f32x4*)g)[64 * j + F.lane];
    }
}

namespace da {
constexpr int PITCH = ABN, KOFF = 1024, VOFF = 2048;
constexpr float C2 = 0.125f * LOG2E;
constexpr int NBUF = 4, LDS_LUT = NBUF * 32768;
#define DA_WAIT_BAR(N) asm volatile("s_waitcnt vmcnt(" #N ") lgkmcnt(0)\n\ts_barrier" ::: "memory")
constexpr float THR = 8.0f;
__device__ __forceinline__ void dma_tile(LAS unsigned char* lds, const bf16* P, int h, int k0, int buf, int wid, int lane) {
#pragma unroll
    for (int i = 0; i < 2; ++i) {
        const int piece = wid * 2 + i, row = piece * 4 + (lane >> 4), pc = lane & 15;
        const int ck = pc ^ (row & 15), cv = pc ^ (2 * (row & 7));
        const bf16* rp = P + (size_t)(k0 + row) * PITCH + h * 128;
        glds16(rp + KOFF + ck * 8, (unsigned)__builtin_amdgcn_readfirstlane(lds_addr(lds) + buf * 32768 + piece * 1024));
        glds16(rp + VOFF + cv * 8, (unsigned)__builtin_amdgcn_readfirstlane(lds_addr(lds) + buf * 32768 + 16384 + piece * 1024));
    }
}
__device__ __forceinline__ float max3_asm(float a, float b, float c) { float r; asm("v_max3_f32 %0, %1, %2, %3" : "=v"(r) : "v"(a), "v"(b), "v"(c)); return r; }
__device__ __forceinline__ void unit(int tid, LAS unsigned char* lds, const bf16* P, bf16* CAT, int h, int qb, float lam, float oscale, const float* subg, const float* rel) {
    const int lane = tid & 63, wid = __builtin_amdgcn_readfirstlane(tid >> 6), r = lane & 31, hh = lane >> 5;
    const int rb = wid >> 1, m = wid & 1;
    const int q0w = qb * 128 + rb * 32, qpos = q0w + r;
    LAS float* lut = (LAS float*)(lds + LDS_LUT);
    __syncthreads();
    if (tid < 258) { const int mm = tid / 129, d = tid % 129; const int b = REL_BUCKET[d];
        lut[mm * 132 + d] = (rel[b * 16 + h * 2 + mm] - rel[31 * 16 + h * 2 + mm]) * LOG2E; }
    const int NT = 2 * qb + 2;
    bf16x8 qf[4];
#pragma unroll
    for (int ks = 0; ks < 4; ++ks) qf[ks] = *(const bf16x8*)(P + (size_t)qpos * PITCH + h * 128 + m * 64 + ks * 16 + hh * 8);
    asm volatile("s_waitcnt vmcnt(0)" : "+v"(qf[0]), "+v"(qf[1]), "+v"(qf[2]), "+v"(qf[3]) :: "memory");
    dma_tile(lds, P, h, 0, 0, wid, lane); dma_tile(lds, P, h, 64, 1, wid, lane);
    if (NT > 2) dma_tile(lds, P, h, 128, 2, wid, lane);
    f32x16 O[4];
#pragma unroll
    for (int e = 0; e < 4; ++e)
#pragma unroll
        for (int i = 0; i < 16; ++i) O[e][i] = 0.f;
    float mref = 0.f, ls4[4] = {0.f, 0.f, 0.f, 0.f};
    f32x16 negm;
#pragma unroll
    for (int i = 0; i < 16; ++i) negm[i] = 0.f;
    const int klane = r * 256, kbits0 = (8 * m + hh) ^ (r & 15);
    const int l16 = lane & 15, qq = l16 >> 2, p4 = l16 & 3, G4 = lane >> 4;
    const int x0 = 4 * hh + qq, lanev20 = (2 * (G4 & 1) + (p4 >> 1)) ^ (2 * x0), vlane = x0 * 256 + (p4 & 1) * 8;
    if (NT > 2) DA_WAIT_BAR(8); else DA_WAIT_BAR(4);
    for (int t = 0; t < NT; ++t) {
        const int buf = t & 3, k0 = t * 64;
        if (t + 3 < NT) dma_tile(lds, P, h, k0 + 192, (t + 3) & 3, wid, lane);
        int kbits = kbits0, lanev2 = lanev20; asm volatile("" : "+v"(kbits), "+v"(lanev2));
        if (k0 <= q0w + 31) {
            const LAS unsigned char* Kb = lds + buf * 32768; const LAS unsigned char* Vb = Kb + 16384;
            const bool two = (k0 + 32 <= q0w + 31);
            bf16x8 kf[2][4];
#pragma unroll
            for (int kb = 0; kb < 2; ++kb)
#pragma unroll
                for (int ks = 0; ks < 4; ++ks) kf[kb][ks] = *(const LAS bf16x8*)(Kb + kb * 8192 + klane + (((2 * ks) ^ kbits) << 4));
            __builtin_amdgcn_sched_barrier(0);
            f32x16 s0 = negm, s1 = negm;
#pragma unroll
            for (int ks = 0; ks < 4; ++ks) { s0 = MFMA32(kf[0][ks], qf[ks], s0); s1 = MFMA32(kf[1][ks], qf[ks], s1); }
            asm volatile("s_nop 15\n\ts_nop 7" : "+v"(s0), "+v"(s1));
            if (k0 + 191 > q0w) {
#pragma unroll
                for (int i = 0; i < 16; ++i) { const int d0 = qpos - (k0 + crow(i, hh)), d1 = d0 - 32;
                    s0[i] = d0 < 0 ? -INFINITY : s0[i] + lut[m * 132 + (d0 > 128 ? 128 : d0)];
                    s1[i] = d1 < 0 ? -INFINITY : s1[i] + lut[m * 132 + (d1 > 128 ? 128 : d1)]; }
            }
            float mx = max3_asm(s0[0], s0[1], s0[2]), my = max3_asm(s1[0], s1[1], s1[2]);
#pragma unroll
            for (int i = 3; i < 15; i += 2) { mx = max3_asm(mx, s0[i], s0[i + 1]); my = max3_asm(my, s1[i], s1[i + 1]); }
            mx = max3_asm(mx, s0[15], my); mx = fmaxf(mx, s1[15]);
            mx = max32(mx);
            if (__any(mx > THR)) {
                const float dl = fmaxf(mx, 0.f), alpha = __builtin_amdgcn_exp2f(-dl);
                mref += dl;
#pragma unroll
                for (int i = 0; i < 16; ++i) { s0[i] -= dl; s1[i] -= dl; negm[i] = -mref; }
#pragma unroll
                for (int j = 0; j < 4; ++j) ls4[j] *= alpha;
#pragma unroll
                for (int e = 0; e < 4; ++e)
#pragma unroll
                    for (int i = 0; i < 16; ++i) O[e][i] *= alpha;
            }
#pragma unroll
            for (int i = 0; i < 16; ++i) { s0[i] = __builtin_amdgcn_exp2f(s0[i]); s1[i] = __builtin_amdgcn_exp2f(s1[i]); }
#pragma unroll
            for (int i = 0; i < 16; ++i) { ls4[i & 3] += s0[i]; }
#pragma unroll
            for (int i = 0; i < 16; ++i) { ls4[i & 3] += s1[i]; }
            bf16x8 pk[4];
#pragma unroll
            for (int s2 = 0; s2 < 2; ++s2) { v4u w0, w1;
                w0.x = cvtpk(s0[8 * s2], s0[8 * s2 + 1]); w0.y = cvtpk(s0[8 * s2 + 2], s0[8 * s2 + 3]); w0.z = cvtpk(s0[8 * s2 + 4], s0[8 * s2 + 5]); w0.w = cvtpk(s0[8 * s2 + 6], s0[8 * s2 + 7]);
                w1.x = cvtpk(s1[8 * s2], s1[8 * s2 + 1]); w1.y = cvtpk(s1[8 * s2 + 2], s1[8 * s2 + 3]); w1.z = cvtpk(s1[8 * s2 + 4], s1[8 * s2 + 5]); w1.w = cvtpk(s1[8 * s2 + 6], s1[8 * s2 + 7]);
                pk[s2] = __builtin_bit_cast(bf16x8, w0); pk[2 + s2] = __builtin_bit_cast(bf16x8, w1); }
#pragma unroll
            for (int kk = 0; kk < 4; ++kk) {
                if (kk < 2 || two) {
#pragma unroll
                    for (int e = 0; e < 4; ++e) {
                        const LAS unsigned char* a0 = Vb + (16 * kk) * 256 + vlane + (((4 * e) ^ lanev2) << 4);
                        const s16x4 lo = vtr(a0), hi = vtr(a0 + 2048);
                        const bf16x8 vf = (bf16x8){lo[0], lo[1], lo[2], lo[3], hi[0], hi[1], hi[2], hi[3]};
                        O[e] = MFMA32(vf, pk[kk], O[e]);
                    }
                }
            }
        }
        if (t + 3 < NT) DA_WAIT_BAR(8); else if (t + 2 < NT) DA_WAIT_BAR(4); else DA_WAIT_BAR(0);
    }
    float lsum = sum32((ls4[0] + ls4[1]) + (ls4[2] + ls4[3]));
    LAS float* xch = (LAS float*)lds + rb * 4096 + lane;
    if (m == 1) { const float i1 = lam / lsum;
#pragma unroll
        for (int e = 0; e < 4; ++e)
#pragma unroll
            for (int i = 0; i < 16; ++i) xch[(e * 16 + i) * 64] = O[e][i] * i1; }
    __syncthreads();
    if (m == 0) {
        const float i0 = 1.0f / lsum; float ss = 0.f;
#pragma unroll
        for (int e = 0; e < 4; ++e)
#pragma unroll
            for (int i = 0; i < 16; ++i) { const float o = O[e][i] * i0 - xch[(e * 16 + i) * 64]; O[e][i] = o; ss += o * o; }
        ss = sum32(ss);
        const float rs = oscale / sqrtf(ss * (1.0f / 128.0f) + EPS);
        GAS bf16* orow = (GAS bf16*)CAT + (size_t)qpos * D + h * 128;
#pragma unroll
        for (int e = 0; e < 4; ++e)
#pragma unroll
            for (int g4 = 0; g4 < 4; ++g4) { const int ecol = 32 * e + 8 * g4 + 4 * hh; const f32x4 gv = *(const f32x4*)(subg + ecol);
                v2u w; w.x = cvtpk(O[e][4 * g4] * rs * gv.x, O[e][4 * g4 + 1] * rs * gv.y); w.y = cvtpk(O[e][4 * g4 + 2] * rs * gv.z, O[e][4 * g4 + 3] * rs * gv.w);
                *(GAS v2u*)(orow + ecol) = w; }
    }
}
}

namespace sgp {
constexpr int PITCH = ABN, UOFF = 3072, ZOFF = 4096;
constexpr int L_ST = 0, L_W = 1024, L_Z = 1024 + 128 * 272, RS = 272;
__device__ __forceinline__ void unit(int tid, LAS unsigned char* lds, const bf16* P, bf16* CAT, int n, int g, const float* lng, const float* lnb, const float* sgw, const float* sgb) {
    const int lane = tid & 63, wid = __builtin_amdgcn_readfirstlane(tid >> 6), r = lane & 31, hh = lane >> 5;
    const int R0 = n * 128;
    LAS float* st = (LAS float*)(lds + L_ST);
    __syncthreads();
    for (int rr = 0; rr < 16; ++rr) { const int rl = wid * 16 + rr; const bf16* zp = P + (size_t)(R0 + rl) * PITCH + ZOFF + lane * 16;
        const bf16x8 a = *(const bf16x8*)zp, b = *(const bf16x8*)(zp + 8);
        float x[16]; float s = 0.f;
#pragma unroll
        for (int i = 0; i < 8; ++i) { x[i] = bf2f((unsigned short)a[i]); x[8 + i] = bf2f((unsigned short)b[i]); }
#pragma unroll
        for (int i = 0; i < 16; ++i) s += x[i];
        const float mean = wave_sum(s) * (1.0f / 1024.0f); float q = 0.f;
#pragma unroll
        for (int i = 0; i < 16; ++i) { const float d = x[i] - mean; q += d * d; }
        const float rstd = 1.0f / sqrtf(wave_sum(q) * (1.0f / 1024.0f) + EPS);
        if (lane == 0) { st[2 * rl] = mean; st[2 * rl + 1] = rstd; } }
    __syncthreads();
    LAS bf16* ZT = (LAS bf16*)(lds + L_Z); LAS bf16* WT = (LAS bf16*)(lds + L_W);
#pragma unroll
    for (int i = 0; i < 4; ++i) { const int item = tid + 512 * i, sr = item >> 4, ch = item & 15;
        const bf16x8 z = *(const bf16x8*)(P + (size_t)(R0 + sr) * PITCH + ZOFF + g * 128 + ch * 8);
        const float mean = st[2 * sr], rstd = st[2 * sr + 1];
#pragma unroll
        for (int e = 0; e < 8; ++e) { const int c = ch * 8 + e; const float zn = (bf2f((unsigned short)z[e]) - mean) * rstd * lng[g * 128 + c] + lnb[g * 128 + c];
            ZT[c * (RS / 2) + sr] = (bf16)f2bf(zn); } }
#pragma unroll
    for (int i = 0; i < 4; ++i) { const int item = tid + 512 * i, t = item >> 4, sch = item & 15;
        const float* wp = sgw + ((size_t)g * 128 + t) * 128 + sch * 8; const f32x4 a = *(const f32x4*)wp, b = *(const f32x4*)(wp + 4);
        float w[8] = {a.x, a.y, a.z, a.w, b.x, b.y, b.z, b.w};
#pragma unroll
        for (int e = 0; e < 8; ++e) if (sch * 8 + e > t) w[e] = 0.f;
        v4u o; o.x = pk2(w[0], w[1]); o.y = pk2(w[2], w[3]); o.z = pk2(w[4], w[5]); o.w = pk2(w[6], w[7]);
        *(LAS v4u*)(lds + L_W + t * RS + sch * 16) = o; }
    __syncthreads();
    const int tb = wid >> 1, cbp = (wid & 1) * 2;
    f32x16 acc[2];
#pragma unroll
    for (int cc = 0; cc < 2; ++cc)
#pragma unroll
        for (int i = 0; i < 16; ++i) acc[cc][i] = 0.f;
#pragma unroll
    for (int ks = 0; ks < 8; ++ks) {
        if (16 * ks <= 32 * tb + 31) {
            const bf16x8 a = *(const LAS bf16x8*)(lds + L_W + (32 * tb + r) * RS + (16 * ks + 8 * hh) * 2);
#pragma unroll
            for (int cc = 0; cc < 2; ++cc) { const bf16x8 b = *(const LAS bf16x8*)(lds + L_Z + (32 * (cbp + cc) + r) * RS + (16 * ks + 8 * hh) * 2); acc[cc] = MFMA32(a, b, acc[cc]); }
        }
    }
#pragma unroll
    for (int cc = 0; cc < 2; ++cc) { const int c = g * 128 + 32 * (cbp + cc) + r;
#pragma unroll
        for (int i = 0; i < 16; ++i) { const int t = 32 * tb + crow(i, hh); const size_t row = (size_t)(R0 + t);
            const float u = bf2f(P[row * PITCH + UOFF + c]); CAT[row * D + 1024 + c] = (bf16)f2bf(u * (acc[cc][i] + sgb[g * 128 + t])); } }
}
}


namespace dsa {
constexpr int PITCH = CINP, KOFF = 2048, VOFF = 2560, QIOFF = 3072, KIOFF = 4096, WIOFF = 4160;
constexpr float CQ = 0.08838834764831845f * LOG2E;
#define MFMA16(a, b, c) __builtin_amdgcn_mfma_f32_16x16x32_bf16((a), (b), (c), 0, 0, 0)
__device__ __forceinline__ float relu_asm(float x) { float r; asm("v_max_f32_e32 %0, 0, %1" : "=v"(r) : "v"(x)); return r; }
constexpr int L_HIST = 0, L_SEL = 0, L_CS = 16384, L_CK = 32768, L_KT = 65536, L_META = 131072, L_TMP = 131584;
#define IDX_WAIT_BAR(N) asm volatile("s_waitcnt vmcnt(" #N ") lgkmcnt(0)\n\ts_barrier" ::: "memory")
constexpr int NCAND = 128;
__device__ __forceinline__ void dma_ktile(LAS unsigned char* lds, const bf16* P, int t, int buf, int wid, int lane) {
#pragma unroll
    for (int i = 0; i < 2; ++i) { const int piece = wid * 2 + i, row = piece * 8 + (lane >> 3), pc = lane & 7, c = pc ^ ((row >> 1) & 7);
        glds16(P + (size_t)(128 * t + row) * PITCH + KIOFF + c * 8, (unsigned)__builtin_amdgcn_readfirstlane(lds_addr(lds) + L_KT + buf * 16384 + piece * 1024)); }
}
template <int PASS, bool FULL> __device__ __forceinline__ void score_tile(LAS unsigned char* lds, const LAS unsigned char* KT, int kb_, int key0, int u, int wid, int r, int hh, int qmaxw,
                                                                          const bf16x8 (&aq)[2][4], const float (&w)[2][16], int T0, int T1) {
    LAS unsigned* hist = (LAS unsigned*)(lds + L_HIST); LAS unsigned short* sel = (LAS unsigned short*)(lds + L_SEL);
    LAS float* cs = (LAS float*)(lds + L_CS); LAS unsigned short* ck = (LAS unsigned short*)(lds + L_CK); LAS int* meta = (LAS int*)(lds + L_META);
    bf16x8 bk[2][4];
#pragma unroll
    for (int ks = 0; ks < 4; ++ks) bk[0][ks] = *(const LAS bf16x8*)(KT + (((2 * ks) ^ kb_) << 4));
#pragma unroll
    for (int sb = 0; sb < 4; ++sb) {
        if (sb < 3) {
#pragma unroll
            for (int ks = 0; ks < 4; ++ks) bk[(sb + 1) & 1][ks] = *(const LAS bf16x8*)(KT + (sb + 1) * 4096 + (((2 * ks) ^ kb_) << 4));
        }
        __builtin_amdgcn_sched_barrier(0);
        if (FULL || key0 + 32 * sb <= qmaxw) {
            f32x16 acc[2];
#pragma unroll
            for (int p = 0; p < 2; ++p)
#pragma unroll
                for (int i = 0; i < 16; ++i) acc[p][i] = 0.f;
#pragma unroll
            for (int ks = 0; ks < 4; ++ks)
#pragma unroll
                for (int p = 0; p < 2; ++p) acc[p] = MFMA32(aq[p][ks], bk[sb & 1][ks], acc[p]);
            asm volatile("s_nop 15\n\ts_nop 7" : "+v"(acc[0]), "+v"(acc[1]));
#pragma unroll
            for (int p = 0; p < 2; ++p) {
                float s4[4] = {0.f, 0.f, 0.f, 0.f};
#pragma unroll
                for (int i = 0; i < 16; ++i) s4[i & 3] += relu_asm(acc[p][i]) * w[p][i];
                const float sc = (s4[0] + s4[1]) + (s4[2] + s4[3]);
                const int rl = 4 * wid + 2 * p + hh, key = key0 + 32 * sb + r;
                int b = (int)((sc + 32.0f) * 8.0f); b = b < 0 ? 0 : (b > 511 ? 511 : b);
                if (FULL || key <= 32 * u + rl) {
                    if (PASS == 1) (void)__hip_atomic_fetch_add(&hist[rl * 512 + b], 1u, __ATOMIC_RELAXED, __HIP_MEMORY_SCOPE_WORKGROUP);
                    else { const int T = p ? T1 : T0;
                        if (b > T) { const int pos = __hip_atomic_fetch_add(&meta[rl], 1, __ATOMIC_RELAXED, __HIP_MEMORY_SCOPE_WORKGROUP); if (pos < 256) sel[rl * 256 + pos] = (unsigned short)key; }
                        else if (b == T) { const int pos = __hip_atomic_fetch_add(&meta[32 + rl], 1, __ATOMIC_RELAXED, __HIP_MEMORY_SCOPE_WORKGROUP); if (pos < NCAND) { cs[rl * NCAND + pos] = sc; ck[rl * NCAND + pos] = (unsigned short)key; } } }
                }
            }
        }
    }
}
template <int PASS> __device__ __forceinline__ void score_pass(LAS unsigned char* lds, const bf16* P, int u, int wid, int lane, const bf16x8 (&aq)[2][4], const float (&w)[2][16], int T0, int T1) {
    const int r = lane & 31, hh = lane >> 5;
    const int NT = (32 * u + 32 + 127) >> 7, qmaxw = 32 * u + 4 * wid + 3;
    const int kb0 = hh ^ ((r >> 1) & 7);
    VM_WAIT();
    dma_ktile(lds, P, 0, 0, wid, lane);
    if (NT > 1) dma_ktile(lds, P, 1, 1, wid, lane);
    if (NT > 2) dma_ktile(lds, P, 2, 2, wid, lane);
    if (NT > 2) IDX_WAIT_BAR(4); else if (NT > 1) IDX_WAIT_BAR(2); else IDX_WAIT_BAR(0);
    for (int t = 0; t < NT; ++t) {
        const int buf = t & 3;
        if (t + 3 < NT) dma_ktile(lds, P, t + 3, (t + 3) & 3, wid, lane);
        int kb_ = kb0; asm volatile("" : "+v"(kb_));
        const LAS unsigned char* KT = lds + L_KT + buf * 16384 + r * 128;
        if (128 * t + 127 <= 32 * u) score_tile<PASS, true>(lds, KT, kb_, 128 * t, u, wid, r, hh, qmaxw, aq, w, T0, T1);
        else score_tile<PASS, false>(lds, KT, kb_, 128 * t, u, wid, r, hh, qmaxw, aq, w, T0, T1);
        if (t + 3 < NT) IDX_WAIT_BAR(4); else if (t + 2 < NT) IDX_WAIT_BAR(2); else IDX_WAIT_BAR(0);
    }
}
__device__ __forceinline__ void index_phase(Frame& F, const bf16* P, unsigned short* SEL) {
    LAS unsigned char* lds = F.lds; const int wid = F.wave;
    LAS unsigned* hist = (LAS unsigned*)(lds + L_HIST); LAS unsigned short* sel = (LAS unsigned short*)(lds + L_SEL);
    LAS float* cs = (LAS float*)(lds + L_CS); LAS unsigned short* ck = (LAS unsigned short*)(lds + L_CK); LAS int* meta = (LAS int*)(lds + L_META);
    for (int ui = F.vcu; ui < 512; ui += F.G) {
        int tid = F.tid; asm volatile("" : "+v"(tid));
        const int lane = tid & 63, r = lane & 31, hh = lane >> 5;
        const int u = (ui < 256) ? ui : 767 - ui;
        __syncthreads();
        if (u < 8) {
            for (int e = tid; e < 32 * 256; e += 512) { const int q = 32 * u + (e >> 8), jj = e & 255; SEL[(size_t)q * 256 + jj] = (unsigned short)(jj <= q ? jj : 0); }
            continue;
        }
        { v4u z = {0u, 0u, 0u, 0u};
#pragma unroll
            for (int i = 0; i < 8; ++i) *(LAS v4u*)(lds + L_HIST + (tid + 512 * i) * 16) = z;
            if (tid < 128) meta[tid] = 0; }
        bf16x8 aq[2][4]; float w[2][16];
#pragma unroll
        for (int p = 0; p < 2; ++p) { const int qrow = 32 * u + 4 * wid + 2 * p + ((r >> 2) & 1), head = (r & 3) + 4 * (r >> 3);
#pragma unroll
            for (int ks = 0; ks < 4; ++ks) aq[p][ks] = *(const bf16x8*)(P + (size_t)qrow * PITCH + QIOFF + head * 64 + ks * 16 + hh * 8);
            const bf16* wp = P + (size_t)(32 * u + 4 * wid + 2 * p + hh) * PITCH + WIOFF;
            const bf16x8 w0 = *(const bf16x8*)wp, w1 = *(const bf16x8*)(wp + 8);
#pragma unroll
            for (int i = 0; i < 8; ++i) { w[p][i] = bf2f((unsigned short)w0[i]) * 0.125f; w[p][8 + i] = bf2f((unsigned short)w1[i]) * 0.125f; } }
        __syncthreads();
        score_pass<1>(lds, P, u, wid, lane, aq, w, 0, 0);
        LAS int* tmp = (LAS int*)(lds + L_TMP) + wid * 64;
        for (int rr = 0; rr < 4; ++rr) { const int rl = 4 * wid + rr;
            unsigned cw[8]; { const v4u a = *(const LAS v4u*)(hist + rl * 512 + 8 * lane), b = *(const LAS v4u*)(hist + rl * 512 + 8 * lane + 4);
                cw[0] = a.x; cw[1] = a.y; cw[2] = a.z; cw[3] = a.w; cw[4] = b.x; cw[5] = b.y; cw[6] = b.z; cw[7] = b.w; }
            int ls = 0;
#pragma unroll
            for (int i = 0; i < 8; ++i) ls += (int)cw[i];
            int suf = ls;
#pragma unroll
            for (int off = 1; off < 64; off <<= 1) { tmp[lane] = suf; LDS_WAIT(); const int o2 = lane + off; const int v = tmp[o2 < 64 ? o2 : 63]; LDS_WAIT(); suf += (o2 < 64) ? v : 0; }
            const unsigned long long bal = __ballot(suf >= 256);
            const int L = 63 - __builtin_clzll(bal | 1ull);
            if (lane == L) { int cum = suf - ls, T = 8 * L, cab = cum; bool found = false;
#pragma unroll
                for (int bb = 7; bb >= 0; --bb) { const int cnt = (int)cw[bb];
                    if (!found) { if (cum + cnt >= 256) { T = 8 * L + bb; cab = cum; found = true; } else cum += cnt; } }
                meta[64 + rl] = T; meta[96 + rl] = cab; }
            LDS_WAIT(); asm volatile("" ::: "memory"); }
        __syncthreads();
        { v4u z = {0u, 0u, 0u, 0u};
#pragma unroll
            for (int i = 0; i < 2; ++i) *(LAS v4u*)(lds + L_SEL + (tid + 512 * i) * 16) = z; }
        const int T0 = meta[64 + 4 * wid + hh], T1 = meta[64 + 4 * wid + 2 + hh];
        score_pass<2>(lds, P, u, wid, lane, aq, w, T0, T1);
        for (int rr = 0; rr < 4; ++rr) { const int rl = 4 * wid + rr; const int cab = meta[96 + rl], need = 256 - cab; int m = meta[32 + rl]; m = m > NCAND ? NCAND : m;
#pragma unroll
            for (int half = 0; half < 2; ++half) { const int i = lane + 64 * half; const float si = cs[rl * NCAND + i]; const int ki = ck[rl * NCAND + i]; int rank = 0;
                for (int j2 = 0; j2 < m; ++j2) { const float sj = cs[rl * NCAND + j2]; const int kj = ck[rl * NCAND + j2]; rank += (sj > si || (sj == si && kj < ki)) ? 1 : 0; }
                if (i < m && rank < need) sel[rl * 256 + cab + rank] = (unsigned short)ki; }
            LDS_WAIT(); asm volatile("" ::: "memory");
            const v2u o = *(const LAS v2u*)(lds + L_SEL + rl * 512 + lane * 8);
            *(GAS v2u*)(SEL + (size_t)(32 * u + rl) * 256 + 4 * lane) = o; }
#if MK_DUP & 128
        __syncthreads(); score_pass<1>(lds, P, u, wid, lane, aq, w, 0, 0);
#endif
#if MK_DUP & 256
        __syncthreads(); score_pass<2>(lds, P, u, wid, lane, aq, w, T0 + 512, T1 + 512);
#endif
    }
}
constexpr int A_LUT = 0, A_SEL = 8448, A_V = 16384;
__device__ __forceinline__ void attn_phase(Frame& F, const bf16* P, const unsigned short* SEL, bf16* CAT, const float* rel) {
    LAS unsigned char* lds = F.lds; const int tid = F.tid, lane = F.lane, wid = F.wave;
    LAS float* lut = (LAS float*)(lds + A_LUT);
    __syncthreads();
    for (int e = tid; e < 129 * 16; e += 512) lut[e] = rel[REL_BUCKET[e >> 4] * 16 + (e & 15)] * LOG2E;
    __syncthreads();
    LAS unsigned short* sb = (LAS unsigned short*)(lds + A_SEL) + wid * 256; LAS unsigned char* vbuf = lds + A_V + wid * 16384;
    const int c16 = lane & 15, q4 = lane >> 4, qq = c16 >> 2, p4 = c16 & 3;
    const int rho = 4 * q4 + qq, vx0 = rho & 7, vbase = rho * 256 + (p4 & 1) * 8;
    const int gw = F.vcu * NWAVES + wid, NGW = F.G * NWAVES;
    for (int q = gw; q < S; q += NGW) {
        const int count = (q + 1 < 256) ? q + 1 : 256;
        *(LAS v2u*)(sb + 4 * lane) = *(const GAS v2u*)(SEL + (size_t)q * 256 + 4 * lane);
        LDS_WAIT(); asm volatile("" ::: "memory");
        for (int g = 0; g < 4; ++g) {
            const int head = 4 * g + (c16 & 3);
            bf16x8 qb[4];
#pragma unroll
            for (int ks = 0; ks < 4; ++ks) qb[ks] = *(const bf16x8*)(P + (size_t)q * PITCH + head * 128 + q4 * 32 + ks * 8);
            f32x4 s[16];
#pragma unroll
            for (int bt = 0; bt < 2; ++bt) {
                bf16x8 ak[8][4];
#pragma unroll
                for (int b2 = 0; b2 < 8; ++b2) { const int kpos = sb[16 * (8 * bt + b2) + c16]; const bf16* kp = P + (size_t)kpos * PITCH + KOFF + g * 128 + q4 * 32;
#pragma unroll
                    for (int ks = 0; ks < 4; ++ks) ak[b2][ks] = *(const bf16x8*)(kp + ks * 8); }
#pragma unroll
                for (int b2 = 0; b2 < 8; ++b2) { f32x4 a = {0.f, 0.f, 0.f, 0.f};
#pragma unroll
                    for (int ks = 0; ks < 4; ++ks) a = MFMA16(ak[b2][ks], qb[ks], a);
                    s[8 * bt + b2] = a; }
            }
            float mx = -INFINITY;
#pragma unroll
            for (int b = 0; b < 16; ++b) { const v2u kk2 = *(const LAS v2u*)(sb + 16 * b + 4 * q4);
#pragma unroll
                for (int i = 0; i < 4; ++i) { const int jj = 16 * b + 4 * q4 + i; const int kpos = (int)(((i & 2) ? kk2.y : kk2.x) >> ((i & 1) * 16)) & 0xffff;
                    int dist = q - kpos; dist = dist < 0 ? 0 : (dist > 128 ? 128 : dist);
                    (void)jj; s[b][i] += lut[dist * 16 + head]; } }
            if (count < 256) {
                int cnt = count - 4 * q4; asm volatile("" : "+v"(cnt));
#pragma unroll
                for (int b = 0; b < 16; ++b)
#pragma unroll
                    for (int i = 0; i < 4; ++i) if (16 * b + i >= cnt) s[b][i] = -INFINITY; }
#pragma unroll
            for (int b = 0; b < 16; ++b)
#pragma unroll
                for (int i = 0; i < 4; ++i) mx = fmaxf(mx, s[b][i]);
            mx = fmaxf(mx, swz_xor<16>(mx)); mx = max32(mx);
            float sum = 0.f;
#pragma unroll
            for (int b = 0; b < 16; ++b)
#pragma unroll
                for (int i = 0; i < 4; ++i) { const float pv = __builtin_amdgcn_exp2f(s[b][i] - mx); s[b][i] = pv; sum += pv; }
            sum += swz_xor<16>(sum); sum = sum32(sum);
            bf16x8 pb[8];
#pragma unroll
            for (int kk = 0; kk < 8; ++kk) { v4u wv; wv.x = cvtpk(s[2 * kk][0], s[2 * kk][1]); wv.y = cvtpk(s[2 * kk][2], s[2 * kk][3]); wv.z = cvtpk(s[2 * kk + 1][0], s[2 * kk + 1][1]); wv.w = cvtpk(s[2 * kk + 1][2], s[2 * kk + 1][3]);
                pb[kk] = __builtin_bit_cast(bf16x8, wv); }
            f32x4 O[8];
#pragma unroll
            for (int db = 0; db < 8; ++db) O[db] = (f32x4){0.f, 0.f, 0.f, 0.f};
#define SPA_DMA(kk_) do { _Pragma("unroll") for (int pi = 0; pi < 8; ++pi) { const int row = 4 * pi + (lane >> 4), pc = lane & 15, c = pc ^ (2 * (row & 7)); const int kpos = sb[32 * (kk_) + row]; \
                glds16(P + (size_t)kpos * PITCH + VOFF + g * 128 + c * 8, (unsigned)__builtin_amdgcn_readfirstlane(lds_addr(vbuf) + ((kk_) & 1) * 8192 + pi * 1024)); } } while (0)
            VM_WAIT();
            SPA_DMA(0);
#pragma unroll
            for (int kk = 0; kk < 8; ++kk) {
                if (kk < 7) { LDS_WAIT(); SPA_DMA(kk + 1); asm volatile("s_waitcnt vmcnt(8)" ::: "memory"); }
                else asm volatile("s_waitcnt vmcnt(0)" ::: "memory");
                int vx = vx0; asm volatile("" : "+v"(vx));
#pragma unroll
                for (int db = 0; db < 8; ++db) { const LAS unsigned char* a0 = vbuf + (kk & 1) * 8192 + vbase + (((((db ^ vx) << 1) | (p4 >> 1))) << 4);
                    const s16x4 lo = vtr(a0), hi = vtr(a0 + 4096);
                    const bf16x8 vf = (bf16x8){lo[0], lo[1], lo[2], lo[3], hi[0], hi[1], hi[2], hi[3]};
                    O[db] = MFMA16(vf, pb[kk], O[db]); }
            }
#undef SPA_DMA
            if (c16 < 4) { const float inv = 1.0f / sum; GAS bf16* op = (GAS bf16*)CAT + (size_t)q * D + head * 128 + 4 * q4;
#pragma unroll
                for (int db = 0; db < 8; ++db) { v2u wv; wv.x = cvtpk(O[db][0] * inv, O[db][1] * inv); wv.y = cvtpk(O[db][2] * inv, O[db][3] * inv); *(GAS v2u*)(op + 16 * db) = wv; } }
        }
    }
}
}


struct Args;
__device__ __forceinline__ const float* in_ptr(const Args& a, int i);
struct Args { const float* in[19]; float* out; unsigned char* ws; int ph_lo, ph_hi; };
__device__ __forceinline__ const float* in_ptr(const Args& a, int i) { (void)a; extern __shared__ __attribute__((aligned(16))) unsigned char lds_all[];
    const unsigned long long v = ((const LAS unsigned long long*)((LAS unsigned char*)lds_all + INP_OFF))[i];
    const unsigned lo = __builtin_amdgcn_readfirstlane((unsigned)v), hi = __builtin_amdgcn_readfirstlane((unsigned)(v >> 32));
    return (const float*)(((unsigned long long)hi << 32) | lo); }
constexpr int N_PHASES = 45 + ((MK_DUP & 4) ? 2 : 0) + ((MK_DUP & 8) ? 2 : 0) + ((MK_DUP & 64) ? 8 : 0) + ((MK_DUP & 16) ? 1 : 0) + ((MK_DUP & 1) ? 2 : 0) + ((MK_DUP & 2) ? 2 : 0) + ((MK_DUP & 512) ? 8 : 0) + ((MK_DUP & 32) ? 8 : 0);
typedef pg8::StaticOrder SOrd;
#define GEMM_PHASE(EPI, g, E, WGM_) do { int bx_ = (int)blockIdx.x, G_ = F.G; asm volatile("" : "+s"(bx_), "+s"(G_));   \
    SOrd S_; S_.init((g).M, (g).N, G_, bx_, (WGM_)); pg8::gemm_phase<EPI, SOrd, MK_ALIGN, MK_SP2>(F.lds, (g), S_, (E)); } while (0)

__global__ void __launch_bounds__(NWAVES * 64, 2) fwd_kernel(Args args) {
    extern __shared__ __attribute__((aligned(16))) unsigned char lds[];
    Frame F;
    F.lds = (LAS unsigned char*)lds;
    F.tid = threadIdx.x; F.lane = F.tid & 63; F.wave = __builtin_amdgcn_readfirstlane(F.tid >> 6);
    F.G = gridDim.x; { const int bx = blockIdx.x; F.vcu = (F.G % 8 == 0) ? (bx % 8) * (F.G / 8) + bx / 8 : bx; }
    volatile LAS unsigned* MISC = (volatile LAS unsigned*)(F.lds + MISC_OFF);
    if (F.tid < 64) MISC[F.tid] = 0u;
    if (F.tid == 0) { LAS unsigned long long* ip = (LAS unsigned long long*)(F.lds + INP_OFF);
#pragma unroll
        for (int i = 0; i < 19; ++i) ip[i] = (unsigned long long)args.in[i]; }
    __syncthreads();
    const int lo = args.ph_lo, hi = args.ph_hi;
    XcdBarrier bar; bar.bar = (unsigned*)(args.ws + WS_CTL) + CW_BAR; bar.x = 0; bar.st = nullptr;
    if (hi - lo > 1) bar = xcd_barrier_post((unsigned*)(args.ws + WS_CTL) + CW_BAR, MISC + 8, F.wave);
    int ph = 0;
#define RUN() (lo <= ph && ph < hi)
#define SEAM() do { if (lo <= ph && ph + 1 < hi) { XcdBarrier b_ = bar; asm volatile("" : "+s"(b_.bar), "+s"(b_.x));   xcd_barrier(b_, F.wave); } ++ph; } while (0)

#define WSP() unsigned char* ws = args.ws; asm volatile("" : "+s"(ws)); \
    { int t_ = threadIdx.x; asm volatile("" : "+v"(t_)); F.tid = t_; F.lane = t_ & 63; }     \
    float* XRES = (float*)(ws + WS_XRES); bf16* XN = (bf16*)(ws + WS_XN); bf16* H = (bf16*)(ws + WS_H); bf16* PROJ = (bf16*)(ws + WS_PROJ); bf16* CAT = (bf16*)(ws + WS_CAT); \
    const float* NA = (const float*)(ws + WS_VEC); const float* NB = NA + 12 * 2048; const float* GT = NB + 12 * 2048; \
    (void)XRES; (void)XN; (void)H; (void)PROJ; (void)CAT; (void)NA; (void)NB; (void)GT;
#define INP(i) in_ptr(args, (i))

    if (RUN()) { WSP(); prologue_phase(F, args, ws); }
#if MK_DUP & 16
    SEAM(); if (RUN()) { WSP(); prologue_phase(F, args, ws); }
#endif
    SEAM();
    if (RUN()) { WSP(); vec_phase(F, args, ws); }
    SEAM();

    for (int s = 0; s < 8; ++s) {
        asm volatile("" : "+s"(F.wave), "+s"(F.vcu), "+s"(F.G));
        const int l = s >> 1, f = s & 1, jn = f ? 2 : 0;
        if (RUN()) { WSP(); const float* xsrc = (s == 0) ? INP(0) : XRES; norm_phase(F, xsrc, NA + (l * 3 + jn) * 2048, NB + (l * 3 + jn) * 2048, XN); }
        SEAM();
#if MK_DUP & 32
        if (RUN()) { WSP(); const float* xsrc = (s == 0) ? INP(0) : XRES; norm_phase(F, xsrc, NA + (l * 3 + jn) * 2048, NB + (l * 3 + jn) * 2048, XN); }
        SEAM();
#endif
        if (RUN()) { WSP(); pg8::Gemm g{XN, (const bf16*)(ws + WS_W1T) + (size_t)s * W1T_SZ, S, 2 * DFF, D, 0}; pg8::EpiSwiglu E{H, DFF}; GEMM_PHASE(pg8::EpiSwiglu, g, E, MK_WGM_UP); }
        SEAM();
#if MK_DUP & 64
        if (RUN()) { WSP(); pg8::Gemm g{XN, (const bf16*)(ws + WS_W1T) + (size_t)s * W1T_SZ, S, 2 * DFF, D, 0}; pg8::EpiSwiglu E{H, DFF}; GEMM_PHASE(pg8::EpiSwiglu, g, E, MK_WGM_UP); }
        SEAM();
#endif
        if (RUN()) { WSP(); const float* xsrc = (s == 0) ? INP(0) : XRES; pg8::Gemm g{H, (const bf16*)(ws + WS_W2T) + (size_t)s * W2T_SZ, S, D, DFF, 1}; pg8::EpiResid E{xsrc, XRES, GT + (l * 3 + jn) * 2048, D}; GEMM_PHASE(pg8::EpiResid, g, E, MK_WGM_DN); }
        SEAM();
#if MK_DUP & 512
        if (RUN()) { WSP(); pg8::Gemm g{H, (const bf16*)(ws + WS_W2T) + (size_t)s * W2T_SZ, S, D, DFF, 1}; pg8::EpiResid E{XRES, XRES, (const float*)(ws + WS_CTL + 524288), D}; GEMM_PHASE(pg8::EpiResid, g, E, MK_WGM_OUT); }
        SEAM();
#endif
        if (f == 0) {
            if (RUN()) { WSP(); norm_phase(F, XRES, NA + (l * 3 + 1) * 2048, NB + (l * 3 + 1) * 2048, XN); }
            SEAM();
            const int j = l >> 1;
            if ((l & 1) == 0) {
                if (RUN()) { WSP(); pg8::Gemm g{XN, (const bf16*)(ws + WS_ABIN) + (size_t)j * ABIN_SZ, S, ABN, D, 0}; pg8::EpiProj E{PROJ, ABN, 4, da::C2, 12}; GEMM_PHASE(pg8::EpiProj, g, E, MK_WGM_IN); }
                SEAM();
                if (RUN()) {
#if MK_AB
                    WSP();
                    const float* lp = INP(10) + j * 256;
                    const float s01 = wave_sum(lp[F.lane] * lp[64 + F.lane]), s23 = wave_sum(lp[128 + F.lane] * lp[192 + F.lane]);
                    const float lam_init = (j == 0) ? 0.2f : 0.4707130183435842f;
                    const float lam = expf(s01) - expf(s23) + lam_init;
                    for (int ui = F.vcu; ui < 1024; ui += F.G) { const int v = ui & 255, k = ui >> 8, h = v >> 5, p = v & 31;
                        const int qb = (k == 0) ? p : (k == 1) ? 127 - p : (k == 2) ? 63 - p : 64 + p;
                        da::unit(F.tid, F.lds, PROJ, CAT, h, qb, lam, 1.0f - lam_init, INP(11) + j * 128, INP(7)); }
                    for (int ui = F.vcu; ui < 1024; ui += F.G)
                        sgp::unit(F.tid, F.lds, PROJ, CAT, ui >> 3, ui & 7, INP(12) + j * 1024, INP(13) + j * 1024, INP(14) + (size_t)j * 8 * 128 * 128, INP(15) + j * 8 * 128);
#endif
                }
                SEAM();
#if MK_DUP & 2
                if (RUN()) { WSP();
                    for (int ui = F.vcu; ui < 1024; ui += F.G)
                        sgp::unit(F.tid, F.lds, PROJ, CAT, ui >> 3, ui & 7, INP(12) + j * 1024, INP(13) + j * 1024, INP(14) + (size_t)j * 8 * 128 * 128, INP(15) + j * 8 * 128); }
                SEAM();
#endif
#if MK_DUP & 1
                if (RUN()) {
#if MK_AB
                    WSP();
                    const float* lp = INP(10) + j * 256;
                    const float s01 = wave_sum(lp[F.lane] * lp[64 + F.lane]), s23 = wave_sum(lp[128 + F.lane] * lp[192 + F.lane]);
                    const float lam_init = (j == 0) ? 0.2f : 0.4707130183435842f;
                    const float lam = expf(s01) - expf(s23) + lam_init;
                    for (int ui = F.vcu; ui < 1024; ui += F.G) { const int v = ui & 255, k = ui >> 8, h = v >> 5, p = v & 31;
                        const int qb = (k == 0) ? p : (k == 1) ? 127 - p : (k == 2) ? 63 - p : 64 + p;
                        da::unit(F.tid, F.lds, PROJ, CAT, h, qb, lam, 1.0f - lam_init, INP(11) + j * 128, INP(7)); }
                    for (int ui = F.vcu; ui < 1024; ui += F.G)
                        sgp::unit(F.tid, F.lds, PROJ, CAT, ui >> 3, ui & 7, INP(12) + j * 1024, INP(13) + j * 1024, INP(14) + (size_t)j * 8 * 128 * 128, INP(15) + j * 8 * 128);
#endif
                }
                SEAM();
#endif
                if (RUN()) {
#if MK_AB
                    WSP(); pg8::Gemm g{CAT, (const bf16*)(ws + WS_ABOUT) + (size_t)j * SQ_SZ, S, D, D, 0}; pg8::EpiResid E{XRES, XRES, GT + (l * 3 + 1) * 2048, D}; GEMM_PHASE(pg8::EpiResid, g, E, MK_WGM_OUT);
#endif
                }
                SEAM();
            } else {
                if (RUN()) {
#if MK_DSA
                    WSP(); pg8::Gemm g{XN, (const bf16*)(ws + WS_DSAIN) + (size_t)j * DSAIN_SZ, S, CINP, D, 0}; pg8::EpiProj E{PROJ, CINP, 8, dsa::CQ, 1000}; GEMM_PHASE(pg8::EpiProj, g, E, MK_WGM_IN);
#endif
                }
                SEAM();
                if (RUN()) {
#if MK_DSA
                    WSP(); dsa::index_phase(F, PROJ, (unsigned short*)(ws + WS_SEL));
#endif
                }
                SEAM();
#if MK_DUP & 4
                if (RUN()) { WSP(); dsa::index_phase(F, PROJ, (unsigned short*)(ws + WS_SEL)); }
                SEAM();
#endif
                if (RUN()) {
#if MK_DSA
                    WSP(); dsa::attn_phase(F, PROJ, (const unsigned short*)(ws + WS_SEL), CAT, INP(7));
#endif
                }
                SEAM();
#if MK_DUP & 8
                if (RUN()) { WSP(); dsa::attn_phase(F, PROJ, (const unsigned short*)(ws + WS_SEL), CAT, INP(7)); }
                SEAM();
#endif
                if (RUN()) {
#if MK_DSA
                    WSP(); pg8::Gemm g{CAT, (const bf16*)(ws + WS_DSAOUT) + (size_t)j * SQ_SZ, S, D, D, 0}; pg8::EpiResid E{XRES, XRES, GT + (l * 3 + 1) * 2048, D}; GEMM_PHASE(pg8::EpiResid, g, E, MK_WGM_OUT);
#endif
                }
                SEAM();
            }
        }
    }
    if (RUN()) { WSP(); final_norm_phase(F, XRES, INP(18), args.out); }
    ++ph;
#undef RUN
#undef SEAM
}


#if MK_DIAG
__device__ const int DG_ROWS[16] = {0, 129, 255, 256, 1000, 2500, 4097, 6000, 8191, 8192, 9500, 10000, 11111, 12287, 12345, 16383};
__device__ __forceinline__ void dg_max(unsigned* slot, float e) { if (!(e >= 0.f)) e = 1e9f; atomicMax(slot, __builtin_bit_cast(unsigned, e)); }
constexpr int DG_SLOT = 2048;
__global__ void __launch_bounds__(512) diag_check(Args args, int which, int j) {
    extern __shared__ __attribute__((aligned(16))) unsigned char lds[];
    unsigned char* ws = args.ws; unsigned* slot = (unsigned*)(ws + WS_CTL) + DG_SLOT;
    const float* NA = (const float*)(ws + WS_VEC); const float* NB = NA + 12 * 2048; const float* GT = NB + 12 * 2048;
    const bf16* XN = (const bf16*)(ws + WS_XN); const bf16* H = (const bf16*)(ws + WS_H); const float* XRES = (const float*)(ws + WS_XRES);
    const bf16* PROJ = (const bf16*)(ws + WS_PROJ); const bf16* CAT = (const bf16*)(ws + WS_CAT);
    const int tid = threadIdx.x; float* fl = (float*)lds;
    const int row = DG_ROWS[blockIdx.x & 15]; const int sub = blockIdx.x >> 4;
    float err = 0.f;
    if (which == 1) {
        const float* x = args.in[0] + (size_t)row * D; float ss = 0.f;
        for (int c = 0; c < D; ++c) ss += x[c] * x[c];
        const float rstd = 1.0f / sqrtf(ss / D + EPS);
        for (int c = tid; c < D; c += 512) err = fmaxf(err, fabsf(x[c] * rstd * NA[c] + NB[c] - bf2f(XN[(size_t)row * D + c])));
    } else if (which == 2) {
        const float* w1 = args.in[5] + (size_t)j * D * 2 * DFF;
        for (int c = tid; c < DFF; c += 512) { float g = 0.f, u = 0.f;
            for (int k = 0; k < D; ++k) { const float a = bf2f(XN[(size_t)row * D + k]); g += a * w1[(size_t)k * 2 * DFF + c]; u += a * w1[(size_t)k * 2 * DFF + DFF + c]; }
            const float ref = g / (1.0f + expf(-g)) * u; err = fmaxf(err, fabsf(ref - bf2f(H[(size_t)row * DFF + c]))); }
    } else if (which == 3) {
        const float* w2 = args.in[6] + (size_t)j * DFF * D; const float* x = (j == 0) ? args.in[0] : (const float*)(ws + WS_END);
        const float* gt = GT + ((j >> 1) * 3 + ((j & 1) ? 2 : 0)) * 2048;
        for (int c = tid; c < D; c += 512) { float a = 0.f;
            for (int k = 0; k < DFF; ++k) a += bf2f(H[(size_t)row * DFF + k]) * w2[(size_t)k * D + c];
            err = fmaxf(err, fabsf(x[(size_t)row * D + c] + gt[c] * a - XRES[(size_t)row * D + c])); }
    } else if (which == 4) {
        const float* w = args.in[8] + (size_t)j * D * ABN;
        for (int c = tid; c < ABN; c += 512) { float a = 0.f;
            for (int k = 0; k < D; ++k) a += bf2f(XN[(size_t)row * D + k]) * w[(size_t)k * ABN + c];
            if (c < 1024) a *= da::C2; if (c >= 3072) a = 0.5f * a * (1.0f + tanhf(0.7978845608028654f * (a + 0.044715f * a * a * a)));
            err = fmaxf(err, fabsf(a - bf2f(PROJ[(size_t)row * ABN + c]))); }
    } else if (which == 5) {
        const int h = sub;
        const float* lp = args.in[10] + j * 256; float s01 = 0.f, s23 = 0.f;
        for (int i = 0; i < 64; ++i) { s01 += lp[i] * lp[64 + i]; s23 += lp[128 + i] * lp[192 + i]; }
        const float lam_init = 0.8f - 0.6f * expf(-0.3f * (2 * j)), lam = expf(s01) - expf(s23) + lam_init;
        float* lg = fl;
        float* red = fl + 2 * 16384;
        for (int m = 0; m < 2; ++m) {
            for (int key = tid; key <= row; key += 512) { float a = 0.f;
                for (int d = 0; d < 64; ++d) a += bf2f(PROJ[(size_t)row * ABN + h * 128 + m * 64 + d]) * bf2f(PROJ[(size_t)key * ABN + 1024 + h * 128 + m * 64 + d]);
                const int dist = row - key; a += args.in[7][REL_BUCKET[dist > 128 ? 128 : dist] * 16 + h * 2 + m] * LOG2E; lg[m * 16384 + key] = a; }
        }
        __syncthreads();
        float mx[2], sm[2];
        for (int m = 0; m < 2; ++m) { float v = -INFINITY; for (int key = tid; key <= row; key += 512) v = fmaxf(v, lg[m * 16384 + key]);
            red[tid] = v; __syncthreads(); if (tid == 0) { float t = -INFINITY; for (int i = 0; i < 512; ++i) t = fmaxf(t, red[i]); red[512] = t; } __syncthreads(); mx[m] = red[512]; __syncthreads();
            float s = 0.f; for (int key = tid; key <= row; key += 512) s += exp2f(lg[m * 16384 + key] - mx[m]);
            red[tid] = s; __syncthreads(); if (tid == 0) { float t = 0.f; for (int i = 0; i < 512; ++i) t += red[i]; red[512] = t; } __syncthreads(); sm[m] = red[512]; __syncthreads(); }
        const int e = tid & 127, part = tid >> 7; float o = 0.f;
        for (int key = part; key <= row; key += 4) { const float p = exp2f(lg[key] - mx[0]) / sm[0] - lam * exp2f(lg[16384 + key] - mx[1]) / sm[1]; o += p * bf2f(PROJ[(size_t)key * ABN + 2048 + h * 128 + e]); }
        red[tid] = o; __syncthreads();
        if (tid < 128) { o = red[tid] + red[128 + tid] + red[256 + tid] + red[384 + tid]; red[512 + tid] = o * o; red[tid] = o; } __syncthreads();
        if (tid == 0) { float t = 0.f; for (int i = 0; i < 128; ++i) t += red[512 + i]; red[700] = t; } __syncthreads();
        if (tid < 128) { const float ref = red[tid] / sqrtf(red[700] / 128.0f + EPS) * args.in[11][j * 128 + tid] * (1.0f - lam_init);
            err = fabsf(ref - bf2f(CAT[(size_t)row * D + h * 128 + tid])); }
    } else if (which == 7) {
        const float* w2 = args.in[6]; const float* x = args.in[0]; const float* wo = args.in[9] + (size_t)j * D * D;
        for (int c = tid; c < D; c += 512) { float a = 0.f, b = 0.f;
            for (int k = 0; k < DFF; ++k) a += bf2f(H[(size_t)row * DFF + k]) * w2[(size_t)k * D + c];
            for (int k = 0; k < D; ++k) b += bf2f(CAT[(size_t)row * D + k]) * wo[(size_t)k * D + c];
            err = fmaxf(err, fabsf(x[(size_t)row * D + c] + GT[c] * a + GT[2048 + c] * b - XRES[(size_t)row * D + c])); }
    } else if (which == 8) {
        const int lj = sub, l = lj / 3, jj = lj % 3;
        if (tid < 8) { const int col = (DG_ROWS[blockIdx.x & 15] + 257 * tid) & 2047; float mv[3];
            for (int t = 0; t < 3; ++t) { const int n = (3 * jj + t) * 2048 + col; float a = args.in[4][l * NMODV + n];
                for (int k = 0; k < 2048; ++k) { const float cv = args.in[1][k]; a += cv / (1.0f + expf(-cv)) * args.in[3][((size_t)l * 2048 + k) * NMODV + n]; } mv[t] = a; }
            err = fmaxf(fabsf(args.in[2][lj * 2048 + col] * (1.0f + mv[1]) - NA[lj * 2048 + col]), fabsf(mv[0] - NB[lj * 2048 + col]));
            err = fmaxf(err, fabsf((jj == 1 ? 1.0f : 0.5f) * (1.0f + mv[2]) - GT[lj * 2048 + col])); }
    } else if (which == 9) {
        const float* x = XRES + (size_t)row * D; float ss = 0.f;
        for (int c = 0; c < D; ++c) ss += x[c] * x[c];
        const float rstd = 1.0f / sqrtf(ss / D + EPS);
        for (int c = tid; c < D; c += 512) err = fmaxf(err, fabsf(x[c] * rstd * args.in[18][c] - args.out[(size_t)row * D + c]));
    } else if (which == 6) {
        const int n = row >> 7, t = row & 127; float* st = fl;
        for (int s = tid; s <= t; s += 512) { const bf16* z = PROJ + (size_t)(n * 128 + s) * ABN + 4096; float m = 0.f; for (int c = 0; c < 1024; ++c) m += bf2f(z[c]); m /= 1024.0f;
            float q = 0.f; for (int c = 0; c < 1024; ++c) { const float d = bf2f(z[c]) - m; q += d * d; } st[2 * s] = m; st[2 * s + 1] = 1.0f / sqrtf(q / 1024.0f + EPS); }
        __syncthreads();
        for (int c = tid; c < 1024; c += 512) { const int g = c >> 7; float a = 0.f;
            for (int s = 0; s <= t; ++s) { const float zn = (bf2f(PROJ[(size_t)(n * 128 + s) * ABN + 4096 + c]) - st[2 * s]) * st[2 * s + 1] * args.in[12][j * 1024 + c] + args.in[13][j * 1024 + c];
                a += args.in[14][(((size_t)j * 8 + g) * 128 + t) * 128 + s] * zn; }
            a += args.in[15][(j * 8 + g) * 128 + t];
            const float ref = bf2f(PROJ[(size_t)row * ABN + 3072 + c]) * a; err = fmaxf(err, fabsf(ref - bf2f(CAT[(size_t)row * D + 1024 + c]))); }
    }
    dg_max(slot, err);
}
__global__ void diag_out(Args args) {
    const size_t i = (size_t)blockIdx.x * 256 + threadIdx.x; const unsigned* slot = (const unsigned*)(args.ws + WS_CTL) + DG_SLOT;
    if (i < (size_t)S * D) args.out[i] = (i == 0) ? 10.0f + 1.0e4f * __builtin_bit_cast(float, slot[0]) : 0.f;
}
#endif

extern "C" void kernel_launch(void* const* d_in, const int* in_sizes, int n_in, void* d_out, int out_size, void* d_ws, size_t ws_size, hipStream_t stream) {
    static int grid = 0;
    if (grid == 0) {
        if (n_in != 19 || in_sizes[0] != S * D || out_size != S * D || ws_size < WS_END) { fprintf(stderr, "kernel_launch: unexpected shapes (n_in %d, in0 %d, out %d, ws %zu); nothing launched\n", n_in, n_in > 0 ? in_sizes[0] : -1, out_size, ws_size); grid = -1; return; }
        int dev = 0, cus = 0, per_cu = 0;
        if (hipGetDevice(&dev) != hipSuccess || hipDeviceGetAttribute(&cus, hipDeviceAttributeMultiprocessorCount, dev) != hipSuccess) { grid = -1; return; }
        if (hipFuncSetAttribute((const void*)fwd_kernel, hipFuncAttributeMaxDynamicSharedMemorySize, LDS_BYTES) != hipSuccess) { fprintf(stderr, "kernel_launch: hipFuncSetAttribute failed\n"); grid = -1; return; }
        if (hipOccupancyMaxActiveBlocksPerMultiprocessor(&per_cu, (const void*)fwd_kernel, NWAVES * 64, LDS_BYTES) != hipSuccess || per_cu < 1)
            fprintf(stderr, "kernel_launch: note: occupancy query reports %d workgroups per CU\n", per_cu);
        (void)hipGetLastError();
        grid = cus;
    }
    if (grid < 0) return;
    if (hipMemsetAsync((char*)d_ws + WS_CTL, 0, CTL_ZERO_BYTES, stream) != hipSuccess) return;
    Args a{};
    for (int i = 0; i < 19; ++i) a.in[i] = (const float*)d_in[i];
    a.out = (float*)d_out; a.ws = (unsigned char*)d_ws;
#if MK_DIAG == 99
    {
        hipFuncSetAttribute((const void*)diag_check, hipFuncAttributeMaxDynamicSharedMemorySize, 143360);
        const int up_ph[8] = {3, 10, 13, 21, 24, 31, 34, 42}; int done = -1;
        for (int s = 1; s < 8; ++s) {
            for (int p = done + 1; p <= up_ph[s]; ++p) { a.ph_lo = p; a.ph_hi = p + 1; hipLaunchKernelGGL(fwd_kernel, dim3(grid), dim3(NWAVES * 64), LDS_BYTES, stream, a); }
            if (s == 1) hipLaunchKernelGGL(diag_check, dim3(16 * 12), dim3(512), 143360, stream, a, 8, 0);
            hipLaunchKernelGGL(diag_check, dim3(16), dim3(512), 143360, stream, a, 2, s);
            hipMemcpyAsync((char*)d_ws + WS_END, (char*)d_ws + WS_XRES, (size_t)S * D * 4, hipMemcpyDeviceToDevice, stream);
            a.ph_lo = up_ph[s] + 1; a.ph_hi = up_ph[s] + 2; hipLaunchKernelGGL(fwd_kernel, dim3(grid), dim3(NWAVES * 64), LDS_BYTES, stream, a);
            done = up_ph[s] + 1;
            hipLaunchKernelGGL(diag_check, dim3(16), dim3(512), 143360, stream, a, 3, s);
        }
        for (int p = done + 1; p < N_PHASES; ++p) { a.ph_lo = p; a.ph_hi = p + 1; hipLaunchKernelGGL(fwd_kernel, dim3(grid), dim3(NWAVES * 64), LDS_BYTES, stream, a); }
        hipLaunchKernelGGL(diag_check, dim3(16), dim3(512), 143360, stream, a, 9, 0);
        hipLaunchKernelGGL(diag_out, dim3((S * D + 255) / 256), dim3(256), 0, stream, a);
        return;
    }
#elif MK_DIAG
    {
        int digits[8], nd = 0; for (int v = MK_DIAG; v > 0; v /= 10) digits[nd++] = v % 10;
        hipFuncSetAttribute((const void*)diag_check, hipFuncAttributeMaxDynamicSharedMemorySize, 143360);
        int done = -1;
        for (int stage = 0; stage < 3; ++stage) {
            const int upto = ((stage == 0) ? 4 : (stage == 1) ? 7 : 8) + (MK_DIAGJ ? 21 : 0); bool any = false;
            for (int i = 0; i < nd; ++i) { const int w = digits[i]; const int st = (w <= 3) ? 0 : (w <= 6) ? 1 : 2; any |= (st == stage); }
            if (!any) continue;
            for (int p = done + 1; p <= upto; ++p) { a.ph_lo = p; a.ph_hi = p + 1; hipLaunchKernelGGL(fwd_kernel, dim3(grid), dim3(NWAVES * 64), LDS_BYTES, stream, a); }
            done = upto;
            for (int i = 0; i < nd; ++i) { const int w = digits[i]; const int st = (w <= 3) ? 0 : (w <= 6) ? 1 : 2; if (st == stage) hipLaunchKernelGGL(diag_check, dim3(w == 5 ? 128 : 16), dim3(512), 143360, stream, a, w, MK_DIAGJ); }
        }
        hipLaunchKernelGGL(diag_out, dim3((S * D + 255) / 256), dim3(256), 0, stream, a);
        return;
    }
#endif
#if MK_MULTI
    for (int p = 0; p < N_PHASES; ++p) { a.ph_lo = p; a.ph_hi = p + 1; hipLaunchKernelGGL(fwd_kernel, dim3(grid), dim3(NWAVES * 64), LDS_BYTES, stream, a); }
#else
    a.ph_lo = 0; a.ph_hi = N_PHASES;
    hipLaunchKernelGGL(fwd_kernel, dim3(grid), dim3(NWAVES * 64), LDS_BYTES, stream, a);
#endif
    const hipError_t le = hipPeekAtLastError();
    if (le != hipSuccess) fprintf(stderr, "kernel_launch: launch failed: %s\n", hipGetErrorName(le));
}
```

```cpp
#define MK_MULTI 0
#define MK_AB 1
#define MK_DSA 1
#include <hip/hip_runtime.h>
#include <cstdio>
#include <cstdint>
#ifndef MK_DIAG
#define MK_DIAG 0
#endif
#ifndef MK_DIAGJ
#define MK_DIAGJ 0
#endif
#ifndef MK_DUP
#define MK_DUP 0
#endif
#ifndef MK_SP2
#define MK_SP2 true
#endif
#ifndef MK_ALIGN
#define MK_ALIGN true
#endif
#ifndef MK_WGM_UP
#define MK_WGM_UP 4
#endif
#ifndef MK_WGM_DN
#define MK_WGM_DN 2
#endif
#ifndef MK_WGM_IN
#define MK_WGM_IN 4
#endif
#ifndef MK_WGM_OUT
#define MK_WGM_OUT 4
#endif
#ifndef MK_MULTI
#define MK_MULTI 0
#endif

namespace pg8 {
#define PG8_LAS __attribute__((address_space(3)))
typedef unsigned short bf16_t;
typedef short bf16x8 __attribute__((ext_vector_type(8)));
typedef float f32x4 __attribute__((ext_vector_type(4)));
typedef unsigned u32x4 __attribute__((ext_vector_type(4)));
constexpr int BM = 256, BK = 64, HALF = 128, HTB = HALF * BK * 2  , STAGE_BYTES = 8 * HTB, NXCD = 8;

__host__ __device__ __forceinline__ int lds_byte(int r, int c) { const int st = (r >> 4) * 2 + (c >> 5), rr = r & 15, cc = c & 31, ob = rr * 64 + cc * 2; return st * 1024 + (ob ^ (((ob >> 9) & 1) << 5)); }
__host__ __device__ __forceinline__ void stage_rc(int b, int& R, int& C) { const int st = b / 1024, sb = b % 1024, swz = sb ^ (((sb >> 9) & 1) << 5); R = (st >> 1) * 16 + swz / 64; C = (st & 1) * 32 + (swz % 64) / 2; }
__host__ __device__ __forceinline__ int perm32(int rho) { const int n = rho >> 4, i = rho & 15; return 8 * (i >> 2) + 4 * n + (i & 3); }

struct Unit { int pm, pn; };
struct Gemm { const bf16_t* A; const bf16_t* Bt; int M, N, K; int atile; };

struct StaticOrder {
    int nM, nN, nwg, G, c, WGM;
    __host__ __device__ void init(int M, int N, int G_, int c_, int wgm) { nM = M / BM; nN = N / BM; nwg = nM * nN; G = G_; c = c_; WGM = wgm; }
    __host__ __device__ bool next(int i, Unit& u) const {
        const long L = (long)i * G + c; if (L >= nwg) return false;
        int wgid = (int)L; { const int q = nwg / NXCD, r = nwg % NXCD, xcd = wgid % NXCD, off = wgid / NXCD; wgid = (xcd < r ? xcd * (q + 1) : r * (q + 1) + (xcd - r) * q) + off; }
        const int nig = WGM * nN, gid = wgid / nig, fm = gid * WGM, gsz = (nM - fm) < WGM ? (nM - fm) : WGM;
        u.pm = fm + ((wgid % nig) % gsz); u.pn = (wgid % nig) / gsz; return true;
    }
    __device__ __forceinline__ void a_ready(const Unit&) const {}
    __device__ __forceinline__ void done(const Unit&) const {}
};

__device__ __forceinline__ unsigned cvt_pk_bf16(float lo, float hi) { unsigned r; asm volatile("v_cvt_pk_bf16_f32 %0, %1, %2" : "=v"(r) : "v"(lo), "v"(hi)); return r; }
typedef float f32x2 __attribute__((ext_vector_type(2)));

__device__ __forceinline__ float fast_sigmoid(float x) { return __builtin_amdgcn_rcpf(1.0f + __builtin_amdgcn_exp2f(-1.4426950408889634f * x)); }
struct EpiSwiglu {
    static constexpr bool PERM = true, AFTER_DRAIN = false;
    bf16_t* O; int ldc;
    __device__ __forceinline__ void operator()(const f32x4 (&acc)[2][2][4][2], const Unit& u, int wr, int wc, int fr, int fq) const {
        const int rl0 = wr * 64 + fr, col0 = u.pn * HALF + wc * 32 + 8 * fq, kt = col0 >> 6, c = col0 & 63;
        bf16_t* tile = O + ((size_t)u.pm * (ldc >> 6) + kt) * (BM * BK) + c;
#pragma unroll
        for (int ai = 0; ai < 2; ++ai)
#pragma unroll
            for (int m = 0; m < 4; ++m) { bf16_t* rowp = tile + (size_t)(rl0 + ai * HALF + m * 16) * BK;
                const f32x4 g0 = acc[ai][0][m][0], g1 = acc[ai][0][m][1], u0 = acc[ai][1][m][0], u1 = acc[ai][1][m][1];
                float v[8];
#pragma unroll
                for (int j = 0; j < 4; ++j) { v[j] = g0[j] * fast_sigmoid(g0[j]) * u0[j]; v[4 + j] = g1[j] * fast_sigmoid(g1[j]) * u1[j]; }
                u32x4 w; w.x = cvt_pk_bf16(v[0], v[1]); w.y = cvt_pk_bf16(v[2], v[3]); w.z = cvt_pk_bf16(v[4], v[5]); w.w = cvt_pk_bf16(v[6], v[7]);
                *(u32x4*)rowp = w; }
    }
};
struct EpiResid {
    static constexpr bool PERM = false, AFTER_DRAIN = false;
    const float* base; float* out; const float* coef; int ldc;
    __device__ __forceinline__ void operator()(const f32x4 (&acc)[2][2][4][2], const Unit& u, int wr, int wc, int fr, int fq) const {
        const int row0 = u.pm * BM + wr * 64 + fr, col0 = u.pn * BM + wc * 32 + 4 * fq;
        f32x4 cv[2][2];
#pragma unroll
        for (int bj = 0; bj < 2; ++bj)
#pragma unroll
            for (int n = 0; n < 2; ++n) cv[bj][n] = *(const f32x4*)(coef + col0 + bj * HALF + n * 16);
#pragma unroll
        for (int ai = 0; ai < 2; ++ai)
#pragma unroll
            for (int m = 0; m < 4; ++m) { const size_t off = (size_t)(row0 + ai * HALF + m * 16) * ldc + col0;
#pragma unroll
                for (int bj = 0; bj < 2; ++bj)
#pragma unroll
                    for (int n = 0; n < 2; ++n) { const f32x4 b = *(const f32x4*)(base + off + bj * HALF + n * 16);
                        *(f32x4*)(out + off + bj * HALF + n * 16) = b + cv[bj][n] * acc[ai][bj][m][n]; } }
    }
};
struct EpiProj {
    static constexpr bool PERM = true, AFTER_DRAIN = false;
    bf16_t* O; int ldc; int nscale; float scale; int gelu_from;
    __device__ __forceinline__ void operator()(const f32x4 (&acc)[2][2][4][2], const Unit& u, int wr, int wc, int fr, int fq) const {
        const int row0 = u.pm * BM + wr * 64 + fr, col0 = u.pn * BM + wc * 32 + 8 * fq;
        const float sc = (u.pn < nscale) ? scale : 1.0f; const bool gl = (u.pn >= gelu_from);
#pragma unroll
        for (int ai = 0; ai < 2; ++ai)
#pragma unroll
            for (int m = 0; m < 4; ++m) { bf16_t* rowp = O + (size_t)(row0 + ai * HALF + m * 16) * ldc + col0;
#pragma unroll
                for (int bj = 0; bj < 2; ++bj) { f32x4 v0 = acc[ai][bj][m][0] * sc, v1 = acc[ai][bj][m][1] * sc;
                    if (gl) {
#pragma unroll
                        for (int j = 0; j < 4; ++j) { const float a = v0[j], b = v1[j];
                            v0[j] = a * fast_sigmoid(1.5957691216057308f * (a + 0.044715f * a * a * a));
                            v1[j] = b * fast_sigmoid(1.5957691216057308f * (b + 0.044715f * b * b * b)); } }
                    u32x4 w; w.x = cvt_pk_bf16(v0[0], v0[1]); w.y = cvt_pk_bf16(v0[2], v0[3]); w.z = cvt_pk_bf16(v1[0], v1[1]); w.w = cvt_pk_bf16(v1[2], v1[3]);
                    *(u32x4*)(rowp + bj * HALF) = w; } }
    }
};

template <class Epi, class Sched, bool ALIGN_EPI = false, bool SP2 = false>
__device__ __forceinline__ void gemm_phase(PG8_LAS unsigned char* lds, const Gemm g, const Sched& S, const Epi& E) {
    int tid_ = threadIdx.x; asm volatile("" : "+v"(tid_));
    const int tid = tid_, wid = __builtin_amdgcn_readfirstlane(tid >> 6), lane = tid & 63, wr = wid >> 2, wc = wid & 3, fr = lane & 15, fq = lane >> 4;
    const int K = g.K, nt = K / BK;
    unsigned voffA[2], voffB[2];
#pragma unroll
    for (int i = 0; i < 2; ++i) { int R, C; stage_rc(tid * 16 + i * 8192, R, C); const int Rb = Epi::PERM ? ((R & ~31) + perm32(R & 31)) : R;
        voffA[i] = g.atile ? (unsigned)(R * BK + C) * 2u : (unsigned)(R * K + C) * 2u; voffB[i] = (unsigned)(Rb * K + C) * 2u; }
    const size_t kstep = (size_t)(BK * 2);
    const size_t hstep = (size_t)HALF * K * 2;
    const size_t tstep = 2 * hstep;
    const size_t kstepA = g.atile ? (size_t)(BM * BK * 2) : kstep, hstepA = g.atile ? (size_t)(HALF * BK * 2) : hstep, tstepA = g.atile ? (size_t)nt * (BM * BK * 2) : tstep;
    const unsigned ldsw = (unsigned)wid * 1024u;
    const int aoff = lds_byte(wr * 64 + fr, fq * 8), boff = lds_byte(wc * 32 + fr, fq * 8);
#define PG8_SA(b, h) (((b) * 2 + (h)) * HTB)
#define PG8_SB(b, h) ((4 + (b) * 2 + (h)) * HTB)
#define PG8_STAGE(bufoff, gbase, voff) do { _Pragma("unroll") for (int _i = 0; _i < 2; ++_i) \
        __builtin_amdgcn_global_load_lds((const unsigned*)((const char*)(gbase) + (voff)[_i]), (PG8_LAS unsigned*)(lds + (bufoff) + ldsw + _i * 8192), 16, 0, 0); } while (0)
#define PG8_LDA(dst, b, h) do { _Pragma("unroll") for (int m = 0; m < 4; ++m) _Pragma("unroll") for (int k = 0; k < 2; ++k) dst[m][k] = *(const PG8_LAS bf16x8*)(lds + PG8_SA(b, h) + aoff + m * 2048 + k * 1024); } while (0)
#define PG8_LDB(dst, b, h) do { _Pragma("unroll") for (int n = 0; n < 2; ++n) _Pragma("unroll") for (int k = 0; k < 2; ++k) dst[n][k] = *(const PG8_LAS bf16x8*)(lds + PG8_SB(b, h) + boff + n * 2048 + k * 1024); } while (0)
#define PG8_MMA(ai, bj, At, Bt) do { __builtin_amdgcn_s_setprio(1); _Pragma("unroll") for (int m = 0; m < 4; ++m) _Pragma("unroll") for (int n = 0; n < 2; ++n) _Pragma("unroll") for (int k = 0; k < 2; ++k) \
        acc[ai][bj][m][n] = __builtin_amdgcn_mfma_f32_16x16x32_bf16(Bt[n][k], At[m][k], acc[ai][bj][m][n], 0, 0, 0); __builtin_amdgcn_s_setprio(0); } while (0)
#define PG8_WAIT_V(n) asm volatile("s_waitcnt vmcnt(" #n ")" ::: "memory")
#define PG8_WAIT_L(n) asm volatile("s_waitcnt lgkmcnt(" #n ")" ::: "memory")
#define PG8_BAR __builtin_amdgcn_s_barrier()
#define PG8_SCHED __builtin_amdgcn_sched_barrier(0)
    Unit cur, nxt; int ui = 0;
    if (!S.next(0, cur)) return;
    f32x4 acc[2][2][4][2];
#pragma unroll
    for (int a = 0; a < 2; ++a)
#pragma unroll
        for (int b = 0; b < 2; ++b)
#pragma unroll
            for (int m = 0; m < 4; ++m)
#pragma unroll
                for (int n = 0; n < 2; ++n) acc[a][b][m][n] = (f32x4){0.f, 0.f, 0.f, 0.f};
    bf16x8 At[4][2], B0[2][2], B1[2][2];
    const char* cA = (const char*)g.A + (size_t)cur.pm * tstepA; const char* cB = (const char*)g.Bt + (size_t)cur.pn * tstep;
    S.a_ready(cur);
    if constexpr (SP2) {
        PG8_STAGE(PG8_SB(0, 0), cB, voffB); PG8_STAGE(PG8_SB(0, 1), cB + hstep, voffB); PG8_STAGE(PG8_SA(0, 0), cA, voffA); PG8_STAGE(PG8_SA(0, 1), cA + hstepA, voffA);
        if (wr == 1) PG8_BAR;
        PG8_WAIT_V(2); PG8_BAR;
        PG8_STAGE(PG8_SB(1, 0), cB + kstep, voffB); PG8_STAGE(PG8_SA(1, 0), cA + kstepA, voffA); PG8_STAGE(PG8_SB(1, 1), cB + hstep + kstep, voffB);
        PG8_WAIT_V(6); PG8_BAR;
    } else {
        PG8_STAGE(PG8_SB(0, 0), cB, voffB); PG8_STAGE(PG8_SA(0, 0), cA, voffA); PG8_STAGE(PG8_SB(0, 1), cB + hstep, voffB); PG8_STAGE(PG8_SA(0, 1), cA + hstepA, voffA);
        if (wr == 1) PG8_BAR;
        PG8_WAIT_V(4); PG8_BAR;
        PG8_STAGE(PG8_SB(1, 0), cB + kstep, voffB); PG8_STAGE(PG8_SA(1, 0), cA + kstepA, voffA); PG8_STAGE(PG8_SB(1, 1), cB + hstep + kstep, voffB);
        PG8_WAIT_V(6); PG8_BAR;
    }
    for (;;) {
        const bool has_next = S.next(ui + 1, nxt);
        const char* nA = has_next ? (const char*)g.A + (size_t)nxt.pm * tstepA : cA; const char* nB = has_next ? (const char*)g.Bt + (size_t)nxt.pn * tstep : cB;
        for (int t = 0; t < nt; t += 2) {
            const bool last = (t == nt - 2);
            const char* a1 = cA + (size_t)(t + 1) * kstepA;
            const char* a2 = last ? nA : cA + (size_t)(t + 2) * kstepA; const char* b2 = last ? nB : cB + (size_t)(t + 2) * kstep;
            const char* a3 = a2 + kstepA; const char* b3 = b2 + kstep;
            if (last && has_next) S.a_ready(nxt);
            if constexpr (SP2) {
            PG8_LDB(B0, 0, 0); PG8_LDB(B1, 0, 1); PG8_SCHED; PG8_LDA(At, 0, 0); PG8_STAGE(PG8_SA(1, 1), a1 + hstepA, voffA);
            PG8_WAIT_V(8); PG8_WAIT_L(0); PG8_BAR; PG8_MMA(0, 0, At, B0); PG8_MMA(0, 1, At, B1); PG8_BAR; PG8_SCHED;
            PG8_LDA(At, 0, 1); PG8_STAGE(PG8_SB(0, 0), b2, voffB); PG8_STAGE(PG8_SB(0, 1), b2 + hstep, voffB); PG8_STAGE(PG8_SA(0, 0), a2, voffA);
            PG8_WAIT_V(8); PG8_WAIT_L(0); PG8_BAR; PG8_MMA(1, 0, At, B0); PG8_MMA(1, 1, At, B1); PG8_BAR; PG8_SCHED;
            PG8_LDB(B0, 1, 0); PG8_LDB(B1, 1, 1); PG8_SCHED; PG8_LDA(At, 1, 0); PG8_STAGE(PG8_SA(0, 1), a2 + hstepA, voffA);
            PG8_WAIT_V(8); PG8_WAIT_L(0); PG8_BAR; PG8_MMA(0, 0, At, B0); PG8_MMA(0, 1, At, B1); PG8_BAR; PG8_SCHED;
            PG8_LDA(At, 1, 1); PG8_STAGE(PG8_SB(1, 0), b3, voffB); PG8_STAGE(PG8_SB(1, 1), b3 + hstep, voffB); PG8_STAGE(PG8_SA(1, 0), a3, voffA);
            PG8_WAIT_V(8); PG8_WAIT_L(0); PG8_BAR; PG8_MMA(1, 0, At, B0); PG8_MMA(1, 1, At, B1); PG8_BAR; PG8_SCHED;
            } else {
            PG8_LDB(B0, 0, 0); PG8_SCHED; PG8_LDA(At, 0, 0); PG8_STAGE(PG8_SA(1, 1), a1 + hstepA, voffA);
            PG8_WAIT_L(8); PG8_BAR; PG8_WAIT_L(0); PG8_MMA(0, 0, At, B0); PG8_BAR; PG8_SCHED;
            PG8_LDB(B1, 0, 1); PG8_STAGE(PG8_SB(0, 0), b2, voffB);
            PG8_BAR; PG8_WAIT_L(0); PG8_MMA(0, 1, At, B1); PG8_BAR;
            PG8_LDA(At, 0, 1); PG8_STAGE(PG8_SA(0, 0), a2, voffA);
            PG8_BAR; PG8_WAIT_L(0); PG8_MMA(1, 0, At, B0); PG8_BAR; PG8_SCHED;
            PG8_STAGE(PG8_SB(0, 1), b2 + hstep, voffB);
            PG8_WAIT_V(6); PG8_BAR; PG8_MMA(1, 1, At, B1); PG8_BAR;
            PG8_LDB(B0, 1, 0); PG8_SCHED; PG8_LDA(At, 1, 0); PG8_STAGE(PG8_SA(0, 1), a2 + hstepA, voffA);
            PG8_WAIT_L(8); PG8_BAR; PG8_WAIT_L(0); PG8_MMA(0, 0, At, B0); PG8_BAR; PG8_SCHED;
            PG8_LDB(B1, 1, 1); PG8_STAGE(PG8_SB(1, 0), b3, voffB);
            PG8_BAR; PG8_WAIT_L(0); PG8_MMA(0, 1, At, B1); PG8_BAR;
            PG8_LDA(At, 1, 1); PG8_STAGE(PG8_SA(1, 0), a3, voffA);
            PG8_BAR; PG8_WAIT_L(0); PG8_MMA(1, 0, At, B0); PG8_BAR; PG8_SCHED;
            PG8_STAGE(PG8_SB(1, 1), b3 + hstep, voffB);
            PG8_WAIT_V(6); PG8_BAR; PG8_MMA(1, 1, At, B1); PG8_BAR;
            }
        }
        if constexpr (ALIGN_EPI) { if (wr == 0) PG8_BAR; }
        if constexpr (!Epi::AFTER_DRAIN) { E(acc, cur, wr, wc, fr, fq); S.done(cur); }
        if (!has_next) break;
#pragma unroll
        for (int a = 0; a < 2; ++a)
#pragma unroll
            for (int b = 0; b < 2; ++b)
#pragma unroll
                for (int m = 0; m < 4; ++m)
#pragma unroll
                    for (int n = 0; n < 2; ++n) acc[a][b][m][n] = (f32x4){0.f, 0.f, 0.f, 0.f};
        cur = nxt; cA = nA; cB = nB; ++ui;
        if constexpr (ALIGN_EPI) { if (wr == 1) PG8_BAR; }
    }
    PG8_WAIT_V(0);
    if constexpr (!ALIGN_EPI) { if (wr == 0) PG8_BAR; }
    PG8_BAR;
    if constexpr (Epi::AFTER_DRAIN) { E.fused(acc, cur, wr, wc, fr, fq, lds, wid, lane); S.done(cur); }
#undef PG8_SA
#undef PG8_SB
#undef PG8_STAGE
#undef PG8_LDA
#undef PG8_LDB
#undef PG8_MMA
#undef PG8_WAIT_V
#undef PG8_WAIT_L
#undef PG8_BAR
#undef PG8_SCHED
}
}

constexpr int S = 16384, D = 2048, DEPTH = 4, DFF = 5504, NMODV = 9 * 2048;
constexpr int ABN = 5120, CIN = 4176, CINP = 4352;
constexpr float EPS = 1e-6f, LOG2E = 1.4426950408889634f;
constexpr int NWAVES = 8;
constexpr size_t MiB = 1u << 20;
constexpr size_t WS_CTL = 0, CTL_ZERO_BYTES = 1 * MiB;
constexpr size_t WS_PART = 1 * MiB, WS_VEC = 3 * MiB;
constexpr size_t WS_W1T = 4 * MiB, WS_W2T = 348 * MiB, WS_ABIN = 520 * MiB, WS_ABOUT = 560 * MiB, WS_DSAIN = 576 * MiB, WS_DSAOUT = 610 * MiB;
constexpr size_t WS_XRES = 626 * MiB, WS_XN = 754 * MiB, WS_H = 818 * MiB, WS_PROJ = 990 * MiB, WS_CAT = 1150 * MiB, WS_SEL = 1214 * MiB, WS_END = 1222 * MiB;
constexpr size_t W1T_SZ = (size_t)2 * DFF * D, W2T_SZ = (size_t)D * DFF, ABIN_SZ = (size_t)ABN * D, SQ_SZ = (size_t)D * D, DSAIN_SZ = (size_t)CINP * D;
static_assert(WS_W1T + 8 * W1T_SZ * 2 <= WS_W2T && WS_W2T + 8 * W2T_SZ * 2 <= WS_ABIN && WS_ABIN + 2 * ABIN_SZ * 2 <= WS_ABOUT && WS_ABOUT + 2 * SQ_SZ * 2 <= WS_DSAIN &&
              WS_DSAIN + 2 * DSAIN_SZ * 2 <= WS_DSAOUT && WS_DSAOUT + 2 * SQ_SZ * 2 <= WS_XRES && WS_XRES + (size_t)S * D * 4 <= WS_XN && WS_XN + (size_t)S * D * 2 <= WS_H &&
              WS_H + (size_t)S * DFF * 2 <= WS_PROJ && WS_PROJ + (size_t)S * ABN * 2 <= WS_CAT && WS_CAT + (size_t)S * D * 2 <= WS_SEL && WS_SEL + (size_t)S * 256 * 2 <= WS_END, "d_ws map");
constexpr int CW_BAR = 4096;
constexpr int RING_BYTES = 147456;
constexpr int MISC_OFF = RING_BYTES;
constexpr int INP_OFF = RING_BYTES + 256;
constexpr int LDS_BYTES = RING_BYTES + 512;

#define GAS __attribute__((address_space(1)))
#define LAS __attribute__((address_space(3)))
typedef unsigned short bf16;
typedef unsigned v4u __attribute__((ext_vector_type(4)));
typedef unsigned v2u __attribute__((ext_vector_type(2)));
typedef float f32x4 __attribute__((ext_vector_type(4)));
typedef float f32x16 __attribute__((ext_vector_type(16)));
typedef short bf16x8 __attribute__((ext_vector_type(8)));
typedef short s16x4 __attribute__((ext_vector_type(4)));
typedef GAS unsigned gu32;
#define LDS_WAIT() asm volatile("s_waitcnt lgkmcnt(0)" ::: "memory")
#define VM_WAIT() asm volatile("s_waitcnt vmcnt(0)" ::: "memory")
__device__ __forceinline__ unsigned f2bf(float f) { unsigned u = __builtin_bit_cast(unsigned, f); return (u + 0x7fffu + ((u >> 16) & 1u)) >> 16; }
__device__ __forceinline__ unsigned pk2(float lo, float hi) { return f2bf(lo) | (f2bf(hi) << 16); }
__device__ __forceinline__ float bf2f(unsigned short b) { return __builtin_bit_cast(float, (unsigned)b << 16); }
typedef float f32x2_t __attribute__((ext_vector_type(2))); typedef __bf16 bf16x2_t __attribute__((ext_vector_type(2)));
__device__ __forceinline__ unsigned cvtpk(float lo, float hi) { f32x2_t v = {lo, hi}; bf16x2_t b = __builtin_convertvector(v, bf16x2_t); return __builtin_bit_cast(unsigned, b); }
__device__ __forceinline__ int crow(int i, int hh) { return (i & 3) + 8 * (i >> 2) + 4 * hh; }
template <int K> __device__ __forceinline__ float swz_xor(float v) { return __builtin_bit_cast(float, __builtin_amdgcn_ds_swizzle(__builtin_bit_cast(int, v), (K << 10) | 0x1f)); }
__device__ __forceinline__ float sum32(float v) { const unsigned u = __builtin_bit_cast(unsigned, v); auto rr = __builtin_amdgcn_permlane32_swap(u, u, false, false); return __builtin_bit_cast(float, (unsigned)rr[0]) + __builtin_bit_cast(float, (unsigned)rr[1]); }
__device__ __forceinline__ float max32(float v) { const unsigned u = __builtin_bit_cast(unsigned, v); auto rr = __builtin_amdgcn_permlane32_swap(u, u, false, false); return fmaxf(__builtin_bit_cast(float, (unsigned)rr[0]), __builtin_bit_cast(float, (unsigned)rr[1])); }
__device__ __forceinline__ float wave_sum(float v) {
    v += swz_xor<1>(v); v += swz_xor<2>(v); v += swz_xor<4>(v); v += swz_xor<8>(v); v += swz_xor<16>(v);
    return sum32(v);
}
__device__ __forceinline__ void glds16(const void* gsrc, unsigned lds_dst) { unsigned keep;
    asm volatile("s_mov_b32 %0, m0\n\ts_mov_b32 m0, %2\n\ts_nop 0\n\tglobal_load_lds_dwordx4 %1, off\n\ts_mov_b32 m0, %0" : "=&s"(keep) : "v"(gsrc), "s"(lds_dst) : "memory"); }
__device__ __forceinline__ unsigned lds_addr(const LAS unsigned char* p) { return (unsigned)(size_t)p; }
#define MFMA32(a, b, c) __builtin_amdgcn_mfma_f32_32x32x16_bf16((a), (b), (c), 0, 0, 0)
typedef short v4i16_t __attribute__((ext_vector_type(4)));
__device__ __forceinline__ s16x4 vtr(const LAS unsigned char* p) { return __builtin_bit_cast(s16x4, __builtin_amdgcn_ds_read_tr16_b64_v4i16((LAS v4i16_t*)p)); }
__device__ const unsigned char REL_BUCKET[129] = {
    0, 1, 2, 3, 4, 5, 6, 7, 8, 9, 10, 11, 12, 13, 14, 15,
    16, 16, 16, 17, 17, 18, 18, 18, 19, 19, 19, 20, 20, 20, 20, 21,
    21, 21, 21, 22, 22, 22, 22, 22, 23, 23, 23, 23, 23, 23, 24, 24,
    24, 24, 24, 24, 25, 25, 25, 25, 25, 25, 25, 26, 26, 26, 26, 26,
    26, 26, 26, 27, 27, 27, 27, 27, 27, 27, 27, 27, 27, 28, 28, 28,
    28, 28, 28, 28, 28, 28, 28, 29, 29, 29, 29, 29, 29, 29, 29, 29,
    29, 29, 29, 30, 30, 30, 30, 30, 30, 30, 30, 30, 30, 30, 30, 30,
    30, 31, 31, 31, 31, 31, 31, 31, 31, 31, 31, 31, 31, 31, 31, 31,
    31
};

#define XB_TMO      128
#define XB_XCNT(j)  (256  + 64 * (j))
#define XB_XSUB(j)  (1280 + 64 * (j))
#define XB_XGEN(j)  (2304 + 64 * (j))
#define XB_TOP      3328
#define XB_TOPGEN   3392
#define XCD_BAR_WORDS 3456
#define XB_SPIN_CAP (1u << 22)

__device__ __forceinline__ unsigned xb_ld(unsigned* p)              { return __hip_atomic_load(p, __ATOMIC_RELAXED, __HIP_MEMORY_SCOPE_AGENT); }
__device__ __forceinline__ unsigned xb_add(unsigned* p, unsigned v) { return __hip_atomic_fetch_add(p, v, __ATOMIC_RELAXED, __HIP_MEMORY_SCOPE_AGENT); }
__device__ __forceinline__ unsigned xb_xcc_id() { return (unsigned)__builtin_amdgcn_s_getreg((3 << 11) | 20) & 0xFu; }
#define XB_SPIN(cond, bar) do { unsigned _sp = 0; while (cond) { __builtin_amdgcn_s_sleep(1); \
    if ((++_sp & 255u) == 0u) { if (xb_ld(&(bar)[XB_TMO])) break; if (_sp > XB_SPIN_CAP) { atomicAdd(&(bar)[XB_TMO], 1u); break; } } } } while (0)

struct XcdBarrier {
    unsigned* bar; unsigned x;
    volatile LAS unsigned* st;
};

__device__ __forceinline__ bool xb_thread0(int wave) { unsigned z = 0u; asm volatile("" : "+v"(z)); return wave == 0 && __builtin_amdgcn_mbcnt_hi(~0u, __builtin_amdgcn_mbcnt_lo(~0u, z)) == 0u; }
__device__ __forceinline__ XcdBarrier xcd_barrier_post(unsigned* bar, volatile LAS unsigned* st, int wave) {
    XcdBarrier b; b.bar = bar; b.x = xb_xcc_id(); b.st = st;
    if (xb_thread0(wave)) (void)xb_add(&bar[XB_XCNT(b.x)], 1u);
    return b;
}
__device__ __forceinline__ void xcd_barrier_complete(unsigned* bar, unsigned x, unsigned& nloc, unsigned& nx) {
    const unsigned G = gridDim.x * gridDim.y * gridDim.z;
    unsigned sum, cnt, mine, sp = 0u;
    for (;;) {
        sum = 0u; cnt = 0u; mine = 0u;
#pragma unroll
        for (unsigned j = 0; j < 16; ++j) { const unsigned c = xb_ld(&bar[XB_XCNT(j)]); sum += c; cnt += (c > 0u) ? 1u : 0u; mine = (j == x) ? c : mine; }
        if (sum == G) break;
        __builtin_amdgcn_s_sleep(1);
        if ((++sp & 255u) == 0u) { if (xb_ld(&bar[XB_TMO])) break; if (sp > XB_SPIN_CAP) { atomicAdd(&bar[XB_TMO], 1u); break; } }
    }
    nloc = mine > 0u ? mine : 1u; nx = cnt > 0u ? cnt : 1u;
}

__device__ __forceinline__ void xcd_barrier(const XcdBarrier& b, int wave) {
    asm volatile("s_waitcnt vmcnt(0)" ::: "memory");
    __syncthreads();
    if (xb_thread0(wave)) {
        unsigned* bar = b.bar;
        __builtin_amdgcn_s_waitcnt(0);
        unsigned nloc = b.st[0], nx = b.st[1];
        if (nloc == 0u) { xcd_barrier_complete(bar, b.x, nloc, nx); b.st[0] = nloc; b.st[1] = nx; }
        const unsigned old = xb_add(&bar[XB_XSUB(b.x)], 1u);
        const unsigned gen = old / nloc;
        if (old + 1u == (gen + 1u) * nloc) {
            __builtin_amdgcn_fence(__ATOMIC_RELEASE, "agent");
            asm volatile("s_waitcnt vmcnt(0)" ::: "memory");
            const unsigned og = xb_add(&bar[XB_TOP], 1u);
            const unsigned tg = og / nx;
            if (og + 1u == (tg + 1u) * nx) xb_add(&bar[XB_TOPGEN], 1u);
            else XB_SPIN(xb_ld(&bar[XB_TOPGEN]) == tg, bar);
            __builtin_amdgcn_fence(__ATOMIC_ACQUIRE, "agent");
            xb_add(&bar[XB_XGEN(b.x)], 1u);
            asm volatile("s_waitcnt vmcnt(0)" ::: "memory");
        } else {
            XB_SPIN(xb_ld(&bar[XB_XGEN(b.x)]) == gen, bar);
            __builtin_amdgcn_fence(__ATOMIC_ACQUIRE, "agent");
            asm volatile("s_waitcnt vmcnt(0)" ::: "memory");
        }
    }
    __syncthreads();
}

struct Frame {
    LAS unsigned char* lds;
    int tid, lane, wave, vcu, G;
};

__device__ __forceinline__ void tr_item(const float* W, int K, int N, int ncols, bf16* WT, int out_row0, LAS float* scr, int k0, int n0, int lane) {
    const int col = n0 + (lane & 31); const bool ok = col < ncols;
    float tv[32];
    const float* wp = W + (size_t)(k0 + (lane >> 5)) * N + (ok ? col : 0);
#pragma unroll
    for (int i = 0; i < 32; ++i) tv[i] = wp[(size_t)(2 * i) * N];
#pragma unroll
    for (int i = 0; i < 32; ++i) scr[(2 * i + (lane >> 5)) * 33 + (lane & 31)] = ok ? tv[i] : 0.f;
    LDS_WAIT(); asm volatile("" ::: "memory");
    const int c = lane & 7;
#pragma unroll
    for (int j = 0; j < 4; ++j) { const int n = (lane >> 3) + 8 * j; const LAS float* s = scr + (8 * c) * 33 + n;
        v4u o; o.x = pk2(s[0 * 33], s[1 * 33]); o.y = pk2(s[2 * 33], s[3 * 33]); o.z = pk2(s[4 * 33], s[5 * 33]); o.w = pk2(s[6 * 33], s[7 * 33]);
        *(GAS v4u*)(WT + (size_t)(out_row0 + n) * K + k0 + 8 * c) = o; }
    LDS_WAIT(); asm volatile("" ::: "memory");
}
constexpr int I_W1 = 32 * 344, I_W2 = 86 * 64, I_ABI = 32 * 160, I_SQ = 32 * 64, I_DSI = 32 * 136;
constexpr int N_TR_ITEMS = 8 * I_W1 + 8 * I_W2 + 2 * I_ABI + 2 * I_SQ + 2 * I_DSI + 2 * I_SQ;
constexpr int N_GEMV_UNITS = 4 * 72 * 4;
struct Args; __device__ __forceinline__ const float* in_ptr(const Args& a, int i);
__device__ __forceinline__ void prologue_phase(Frame& F, const Args& A, unsigned char* ws) {
    const float* c = in_ptr(A, 1); const float* mod_w = in_ptr(A, 3); float* PART = (float*)(ws + WS_PART);
    for (int unit = F.vcu; unit < N_GEMV_UNITS; unit += F.G) {
        const int l = unit / 288, rem = unit % 288, cb = rem >> 2, kq = rem & 3;
        LAS float* sc = (LAS float*)F.lds + F.wave * 64;
        const int k0 = kq * 512 + F.wave * 64;
        { const float cv = c[k0 + F.lane]; sc[F.lane] = cv * pg8::fast_sigmoid(cv); }
        LDS_WAIT(); asm volatile("" ::: "memory");
        const float* W = mod_w + ((size_t)l * 2048 + k0) * NMODV + cb * 256 + 4 * F.lane;
        f32x4 acc = {0.f, 0.f, 0.f, 0.f};
#pragma unroll 16
        for (int kk = 0; kk < 64; ++kk) acc += sc[kk] * *(const f32x4*)(W + (size_t)kk * NMODV);
        *((LAS f32x4*)(F.lds + 4096) + F.wave * 64 + F.lane) = acc;
        __syncthreads();
        if (F.tid < 256) { float s = 0.f;
#pragma unroll
            for (int w = 0; w < 8; ++w) s += ((LAS float*)(F.lds + 4096))[w * 256 + F.tid];
            PART[(size_t)(kq * 4 + l) * NMODV + cb * 256 + F.tid] = s; }
        __syncthreads();
    }
    LAS float* scr = (LAS float*)(F.lds + 16384 + F.wave * 8704);
    const int gw = F.vcu * NWAVES + F.wave, NGW = F.G * NWAVES;
    for (int it = gw; it < N_TR_ITEMS; it += NGW) {
        int r = it;
        if (r < 8 * I_W1) { const int mi = r / I_W1, q = r % I_W1, kb = q / 344, nb = q % 344, n0 = nb * 32;
            const int orow = (n0 < DFF) ? (n0 / 128) * 256 + (n0 % 128) : ((n0 - DFF) / 128) * 256 + 128 + ((n0 - DFF) % 128);
            tr_item(in_ptr(A, 5) + (size_t)mi * D * 2 * DFF, D, 2 * DFF, 2 * DFF, (bf16*)(ws + WS_W1T) + (size_t)mi * W1T_SZ, orow, scr, kb * 64, n0, F.lane); continue; } r -= 8 * I_W1;
        if (r < 8 * I_W2) { const int mi = r / I_W2, q = r % I_W2, kb = q / 64, nb = q % 64;
            tr_item(in_ptr(A, 6) + (size_t)mi * DFF * D, DFF, D, D, (bf16*)(ws + WS_W2T) + (size_t)mi * W2T_SZ, nb * 32, scr, kb * 64, nb * 32, F.lane); continue; } r -= 8 * I_W2;
        if (r < 2 * I_ABI) { const int mi = r / I_ABI, q = r % I_ABI, kb = q / 160, nb = q % 160;
            tr_item(in_ptr(A, 8) + (size_t)mi * D * ABN, D, ABN, ABN, (bf16*)(ws + WS_ABIN) + (size_t)mi * ABIN_SZ, nb * 32, scr, kb * 64, nb * 32, F.lane); continue; } r -= 2 * I_ABI;
        if (r < 2 * I_SQ) { const int mi = r / I_SQ, q = r % I_SQ, kb = q / 64, nb = q % 64;
            tr_item(in_ptr(A, 9) + (size_t)mi * SQ_SZ, D, D, D, (bf16*)(ws + WS_ABOUT) + (size_t)mi * SQ_SZ, nb * 32, scr, kb * 64, nb * 32, F.lane); continue; } r -= 2 * I_SQ;
        if (r < 2 * I_DSI) { const int mi = r / I_DSI, q = r % I_DSI, kb = q / 136, nb = q % 136;
            tr_item(in_ptr(A, 16) + (size_t)mi * D * CIN, D, CIN, CIN, (bf16*)(ws + WS_DSAIN) + (size_t)mi * DSAIN_SZ, nb * 32, scr, kb * 64, nb * 32, F.lane); continue; } r -= 2 * I_DSI;
        { const int mi = r / I_SQ, q = r % I_SQ, kb = q / 64, nb = q % 64;
            tr_item(in_ptr(A, 17) + (size_t)mi * SQ_SZ, D, D, D, (bf16*)(ws + WS_DSAOUT) + (size_t)mi * SQ_SZ, nb * 32, scr, kb * 64, nb * 32, F.lane); }
    }
}
__device__ __forceinline__ void vec_phase(Frame& F, const Args& A, unsigned char* ws) {
    const float* PART = (const float*)(ws + WS_PART); const float* mod_b = in_ptr(A, 4); const float* norm_g = in_ptr(A, 2);
    float* NA = (float*)(ws + WS_VEC); float* NB = NA + 12 * 2048; float* GT = NB + 12 * 2048;
    for (int idx = F.vcu * 512 + F.tid; idx < 12 * 2048; idx += F.G * 512) {
        const int lj = idx >> 11, col = idx & 2047, l = lj / 3, j = lj % 3;
        float mv[3];
#pragma unroll
        for (int t = 0; t < 3; ++t) { const int n = (3 * j + t) * 2048 + col; float s = mod_b[l * NMODV + n];
#pragma unroll
            for (int kq = 0; kq < 4; ++kq) s += PART[(size_t)(kq * 4 + l) * NMODV + n];
            mv[t] = s; }
        NA[idx] = norm_g[idx] * (1.0f + mv[1]); NB[idx] = mv[0]; GT[idx] = (j == 1 ? 1.0f : 0.5f) * (1.0f + mv[2]);
    }
}
__device__ __forceinline__ void norm_phase(Frame& F, const float* src, const float* na, const float* nb, bf16* dst) {
    const int gw = F.vcu * NWAVES + F.wave, NGW = F.G * NWAVES;
    for (int m = gw; m < S; m += NGW) {
        const GAS f32x4* xr = (const GAS f32x4*)(src + (size_t)m * D) + F.lane;
        f32x4 v[8]; float ss = 0.f;
#pragma unroll
        for (int j = 0; j < 8; ++j) { v[j] = xr[64 * j]; ss += (v[j].x * v[j].x + v[j].y * v[j].y) + (v[j].z * v[j].z + v[j].w * v[j].w); }
        const float rstd = 1.0f / sqrtf(wave_sum(ss) * (1.0f / D) + EPS);
        GAS v2u* o8 = (GAS v2u*)(dst + (size_t)m * D) + F.lane;
#pragma unroll
        for (int j = 0; j < 8; ++j) { const f32x4 a = ((const f32x4*)na)[64 * j + F.lane], b = ((const f32x4*)nb)[64 * j + F.lane]; const f32x4 o = v[j] * rstd * a + b;
            v2u w; w.x = cvtpk(o.x, o.y); w.y = cvtpk(o.z, o.w); o8[64 * j] = w; }
    }
}
__device__ __forceinline__ void final_norm_phase(Frame& F, const float* src, const float* g, float* out) {
    const int gw = F.vcu * NWAVES + F.wave, NGW = F.G * NWAVES;
    for (int m = gw; m < S; m += NGW) {
        const GAS f32x4* xr = (const GAS f32x4*)(src + (size_t)m * D) + F.lane;
        f32x4 v[8]; float ss = 0.f;
#pragma unroll
        for (int j = 0; j < 8; ++j) { v[j] = xr[64 * j]; ss += (v[j].x * v[j].x + v[j].y * v[j].y) + (v[j].z * v[j].z + v[j].w * v[j].w); }
        const float rstd = 1.0f / sqrtf(wave_sum(ss) * (1.0f / D) + EPS);
        GAS f32x4* o = (GAS f32x4*)(out + (size_t)m * D) + F.lane;
#pragma unroll
        for (int j = 0; j < 8; ++j) o[64 * j] = v[j] * rstd * ((const f32x4*)g)[64 * j + F.lane];
    }
}

namespace da {
constexpr int PITCH = ABN, KOFF = 1024, VOFF = 2048;
constexpr float C2 = 0.125f * LOG2E;
constexpr int NBUF = 4, LDS_LUT = NBUF * 32768;
#define DA_WAIT_BAR(N) asm volatile("s_waitcnt vmcnt(" #N ") lgkmcnt(0)\n\ts_barrier" ::: "memory")
constexpr float THR = 8.0f;
__device__ __forceinline__ void dma_tile(LAS unsigned char* lds, const bf16* P, int h, int k0, int buf, int wid, int lane) {
#pragma unroll
    for (int i = 0; i < 2; ++i) {
        const int piece = wid * 2 + i, row = piece * 4 + (lane >> 4), pc = lane & 15;
        const int ck = pc ^ (row & 15), cv = pc ^ (2 * (row & 7));
        const bf16* rp = P + (size_t)(k0 + row) * PITCH + h * 128;
        glds16(rp + KOFF + ck * 8, (unsigned)__builtin_amdgcn_readfirstlane(lds_addr(lds) + buf * 32768 + piece * 1024));
        glds16(rp + VOFF + cv * 8, (unsigned)__builtin_amdgcn_readfirstlane(lds_addr(lds) + buf * 32768 + 16384 + piece * 1024));
    }
}
__device__ __forceinline__ float max3_asm(float a, float b, float c) { float r; asm("v_max3_f32 %0, %1, %2, %3" : "=v"(r) : "v"(a), "v"(b), "v"(c)); return r; }
__device__ __forceinline__ void unit(int tid, LAS unsigned char* lds, const bf16* P, bf16* CAT, int h, int qb, float lam, float oscale, const float* subg, const float* rel) {
    const int lane = tid & 63, wid = __builtin_amdgcn_readfirstlane(tid >> 6), r = lane & 31, hh = lane >> 5;
    const int rb = wid >> 1, m = wid & 1;
    const int q0w = qb * 128 + rb * 32, qpos = q0w + r;
    LAS float* lut = (LAS float*)(lds + LDS_LUT);
    __syncthreads();
    if (tid < 258) { const int mm = tid / 129, d = tid % 129; const int b = REL_BUCKET[d];
        lut[mm * 132 + d] = (rel[b * 16 + h * 2 + mm] - rel[31 * 16 + h * 2 + mm]) * LOG2E; }
    const int NT = 2 * qb + 2;
    bf16x8 qf[4];
#pragma unroll
    for (int ks = 0; ks < 4; ++ks) qf[ks] = *(const bf16x8*)(P + (size_t)qpos * PITCH + h * 128 + m * 64 + ks * 16 + hh * 8);
    asm volatile("s_waitcnt vmcnt(0)" : "+v"(qf[0]), "+v"(qf[1]), "+v"(qf[2]), "+v"(qf[3]) :: "memory");
    dma_tile(lds, P, h, 0, 0, wid, lane); dma_tile(lds, P, h, 64, 1, wid, lane);
    if (NT > 2) dma_tile(lds, P, h, 128, 2, wid, lane);
    f32x16 O[4];
#pragma unroll
    for (int e = 0; e < 4; ++e)
#pragma unroll
        for (int i = 0; i < 16; ++i) O[e][i] = 0.f;
    float mref = 0.f, ls4[4] = {0.f, 0.f, 0.f, 0.f};
    f32x16 negm;
#pragma unroll
    for (int i = 0; i < 16; ++i) negm[i] = 0.f;
    const int klane = r * 256, kbits0 = (8 * m + hh) ^ (r & 15);
    const int l16 = lane & 15, qq = l16 >> 2, p4 = l16 & 3, G4 = lane >> 4;
    const int x0 = 4 * hh + qq, lanev20 = (2 * (G4 & 1) + (p4 >> 1)) ^ (2 * x0), vlane = x0 * 256 + (p4 & 1) * 8;
    if (NT > 2) DA_WAIT_BAR(8); else DA_WAIT_BAR(4);
    for (int t = 0; t < NT; ++t) {
        const int buf = t & 3, k0 = t * 64;
        if (t + 3 < NT) dma_tile(lds, P, h, k0 + 192, (t + 3) & 3, wid, lane);
        int kbits = kbits0, lanev2 = lanev20; asm volatile("" : "+v"(kbits), "+v"(lanev2));
        if (k0 <= q0w + 31) {
            const LAS unsigned char* Kb = lds + buf * 32768; const LAS unsigned char* Vb = Kb + 16384;
            const bool two = (k0 + 32 <= q0w + 31);
            bf16x8 kf[2][4];
#pragma unroll
            for (int kb = 0; kb < 2; ++kb)
#pragma unroll
                for (int ks = 0; ks < 4; ++ks) kf[kb][ks] = *(const LAS bf16x8*)(Kb + kb * 8192 + klane + (((2 * ks) ^ kbits) << 4));
            __builtin_amdgcn_sched_barrier(0);
            f32x16 s0 = negm, s1 = negm;
            __builtin_amdgcn_s_setprio(1);
#pragma unroll
            for (int ks = 0; ks < 4; ++ks) { s0 = MFMA32(kf[0][ks], qf[ks], s0); s1 = MFMA32(kf[1][ks], qf[ks], s1); }
            __builtin_amdgcn_s_setprio(0);
            asm volatile("s_nop 15\n\ts_nop 7" : "+v"(s0), "+v"(s1));
            if (k0 + 191 > q0w) {
#pragma unroll
                for (int i = 0; i < 16; ++i) { const int d0 = qpos - (k0 + crow(i, hh)), d1 = d0 - 32;
                    s0[i] = d0 < 0 ? -INFINITY : s0[i] + lut[m * 132 + (d0 > 128 ? 128 : d0)];
                    s1[i] = d1 < 0 ? -INFINITY : s1[i] + lut[m * 132 + (d1 > 128 ? 128 : d1)]; }
            }
            float mx = max3_asm(s0[0], s0[1], s0[2]), my = max3_asm(s1[0], s1[1], s1[2]);
#pragma unroll
            for (int i = 3; i < 15; i += 2) { mx = max3_asm(mx, s0[i], s0[i + 1]); my = max3_asm(my, s1[i], s1[i + 1]); }
            mx = max3_asm(mx, s0[15], my); mx = fmaxf(mx, s1[15]);
            mx = max32(mx);
            if (__any(mx > THR)) {
                const float dl = fmaxf(mx, 0.f), alpha = __builtin_amdgcn_exp2f(-dl);
                mref += dl;
#pragma unroll
                for (int i = 0; i < 16; ++i) { s0[i] -= dl; s1[i] -= dl; negm[i] = -mref; }
#pragma unroll
                for (int j = 0; j < 4; ++j) ls4[j] *= alpha;
#pragma unroll
                for (int e = 0; e < 4; ++e)
#pragma unroll
                    for (int i = 0; i < 16; ++i) O[e][i] *= alpha;
            }
#pragma unroll
            for (int i = 0; i < 16; ++i) { s0[i] = __builtin_amdgcn_exp2f(s0[i]); s1[i] = __builtin_amdgcn_exp2f(s1[i]); }
#pragma unroll
            for (int i = 0; i < 16; ++i) { ls4[i & 3] += s0[i]; }
#pragma unroll
            for (int i = 0; i < 16; ++i) { ls4[i & 3] += s1[i]; }
            bf16x8 pk[4];
#pragma unroll
            for (int s2 = 0; s2 < 2; ++s2) { v4u w0, w1;
                w0.x = cvtpk(s0[8 * s2], s0[8 * s2 + 1]); w0.y = cvtpk(s0[8 * s2 + 2], s0[8 * s2 + 3]); w0.z = cvtpk(s0[8 * s2 + 4], s0[8 * s2 + 5]); w0.w = cvtpk(s0[8 * s2 + 6], s0[8 * s2 + 7]);
                w1.x = cvtpk(s1[8 * s2], s1[8 * s2 + 1]); w1.y = cvtpk(s1[8 * s2 + 2], s1[8 * s2 + 3]); w1.z = cvtpk(s1[8 * s2 + 4], s1[8 * s2 + 5]); w1.w = cvtpk(s1[8 * s2 + 6], s1[8 * s2 + 7]);
                pk[s2] = __builtin_bit_cast(bf16x8, w0); pk[2 + s2] = __builtin_bit_cast(bf16x8, w1); }
#pragma unroll
            for (int kk = 0; kk < 4; ++kk) {
                if (kk < 2 || two) {
#pragma unroll
                    for (int e = 0; e < 4; ++e) {
                        const LAS unsigned char* a0 = Vb + (16 * kk) * 256 + vlane + (((4 * e) ^ lanev2) << 4);
                        const s16x4 lo = vtr(a0), hi = vtr(a0 + 2048);
                        const bf16x8 vf = (bf16x8){lo[0], lo[1], lo[2], lo[3], hi[0], hi[1], hi[2], hi[3]};
                        O[e] = MFMA32(vf, pk[kk], O[e]);
                    }
                }
            }
        }
        if (t + 3 < NT) DA_WAIT_BAR(8); else if (t + 2 < NT) DA_WAIT_BAR(4); else DA_WAIT_BAR(0);
    }
    float lsum = sum32((ls4[0] + ls4[1]) + (ls4[2] + ls4[3]));
    LAS float* xch = (LAS float*)lds + rb * 4096 + lane;
    if (m == 1) { const float i1 = lam / lsum;
#pragma unroll
        for (int e = 0; e < 4; ++e)
#pragma unroll
            for (int i = 0; i < 16; ++i) xch[(e * 16 + i) * 64] = O[e][i] * i1; }
    __syncthreads();
    if (m == 0) {
        const float i0 = 1.0f / lsum; float ss = 0.f;
#pragma unroll
        for (int e = 0; e < 4; ++e)
#pragma unroll
            for (int i = 0; i < 16; ++i) { const float o = O[e][i] * i0 - xch[(e * 16 + i) * 64]; O[e][i] = o; ss += o * o; }
        ss = sum32(ss);
        const float rs = oscale / sqrtf(ss * (1.0f / 128.0f) + EPS);
        GAS bf16* orow = (GAS bf16*)CAT + (size_t)qpos * D + h * 128;
#pragma unroll
        for (int e = 0; e < 4; ++e)
#pragma unroll
            for (int g4 = 0; g4 < 4; ++g4) { const int ecol = 32 * e + 8 * g4 + 4 * hh; const f32x4 gv = *(const f32x4*)(subg + ecol);
                v2u w; w.x = cvtpk(O[e][4 * g4] * rs * gv.x, O[e][4 * g4 + 1] * rs * gv.y); w.y = cvtpk(O[e][4 * g4 + 2] * rs * gv.z, O[e][4 * g4 + 3] * rs * gv.w);
                *(GAS v2u*)(orow + ecol) = w; }
    }
}
}

namespace sgp {
constexpr int PITCH = ABN, UOFF = 3072, ZOFF = 4096;
constexpr int L_ST = 0, L_W = 1024, L_Z = 1024 + 128 * 272, RS = 272;
__device__ __forceinline__ void unit(int tid, LAS unsigned char* lds, const bf16* P, bf16* CAT, int n, int g, const float* lng, const float* lnb, const float* sgw, const float* sgb) {
    const int lane = tid & 63, wid = __builtin_amdgcn_readfirstlane(tid >> 6), r = lane & 31, hh = lane >> 5;
    const int R0 = n * 128;
    LAS float* st = (LAS float*)(lds + L_ST);
    __syncthreads();
    for (int rr = 0; rr < 16; ++rr) { const int rl = wid * 16 + rr; const bf16* zp = P + (size_t)(R0 + rl) * PITCH + ZOFF + lane * 16;
        const bf16x8 a = *(const bf16x8*)zp, b = *(const bf16x8*)(zp + 8);
        float x[16]; float s = 0.f;
#pragma unroll
        for (int i = 0; i < 8; ++i) { x[i] = bf2f((unsigned short)a[i]); x[8 + i] = bf2f((unsigned short)b[i]); }
#pragma unroll
        for (int i = 0; i < 16; ++i) s += x[i];
        const float mean = wave_sum(s) * (1.0f / 1024.0f); float q = 0.f;
#pragma unroll
        for (int i = 0; i < 16; ++i) { const float d = x[i] - mean; q += d * d; }
        const float rstd = 1.0f / sqrtf(wave_sum(q) * (1.0f / 1024.0f) + EPS);
        if (lane == 0) { st[2 * rl] = mean; st[2 * rl + 1] = rstd; } }
    __syncthreads();
    LAS bf16* ZT = (LAS bf16*)(lds + L_Z); LAS bf16* WT = (LAS bf16*)(lds + L_W);
#pragma unroll
    for (int i = 0; i < 4; ++i) { const int item = tid + 512 * i, sr = item >> 4, ch = item & 15;
        const bf16x8 z = *(const bf16x8*)(P + (size_t)(R0 + sr) * PITCH + ZOFF + g * 128 + ch * 8);
        const float mean = st[2 * sr], rstd = st[2 * sr + 1];
#pragma unroll
        for (int e = 0; e < 8; ++e) { const int c = ch * 8 + e; const float zn = (bf2f((unsigned short)z[e]) - mean) * rstd * lng[g * 128 + c] + lnb[g * 128 + c];
            ZT[c * (RS / 2) + sr] = (bf16)f2bf(zn); } }
#pragma unroll
    for (int i = 0; i < 4; ++i) { const int item = tid + 512 * i, t = item >> 4, sch = item & 15;
        const float* wp = sgw + ((size_t)g * 128 + t) * 128 + sch * 8; const f32x4 a = *(const f32x4*)wp, b = *(const f32x4*)(wp + 4);
        float w[8] = {a.x, a.y, a.z, a.w, b.x, b.y, b.z, b.w};
#pragma unroll
        for (int e = 0; e < 8; ++e) if (sch * 8 + e > t) w[e] = 0.f;
        v4u o; o.x = pk2(w[0], w[1]); o.y = pk2(w[2], w[3]); o.z = pk2(w[4], w[5]); o.w = pk2(w[6], w[7]);
        *(LAS v4u*)(lds + L_W + t * RS + sch * 16) = o; }
    __syncthreads();
    const int tb = wid >> 1, cbp = (wid & 1) * 2;
    f32x16 acc[2];
#pragma unroll
    for (int cc = 0; cc < 2; ++cc)
#pragma unroll
        for (int i = 0; i < 16; ++i) acc[cc][i] = 0.f;
#pragma unroll
    for (int ks = 0; ks < 8; ++ks) {
        if (16 * ks <= 32 * tb + 31) {
            const bf16x8 a = *(const LAS bf16x8*)(lds + L_W + (32 * tb + r) * RS + (16 * ks + 8 * hh) * 2);
#pragma unroll
            for (int cc = 0; cc < 2; ++cc) { const bf16x8 b = *(const LAS bf16x8*)(lds + L_Z + (32 * (cbp + cc) + r) * RS + (16 * ks + 8 * hh) * 2); acc[cc] = MFMA32(a, b, acc[cc]); }
        }
    }
#pragma unroll
    for (int cc = 0; cc < 2; ++cc) { const int c = g * 128 + 32 * (cbp + cc) + r;
#pragma unroll
        for (int i = 0; i < 16; ++i) { const int t = 32 * tb + crow(i, hh); const size_t row = (size_t)(R0 + t);
            const float u = bf2f(P[row * PITCH + UOFF + c]); CAT[row * D + 1024 + c] = (bf16)f2bf(u * (acc[cc][i] + sgb[g * 128 + t])); } }
}
}


namespace dsa {
constexpr int PITCH = CINP, KOFF = 2048, VOFF = 2560, QIOFF = 3072, KIOFF = 4096, WIOFF = 4160;
constexpr float CQ = 0.08838834764831845f * LOG2E;
#define MFMA16(a, b, c) __builtin_amdgcn_mfma_f32_16x16x32_bf16((a), (b), (c), 0, 0, 0)
__device__ __forceinline__ float relu_asm(float x) { float r; asm("v_max_f32_e32 %0, 0, %1" : "=v"(r) : "v"(x)); return r; }
constexpr int L_HIST = 0, L_SEL = 0, L_CS = 16384, L_CK = 32768, L_KT = 65536, L_META = 131072, L_TMP = 131584;
#define IDX_WAIT_BAR(N) asm volatile("s_waitcnt vmcnt(" #N ") lgkmcnt(0)\n\ts_barrier" ::: "memory")
constexpr int NCAND = 128;
__device__ __forceinline__ void dma_ktile(LAS unsigned char* lds, const bf16* P, int t, int buf, int wid, int lane) {
#pragma unroll
    for (int i = 0; i < 2; ++i) { const int piece = wid * 2 + i, row = piece * 8 + (lane >> 3), pc = lane & 7, c = pc ^ ((row >> 1) & 7);
        glds16(P + (size_t)(128 * t + row) * PITCH + KIOFF + c * 8, (unsigned)__builtin_amdgcn_readfirstlane(lds_addr(lds) + L_KT + buf * 16384 + piece * 1024)); }
}
template <int PASS, bool FULL> __device__ __forceinline__ void score_tile(LAS unsigned char* lds, const LAS unsigned char* KT, int kb_, int key0, int u, int wid, int r, int hh, int qmaxw,
                                                                          const bf16x8 (&aq)[2][4], const float (&w)[2][16], int T0, int T1) {
    LAS unsigned* hist = (LAS unsigned*)(lds + L_HIST); LAS unsigned short* sel = (LAS unsigned short*)(lds + L_SEL);
    LAS float* cs = (LAS float*)(lds + L_CS); LAS unsigned short* ck = (LAS unsigned short*)(lds + L_CK); LAS int* meta = (LAS int*)(lds + L_META);
    bf16x8 bk[2][4];
#pragma unroll
    for (int ks = 0; ks < 4; ++ks) bk[0][ks] = *(const LAS bf16x8*)(KT + (((2 * ks) ^ kb_) << 4));
#pragma unroll
    for (int sb = 0; sb < 4; ++sb) {
        if (sb < 3) {
#pragma unroll
            for (int ks = 0; ks < 4; ++ks) bk[(sb + 1) & 1][ks] = *(const LAS bf16x8*)(KT + (sb + 1) * 4096 + (((2 * ks) ^ kb_) << 4));
        }
        __builtin_amdgcn_sched_barrier(0);
        if (FULL || key0 + 32 * sb <= qmaxw) {
            f32x16 acc[2];
#pragma unroll
            for (int p = 0; p < 2; ++p)
#pragma unroll
                for (int i = 0; i < 16; ++i) acc[p][i] = 0.f;
            __builtin_amdgcn_s_setprio(1);
#pragma unroll
            for (int ks = 0; ks < 4; ++ks)
#pragma unroll
                for (int p = 0; p < 2; ++p) acc[p] = MFMA32(aq[p][ks], bk[sb & 1][ks], acc[p]);
            __builtin_amdgcn_s_setprio(0);
            asm volatile("s_nop 15\n\ts_nop 7" : "+v"(acc[0]), "+v"(acc[1]));
#pragma unroll
            for (int p = 0; p < 2; ++p) {
                float s4[4] = {0.f, 0.f, 0.f, 0.f};
#pragma unroll
                for (int i = 0; i < 16; ++i) s4[i & 3] += relu_asm(acc[p][i]) * w[p][i];
                const float sc = (s4[0] + s4[1]) + (s4[2] + s4[3]);
                const int rl = 4 * wid + 2 * p + hh, key = key0 + 32 * sb + r;
                int b = (int)((sc + 32.0f) * 8.0f); b = b < 0 ? 0 : (b > 511 ? 511 : b);
                if (FULL || key <= 32 * u + rl) {
                    if (PASS == 1) (void)__hip_atomic_fetch_add(&hist[rl * 512 + b], 1u, __ATOMIC_RELAXED, __HIP_MEMORY_SCOPE_WORKGROUP);
                    else { const int T = p ? T1 : T0;
                        if (b > T) { const int pos = __hip_atomic_fetch_add(&meta[rl], 1, __ATOMIC_RELAXED, __HIP_MEMORY_SCOPE_WORKGROUP); if (pos < 256) sel[rl * 256 + pos] = (unsigned short)key; }
                        else if (b == T) { const int pos = __hip_atomic_fetch_add(&meta[32 + rl], 1, __ATOMIC_RELAXED, __HIP_MEMORY_SCOPE_WORKGROUP); if (pos < NCAND) { cs[rl * NCAND + pos] = sc; ck[rl * NCAND + pos] = (unsigned short)key; } } }
                }
            }
        }
    }
}
template <int PASS> __device__ __forceinline__ void score_pass(LAS unsigned char* lds, const bf16* P, int u, int wid, int lane, const bf16x8 (&aq)[2][4], const float (&w)[2][16], int T0, int T1) {
    const int r = lane & 31, hh = lane >> 5;
    const int NT = (32 * u + 32 + 127) >> 7, qmaxw = 32 * u + 4 * wid + 3;
    const int kb0 = hh ^ ((r >> 1) & 7);
    VM_WAIT();
    dma_ktile(lds, P, 0, 0, wid, lane);
    if (NT > 1) dma_ktile(lds, P, 1, 1, wid, lane);
    IDX_WAIT_BAR(0);
    for (int t = 0; t < NT; t += 2) {
        if (t + 2 < NT) dma_ktile(lds, P, t + 2, (t + 2) & 3, wid, lane);
        if (t + 3 < NT) dma_ktile(lds, P, t + 3, (t + 3) & 3, wid, lane);
        int kb_ = kb0; asm volatile("" : "+v"(kb_));
#pragma unroll
        for (int h2 = 0; h2 < 2; ++h2) {
            const int tt = t + h2;
            if (tt < NT) {
                const LAS unsigned char* KT = lds + L_KT + (tt & 3) * 16384 + r * 128;
                if (128 * tt + 127 <= 32 * u) score_tile<PASS, true>(lds, KT, kb_, 128 * tt, u, wid, r, hh, qmaxw, aq, w, T0, T1);
                else score_tile<PASS, false>(lds, KT, kb_, 128 * tt, u, wid, r, hh, qmaxw, aq, w, T0, T1);
            }
        }
        IDX_WAIT_BAR(0);
    }
}
__device__ __forceinline__ void index_phase(Frame& F, const bf16* P, unsigned short* SEL) {
    LAS unsigned char* lds = F.lds; const int wid = F.wave;
    LAS unsigned* hist = (LAS unsigned*)(lds + L_HIST); LAS unsigned short* sel = (LAS unsigned short*)(lds + L_SEL);
    LAS float* cs = (LAS float*)(lds + L_CS); LAS unsigned short* ck = (LAS unsigned short*)(lds + L_CK); LAS int* meta = (LAS int*)(lds + L_META);
    for (int ui = F.vcu; ui < 512; ui += F.G) {
        int tid = F.tid; asm volatile("" : "+v"(tid));
        const int lane = tid & 63, r = lane & 31, hh = lane >> 5;
        const int u = (ui < 256) ? ui : 767 - ui;
        __syncthreads();
        if (u < 8) {
            for (int e = tid; e < 32 * 256; e += 512) { const int q = 32 * u + (e >> 8), jj = e & 255; SEL[(size_t)q * 256 + jj] = (unsigned short)(jj <= q ? jj : 0); }
            continue;
        }
        { v4u z = {0u, 0u, 0u, 0u};
#pragma unroll
            for (int i = 0; i < 8; ++i) *(LAS v4u*)(lds + L_HIST + (tid + 512 * i) * 16) = z;
            if (tid < 128) meta[tid] = 0; }
        bf16x8 aq[2][4]; float w[2][16];
#pragma unroll
        for (int p = 0; p < 2; ++p) { const int qrow = 32 * u + 4 * wid + 2 * p + ((r >> 2) & 1), head = (r & 3) + 4 * (r >> 3);
#pragma unroll
            for (int ks = 0; ks < 4; ++ks) aq[p][ks] = *(const bf16x8*)(P + (size_t)qrow * PITCH + QIOFF + head * 64 + ks * 16 + hh * 8);
            const bf16* wp = P + (size_t)(32 * u + 4 * wid + 2 * p + hh) * PITCH + WIOFF;
            const bf16x8 w0 = *(const bf16x8*)wp, w1 = *(const bf16x8*)(wp + 8);
#pragma unroll
            for (int i = 0; i < 8; ++i) { w[p][i] = bf2f((unsigned short)w0[i]) * 0.125f; w[p][8 + i] = bf2f((unsigned short)w1[i]) * 0.125f; } }
        __syncthreads();
        score_pass<1>(lds, P, u, wid, lane, aq, w, 0, 0);
        LAS int* tmp = (LAS int*)(lds + L_TMP) + wid * 64;
        for (int rr = 0; rr < 4; ++rr) { const int rl = 4 * wid + rr;
            unsigned cw[8]; { const v4u a = *(const LAS v4u*)(hist + rl * 512 + 8 * lane), b = *(const LAS v4u*)(hist + rl * 512 + 8 * lane + 4);
                cw[0] = a.x; cw[1] = a.y; cw[2] = a.z; cw[3] = a.w; cw[4] = b.x; cw[5] = b.y; cw[6] = b.z; cw[7] = b.w; }
            int ls = 0;
#pragma unroll
            for (int i = 0; i < 8; ++i) ls += (int)cw[i];
            int suf = ls;
#pragma unroll
            for (int off = 1; off < 64; off <<= 1) { tmp[lane] = suf; LDS_WAIT(); const int o2 = lane + off; const int v = tmp[o2 < 64 ? o2 : 63]; LDS_WAIT(); suf += (o2 < 64) ? v : 0; }
            const unsigned long long bal = __ballot(suf >= 256);
            const int L = 63 - __builtin_clzll(bal | 1ull);
            if (lane == L) { int cum = suf - ls, T = 8 * L, cab = cum; bool found = false;
#pragma unroll
                for (int bb = 7; bb >= 0; --bb) { const int cnt = (int)cw[bb];
                    if (!found) { if (cum + cnt >= 256) { T = 8 * L + bb; cab = cum; found = true; } else cum += cnt; } }
                meta[64 + rl] = T; meta[96 + rl] = cab; }
            LDS_WAIT(); asm volatile("" ::: "memory"); }
        __syncthreads();
        { v4u z = {0u, 0u, 0u, 0u};
#pragma unroll
            for (int i = 0; i < 2; ++i) *(LAS v4u*)(lds + L_SEL + (tid + 512 * i) * 16) = z; }
        const int T0 = meta[64 + 4 * wid + hh], T1 = meta[64 + 4 * wid + 2 + hh];
        score_pass<2>(lds, P, u, wid, lane, aq, w, T0, T1);
        for (int rr = 0; rr < 4; ++rr) { const int rl = 4 * wid + rr; const int cab = meta[96 + rl], need = 256 - cab; int m = meta[32 + rl]; m = m > NCAND ? NCAND : m;
#pragma unroll
            for (int half = 0; half < 2; ++half) { const int i = lane + 64 * half; const float si = cs[rl * NCAND + i]; const int ki = ck[rl * NCAND + i]; int rank = 0;
                for (int j2 = 0; j2 < m; ++j2) { const float sj = cs[rl * NCAND + j2]; const int kj = ck[rl * NCAND + j2]; rank += (sj > si || (sj == si && kj < ki)) ? 1 : 0; }
                if (i < m && rank < need) sel[rl * 256 + cab + rank] = (unsigned short)ki; }
            LDS_WAIT(); asm volatile("" ::: "memory");
            const v2u o = *(const LAS v2u*)(lds + L_SEL + rl * 512 + lane * 8);
            *(GAS v2u*)(SEL + (size_t)(32 * u + rl) * 256 + 4 * lane) = o; }
#if MK_DUP & 128
        __syncthreads(); score_pass<1>(lds, P, u, wid, lane, aq, w, 0, 0);
#endif
#if MK_DUP & 256
        __syncthreads(); score_pass<2>(lds, P, u, wid, lane, aq, w, T0 + 512, T1 + 512);
#endif
    }
}
constexpr int A_LUT = 0, A_SEL = 8448, A_V = 16384;
__device__ __forceinline__ void attn_phase(Frame& F, const bf16* P, const unsigned short* SEL, bf16* CAT, const float* rel) {
    LAS unsigned char* lds = F.lds; const int tid = F.tid, lane = F.lane, wid = F.wave;
    LAS float* lut = (LAS float*)(lds + A_LUT);
    __syncthreads();
    for (int e = tid; e < 129 * 16; e += 512) lut[e] = rel[REL_BUCKET[e >> 4] * 16 + (e & 15)] * LOG2E;
    __syncthreads();
    LAS unsigned short* sb = (LAS unsigned short*)(lds + A_SEL) + wid * 256; LAS unsigned char* vbuf = lds + A_V + wid * 16384;
    const int c16 = lane & 15, q4 = lane >> 4, qq = c16 >> 2, p4 = c16 & 3;
    const int rho = 4 * q4 + qq, vx0 = rho & 7, vbase = rho * 256 + (p4 & 1) * 8;
    const int gw = F.vcu * NWAVES + wid, NGW = F.G * NWAVES;
    for (int q = gw; q < S; q += NGW) {
        const int count = (q + 1 < 256) ? q + 1 : 256;
        *(LAS v2u*)(sb + 4 * lane) = *(const GAS v2u*)(SEL + (size_t)q * 256 + 4 * lane);
        LDS_WAIT(); asm volatile("" ::: "memory");
        for (int g = 0; g < 4; ++g) {
            const int head = 4 * g + (c16 & 3);
            bf16x8 qb[4];
#pragma unroll
            for (int ks = 0; ks < 4; ++ks) qb[ks] = *(const bf16x8*)(P + (size_t)q * PITCH + head * 128 + q4 * 32 + ks * 8);
            f32x4 s[16];
#pragma unroll
            for (int bt = 0; bt < 2; ++bt) {
                bf16x8 ak[8][4];
#pragma unroll
                for (int b2 = 0; b2 < 8; ++b2) { const int kpos = sb[16 * (8 * bt + b2) + c16]; const bf16* kp = P + (size_t)kpos * PITCH + KOFF + g * 128 + q4 * 32;
#pragma unroll
                    for (int ks = 0; ks < 4; ++ks) ak[b2][ks] = *(const bf16x8*)(kp + ks * 8); }
#pragma unroll
                for (int b2 = 0; b2 < 8; ++b2) { f32x4 a = {0.f, 0.f, 0.f, 0.f};
#pragma unroll
                    for (int ks = 0; ks < 4; ++ks) a = MFMA16(ak[b2][ks], qb[ks], a);
                    s[8 * bt + b2] = a; }
            }
            float mx = -INFINITY;
#pragma unroll
            for (int b = 0; b < 16; ++b) { const v2u kk2 = *(const LAS v2u*)(sb + 16 * b + 4 * q4);
#pragma unroll
                for (int i = 0; i < 4; ++i) { const int jj = 16 * b + 4 * q4 + i; const int kpos = (int)(((i & 2) ? kk2.y : kk2.x) >> ((i & 1) * 16)) & 0xffff;
                    int dist = q - kpos; dist = dist < 0 ? 0 : (dist > 128 ? 128 : dist);
                    (void)jj; s[b][i] += lut[dist * 16 + head]; } }
            if (count < 256) {
                int cnt = count - 4 * q4; asm volatile("" : "+v"(cnt));
#pragma unroll
                for (int b = 0; b < 16; ++b)
#pragma unroll
                    for (int i = 0; i < 4; ++i) if (16 * b + i >= cnt) s[b][i] = -INFINITY; }
#pragma unroll
            for (int b = 0; b < 16; ++b)
#pragma unroll
                for (int i = 0; i < 4; ++i) mx = fmaxf(mx, s[b][i]);
            mx = fmaxf(mx, swz_xor<16>(mx)); mx = max32(mx);
            float sum = 0.f;
#pragma unroll
            for (int b = 0; b < 16; ++b)
#pragma unroll
                for (int i = 0; i < 4; ++i) { const float pv = __builtin_amdgcn_exp2f(s[b][i] - mx); s[b][i] = pv; sum += pv; }
            sum += swz_xor<16>(sum); sum = sum32(sum);
            bf16x8 pb[8];
#pragma unroll
            for (int kk = 0; kk < 8; ++kk) { v4u wv; wv.x = cvtpk(s[2 * kk][0], s[2 * kk][1]); wv.y = cvtpk(s[2 * kk][2], s[2 * kk][3]); wv.z = cvtpk(s[2 * kk + 1][0], s[2 * kk + 1][1]); wv.w = cvtpk(s[2 * kk + 1][2], s[2 * kk + 1][3]);
                pb[kk] = __builtin_bit_cast(bf16x8, wv); }
            f32x4 O[8];
#pragma unroll
            for (int db = 0; db < 8; ++db) O[db] = (f32x4){0.f, 0.f, 0.f, 0.f};
#define SPA_DMA(kk_) do { _Pragma("unroll") for (int pi = 0; pi < 8; ++pi) { const int row = 4 * pi + (lane >> 4), pc = lane & 15, c = pc ^ (2 * (row & 7)); const int kpos = sb[32 * (kk_) + row]; \
                glds16(P + (size_t)kpos * PITCH + VOFF + g * 128 + c * 8, (unsigned)__builtin_amdgcn_readfirstlane(lds_addr(vbuf) + ((kk_) & 1) * 8192 + pi * 1024)); } } while (0)
            VM_WAIT();
            SPA_DMA(0);
#pragma unroll
            for (int kk = 0; kk < 8; ++kk) {
                if (kk < 7) { LDS_WAIT(); SPA_DMA(kk + 1); asm volatile("s_waitcnt vmcnt(8)" ::: "memory"); }
                else asm volatile("s_waitcnt vmcnt(0)" ::: "memory");
                int vx = vx0; asm volatile("" : "+v"(vx));
#pragma unroll
                for (int db = 0; db < 8; ++db) { const LAS unsigned char* a0 = vbuf + (kk & 1) * 8192 + vbase + (((((db ^ vx) << 1) | (p4 >> 1))) << 4);
                    const s16x4 lo = vtr(a0), hi = vtr(a0 + 4096);
                    const bf16x8 vf = (bf16x8){lo[0], lo[1], lo[2], lo[3], hi[0], hi[1], hi[2], hi[3]};
                    O[db] = MFMA16(vf, pb[kk], O[db]); }
            }
#undef SPA_DMA
            if (c16 < 4) { const float inv = 1.0f / sum; GAS bf16* op = (GAS bf16*)CAT + (size_t)q * D + head * 128 + 4 * q4;
#pragma unroll
                for (int db = 0; db < 8; ++db) { v2u wv; wv.x = cvtpk(O[db][0] * inv, O[db][1] * inv); wv.y = cvtpk(O[db][2] * inv, O[db][3] * inv); *(GAS v2u*)(op + 16 * db) = wv; } }
        }
    }
}
}


struct Args;
__device__ __forceinline__ const float* in_ptr(const Args& a, int i);
struct Args { const float* in[19]; float* out; unsigned char* ws; int ph_lo, ph_hi; };
__device__ __forceinline__ const float* in_ptr(const Args& a, int i) { (void)a; extern __shared__ __attribute__((aligned(16))) unsigned char lds_all[];
    const unsigned long long v = ((const LAS unsigned long long*)((LAS unsigned char*)lds_all + INP_OFF))[i];
    const unsigned lo = __builtin_amdgcn_readfirstlane((unsigned)v), hi = __builtin_amdgcn_readfirstlane((unsigned)(v >> 32));
    return (const float*)(((unsigned long long)hi << 32) | lo); }
constexpr int N_PHASES = 45 + ((MK_DUP & 4) ? 2 : 0) + ((MK_DUP & 8) ? 2 : 0) + ((MK_DUP & 64) ? 8 : 0) + ((MK_DUP & 16) ? 1 : 0) + ((MK_DUP & 1) ? 2 : 0) + ((MK_DUP & 2) ? 2 : 0) + ((MK_DUP & 512) ? 8 : 0) + ((MK_DUP & 32) ? 8 : 0);
typedef pg8::StaticOrder SOrd;
#define GEMM_PHASE(EPI, g, E, WGM_) do { int bx_ = (int)blockIdx.x, G_ = F.G; asm volatile("" : "+s"(bx_), "+s"(G_));   \
    SOrd S_; S_.init((g).M, (g).N, G_, bx_, (WGM_)); pg8::gemm_phase<EPI, SOrd, MK_ALIGN, MK_SP2>(F.lds, (g), S_, (E)); } while (0)

__global__ void __launch_bounds__(NWAVES * 64, 2) fwd_kernel(Args args) {
    extern __shared__ __attribute__((aligned(16))) unsigned char lds[];
    Frame F;
    F.lds = (LAS unsigned char*)lds;
    F.tid = threadIdx.x; F.lane = F.tid & 63; F.wave = __builtin_amdgcn_readfirstlane(F.tid >> 6);
    F.G = gridDim.x; { const int bx = blockIdx.x; F.vcu = (F.G % 8 == 0) ? (bx % 8) * (F.G / 8) + bx / 8 : bx; }
    volatile LAS unsigned* MISC = (volatile LAS unsigned*)(F.lds + MISC_OFF);
    if (F.tid < 64) MISC[F.tid] = 0u;
    if (F.tid == 0) { LAS unsigned long long* ip = (LAS unsigned long long*)(F.lds + INP_OFF);
#pragma unroll
        for (int i = 0; i < 19; ++i) ip[i] = (unsigned long long)args.in[i]; }
    __syncthreads();
    const int lo = args.ph_lo, hi = args.ph_hi;
    XcdBarrier bar; bar.bar = (unsigned*)(args.ws + WS_CTL) + CW_BAR; bar.x = 0; bar.st = nullptr;
    if (hi - lo > 1) bar = xcd_barrier_post((unsigned*)(args.ws + WS_CTL) + CW_BAR, MISC + 8, F.wave);
    int ph = 0;
#define RUN() (lo <= ph && ph < hi)
#define SEAM() do { if (lo <= ph && ph + 1 < hi) { XcdBarrier b_ = bar; asm volatile("" : "+s"(b_.bar), "+s"(b_.x));   xcd_barrier(b_, F.wave); } ++ph; } while (0)

#define WSP() unsigned char* ws = args.ws; asm volatile("" : "+s"(ws)); \
    { int t_ = threadIdx.x; asm volatile("" : "+v"(t_)); F.tid = t_; F.lane = t_ & 63; }     \
    float* XRES = (float*)(ws + WS_XRES); bf16* XN = (bf16*)(ws + WS_XN); bf16* H = (bf16*)(ws + WS_H); bf16* PROJ = (bf16*)(ws + WS_PROJ); bf16* CAT = (bf16*)(ws + WS_CAT); \
    const float* NA = (const float*)(ws + WS_VEC); const float* NB = NA + 12 * 2048; const float* GT = NB + 12 * 2048; \
    (void)XRES; (void)XN; (void)H; (void)PROJ; (void)CAT; (void)NA; (void)NB; (void)GT;
#define INP(i) in_ptr(args, (i))

    if (RUN()) { WSP(); prologue_phase(F, args, ws); }
#if MK_DUP & 16
    SEAM(); if (RUN()) { WSP(); prologue_phase(F, args, ws); }
#endif
    SEAM();
    if (RUN()) { WSP(); vec_phase(F, args, ws); }
    SEAM();

    for (int s = 0; s < 8; ++s) {
        asm volatile("" : "+s"(F.wave), "+s"(F.vcu), "+s"(F.G));
        const int l = s >> 1, f = s & 1, jn = f ? 2 : 0;
        if (RUN()) { WSP(); const float* xsrc = (s == 0) ? INP(0) : XRES; norm_phase(F, xsrc, NA + (l * 3 + jn) * 2048, NB + (l * 3 + jn) * 2048, XN); }
        SEAM();
#if MK_DUP & 32
        if (RUN()) { WSP(); const float* xsrc = (s == 0) ? INP(0) : XRES; norm_phase(F, xsrc, NA + (l * 3 + jn) * 2048, NB + (l * 3 + jn) * 2048, XN); }
        SEAM();
#endif
        if (RUN()) { WSP(); pg8::Gemm g{XN, (const bf16*)(ws + WS_W1T) + (size_t)s * W1T_SZ, S, 2 * DFF, D, 0}; pg8::EpiSwiglu E{H, DFF}; GEMM_PHASE(pg8::EpiSwiglu, g, E, MK_WGM_UP); }
        SEAM();
#if MK_DUP & 64
        if (RUN()) { WSP(); pg8::Gemm g{XN, (const bf16*)(ws + WS_W1T) + (size_t)s * W1T_SZ, S, 2 * DFF, D, 0}; pg8::EpiSwiglu E{H, DFF}; GEMM_PHASE(pg8::EpiSwiglu, g, E, MK_WGM_UP); }
        SEAM();
#endif
        if (RUN()) { WSP(); const float* xsrc = (s == 0) ? INP(0) : XRES; pg8::Gemm g{H, (const bf16*)(ws + WS_W2T) + (size_t)s * W2T_SZ, S, D, DFF, 1}; pg8::EpiResid E{xsrc, XRES, GT + (l * 3 + jn) * 2048, D}; GEMM_PHASE(pg8::EpiResid, g, E, MK_WGM_DN); }
        SEAM();
#if MK_DUP & 512
        if (RUN()) { WSP(); pg8::Gemm g{H, (const bf16*)(ws + WS_W2T) + (size_t)s * W2T_SZ, S, D, DFF, 1}; pg8::EpiResid E{XRES, XRES, (const float*)(ws + WS_CTL + 524288), D}; GEMM_PHASE(pg8::EpiResid, g, E, MK_WGM_OUT); }
        SEAM();
#endif
        if (f == 0) {
            if (RUN()) { WSP(); norm_phase(F, XRES, NA + (l * 3 + 1) * 2048, NB + (l * 3 + 1) * 2048, XN); }
            SEAM();
            const int j = l >> 1;
            if ((l & 1) == 0) {
                if (RUN()) { WSP(); pg8::Gemm g{XN, (const bf16*)(ws + WS_ABIN) + (size_t)j * ABIN_SZ, S, ABN, D, 0}; pg8::EpiProj E{PROJ, ABN, 4, da::C2, 12}; GEMM_PHASE(pg8::EpiProj, g, E, MK_WGM_IN); }
                SEAM();
                if (RUN()) {
#if MK_AB
                    WSP();
                    const float* lp = INP(10) + j * 256;
                    const float s01 = wave_sum(lp[F.lane] * lp[64 + F.lane]), s23 = wave_sum(lp[128 + F.lane] * lp[192 + F.lane]);
                    const float lam_init = (j == 0) ? 0.2f : 0.4707130183435842f;
                    const float lam = expf(s01) - expf(s23) + lam_init;
                    for (int ui = F.vcu; ui < 1024; ui += F.G) { const int v = ui & 255, k = ui >> 8, h = v >> 5, p = v & 31;
                        const int qb = (k == 0) ? p : (k == 1) ? 127 - p : (k == 2) ? 63 - p : 64 + p;
                        da::unit(F.tid, F.lds, PROJ, CAT, h, qb, lam, 1.0f - lam_init, INP(11) + j * 128, INP(7)); }
                    for (int ui = F.vcu; ui < 1024; ui += F.G)
                        sgp::unit(F.tid, F.lds, PROJ, CAT, ui >> 3, ui & 7, INP(12) + j * 1024, INP(13) + j * 1024, INP(14) + (size_t)j * 8 * 128 * 128, INP(15) + j * 8 * 128);
#endif
                }
                SEAM();
#if MK_DUP & 2
                if (RUN()) { WSP();
                    for (int ui = F.vcu; ui < 1024; ui += F.G)
                        sgp::unit(F.tid, F.lds, PROJ, CAT, ui >> 3, ui & 7, INP(12) + j * 1024, INP(13) + j * 1024, INP(14) + (size_t)j * 8 * 128 * 128, INP(15) + j * 8 * 128); }
                SEAM();
#endif
#if MK_DUP & 1
                if (RUN()) {
#if MK_AB
                    WSP();
                    const float* lp = INP(10) + j * 256;
                    const float s01 = wave_sum(lp[F.lane] * lp[64 + F.lane]), s23 = wave_sum(lp[128 + F.lane] * lp[192 + F.lane]);
                    const float lam_init = (j == 0) ? 0.2f : 0.4707130183435842f;
                    const float lam = expf(s01) - expf(s23) + lam_init;
                    for (int ui = F.vcu; ui < 1024; ui += F.G) { const int v = ui & 255, k = ui >> 8, h = v >> 5, p = v & 31;
                        const int qb = (k == 0) ? p : (k == 1) ? 127 - p : (k == 2) ? 63 - p : 64 + p;
                        da::unit(F.tid, F.lds, PROJ, CAT, h, qb, lam, 1.0f - lam_init, INP(11) + j * 128, INP(7)); }
                    for (int ui = F.vcu; ui < 1024; ui += F.G)
                        sgp::unit(F.tid, F.lds, PROJ, CAT, ui >> 3, ui & 7, INP(12) + j * 1024, INP(13) + j * 1024, INP(14) + (size_t)j * 8 * 128 * 128, INP(15) + j * 8 * 128);
#endif
                }
                SEAM();
#endif
                if (RUN()) {
#if MK_AB
                    WSP(); pg8::Gemm g{CAT, (const bf16*)(ws + WS_ABOUT) + (size_t)j * SQ_SZ, S, D, D, 0}; pg8::EpiResid E{XRES, XRES, GT + (l * 3 + 1) * 2048, D}; GEMM_PHASE(pg8::EpiResid, g, E, MK_WGM_OUT);
#endif
                }
                SEAM();
            } else {
                if (RUN()) {
#if MK_DSA
                    WSP(); pg8::Gemm g{XN, (const bf16*)(ws + WS_DSAIN) + (size_t)j * DSAIN_SZ, S, CINP, D, 0}; pg8::EpiProj E{PROJ, CINP, 8, dsa::CQ, 1000}; GEMM_PHASE(pg8::EpiProj, g, E, MK_WGM_IN);
#endif
                }
                SEAM();
                if (RUN()) {
#if MK_DSA
                    WSP(); dsa::index_phase(F, PROJ, (unsigned short*)(ws + WS_SEL));
#endif
                }
                SEAM();
#if MK_DUP & 4
                if (RUN()) { WSP(); dsa::index_phase(F, PROJ, (unsigned short*)(ws + WS_SEL)); }
                SEAM();
#endif
                if (RUN()) {
#if MK_DSA
                    WSP(); dsa::attn_phase(F, PROJ, (const unsigned short*)(ws + WS_SEL), CAT, INP(7));
#endif
                }
                SEAM();
#if MK_DUP & 8
                if (RUN()) { WSP(); dsa::attn_phase(F, PROJ, (const unsigned short*)(ws + WS_SEL), CAT, INP(7)); }
                SEAM();
#endif
                if (RUN()) {
#if MK_DSA
                    WSP(); pg8::Gemm g{CAT, (const bf16*)(ws + WS_DSAOUT) + (size_t)j * SQ_SZ, S, D, D, 0}; pg8::EpiResid E{XRES, XRES, GT + (l * 3 + 1) * 2048, D}; GEMM_PHASE(pg8::EpiResid, g, E, MK_WGM_OUT);
#endif
                }
                SEAM();
            }
        }
    }
    if (RUN()) { WSP(); final_norm_phase(F, XRES, INP(18), args.out); }
    ++ph;
#undef RUN
#undef SEAM
}


#if MK_DIAG
__device__ const int DG_ROWS[16] = {0, 129, 255, 256, 1000, 2500, 4097, 6000, 8191, 8192, 9500, 10000, 11111, 12287, 12345, 16383};
__device__ __forceinline__ void dg_max(unsigned* slot, float e) { if (!(e >= 0.f)) e = 1e9f; atomicMax(slot, __builtin_bit_cast(unsigned, e)); }
constexpr int DG_SLOT = 2048;
__global__ void __launch_bounds__(512) diag_check(Args args, int which, int j) {
    extern __shared__ __attribute__((aligned(16))) unsigned char lds[];
    unsigned char* ws = args.ws; unsigned* slot = (unsigned*)(ws + WS_CTL) + DG_SLOT;
    const float* NA = (const float*)(ws + WS_VEC); const float* NB = NA + 12 * 2048; const float* GT = NB + 12 * 2048;
    const bf16* XN = (const bf16*)(ws + WS_XN); const bf16* H = (const bf16*)(ws + WS_H); const float* XRES = (const float*)(ws + WS_XRES);
    const bf16* PROJ = (const bf16*)(ws + WS_PROJ); const bf16* CAT = (const bf16*)(ws + WS_CAT);
    const int tid = threadIdx.x; float* fl = (float*)lds;
    const int row = DG_ROWS[blockIdx.x & 15]; const int sub = blockIdx.x >> 4;
    float err = 0.f;
    if (which == 1) {
        const float* x = args.in[0] + (size_t)row * D; float ss = 0.f;
        for (int c = 0; c < D; ++c) ss += x[c] * x[c];
        const float rstd = 1.0f / sqrtf(ss / D + EPS);
        for (int c = tid; c < D; c += 512) err = fmaxf(err, fabsf(x[c] * rstd * NA[c] + NB[c] - bf2f(XN[(size_t)row * D + c])));
    } else if (which == 2) {
        const float* w1 = args.in[5] + (size_t)j * D * 2 * DFF;
        for (int c = tid; c < DFF; c += 512) { float g = 0.f, u = 0.f;
            for (int k = 0; k < D; ++k) { const float a = bf2f(XN[(size_t)row * D + k]); g += a * w1[(size_t)k * 2 * DFF + c]; u += a * w1[(size_t)k * 2 * DFF + DFF + c]; }
            const float ref = g / (1.0f + expf(-g)) * u; err = fmaxf(err, fabsf(ref - bf2f(H[(size_t)row * DFF + c]))); }
    } else if (which == 3) {
        const float* w2 = args.in[6] + (size_t)j * DFF * D; const float* x = (j == 0) ? args.in[0] : (const float*)(ws + WS_END);
        const float* gt = GT + ((j >> 1) * 3 + ((j & 1) ? 2 : 0)) * 2048;
        for (int c = tid; c < D; c += 512) { float a = 0.f;
            for (int k = 0; k < DFF; ++k) a += bf2f(H[(size_t)row * DFF + k]) * w2[(size_t)k * D + c];
            err = fmaxf(err, fabsf(x[(size_t)row * D + c] + gt[c] * a - XRES[(size_t)row * D + c])); }
    } else if (which == 4) {
        const float* w = args.in[8] + (size_t)j * D * ABN;
        for (int c = tid; c < ABN; c += 512) { float a = 0.f;
            for (int k = 0; k < D; ++k) a += bf2f(XN[(size_t)row * D + k]) * w[(size_t)k * ABN + c];
            if (c < 1024) a *= da::C2; if (c >= 3072) a = 0.5f * a * (1.0f + tanhf(0.7978845608028654f * (a + 0.044715f * a * a * a)));
            err = fmaxf(err, fabsf(a - bf2f(PROJ[(size_t)row * ABN + c]))); }
    } else if (which == 5) {
        const int h = sub;
        const float* lp = args.in[10] + j * 256; float s01 = 0.f, s23 = 0.f;
        for (int i = 0; i < 64; ++i) { s01 += lp[i] * lp[64 + i]; s23 += lp[128 + i] * lp[192 + i]; }
        const float lam_init = 0.8f - 0.6f * expf(-0.3f * (2 * j)), lam = expf(s01) - expf(s23) + lam_init;
        float* lg = fl;
        float* red = fl + 2 * 16384;
        for (int m = 0; m < 2; ++m) {
            for (int key = tid; key <= row; key += 512) { float a = 0.f;
                for (int d = 0; d < 64; ++d) a += bf2f(PROJ[(size_t)row * ABN + h * 128 + m * 64 + d]) * bf2f(PROJ[(size_t)key * ABN + 1024 + h * 128 + m * 64 + d]);
                const int dist = row - key; a += args.in[7][REL_BUCKET[dist > 128 ? 128 : dist] * 16 + h * 2 + m] * LOG2E; lg[m * 16384 + key] = a; }
        }
        __syncthreads();
        float mx[2], sm[2];
        for (int m = 0; m < 2; ++m) { float v = -INFINITY; for (int key = tid; key <= row; key += 512) v = fmaxf(v, lg[m * 16384 + key]);
            red[tid] = v; __syncthreads(); if (tid == 0) { float t = -INFINITY; for (int i = 0; i < 512; ++i) t = fmaxf(t, red[i]); red[512] = t; } __syncthreads(); mx[m] = red[512]; __syncthreads();
            float s = 0.f; for (int key = tid; key <= row; key += 512) s += exp2f(lg[m * 16384 + key] - mx[m]);
            red[tid] = s; __syncthreads(); if (tid == 0) { float t = 0.f; for (int i = 0; i < 512; ++i) t += red[i]; red[512] = t; } __syncthreads(); sm[m] = red[512]; __syncthreads(); }
        const int e = tid & 127, part = tid >> 7; float o = 0.f;
        for (int key = part; key <= row; key += 4) { const float p = exp2f(lg[key] - mx[0]) / sm[0] - lam * exp2f(lg[16384 + key] - mx[1]) / sm[1]; o += p * bf2f(PROJ[(size_t)key * ABN + 2048 + h * 128 + e]); }
        red[tid] = o; __syncthreads();
        if (tid < 128) { o = red[tid] + red[128 + tid] + red[256 + tid] + red[384 + tid]; red[512 + tid] = o * o; red[tid] = o; } __syncthreads();
        if (tid == 0) { float t = 0.f; for (int i = 0; i < 128; ++i) t += red[512 + i]; red[700] = t; } __syncthreads();
        if (tid < 128) { const float ref = red[tid] / sqrtf(red[700] / 128.0f + EPS) * args.in[11][j * 128 + tid] * (1.0f - lam_init);
            err = fabsf(ref - bf2f(CAT[(size_t)row * D + h * 128 + tid])); }
    } else if (which == 7) {
        const float* w2 = args.in[6]; const float* x = args.in[0]; const float* wo = args.in[9] + (size_t)j * D * D;
        for (int c = tid; c < D; c += 512) { float a = 0.f, b = 0.f;
            for (int k = 0; k < DFF; ++k) a += bf2f(H[(size_t)row * DFF + k]) * w2[(size_t)k * D + c];
            for (int k = 0; k < D; ++k) b += bf2f(CAT[(size_t)row * D + k]) * wo[(size_t)k * D + c];
            err = fmaxf(err, fabsf(x[(size_t)row * D + c] + GT[c] * a + GT[2048 + c] * b - XRES[(size_t)row * D + c])); }
    } else if (which == 8) {
        const int lj = sub, l = lj / 3, jj = lj % 3;
        if (tid < 8) { const int col = (DG_ROWS[blockIdx.x & 15] + 257 * tid) & 2047; float mv[3];
            for (int t = 0; t < 3; ++t) { const int n = (3 * jj + t) * 2048 + col; float a = args.in[4][l * NMODV + n];
                for (int k = 0; k < 2048; ++k) { const float cv = args.in[1][k]; a += cv / (1.0f + expf(-cv)) * args.in[3][((size_t)l * 2048 + k) * NMODV + n]; } mv[t] = a; }
            err = fmaxf(fabsf(args.in[2][lj * 2048 + col] * (1.0f + mv[1]) - NA[lj * 2048 + col]), fabsf(mv[0] - NB[lj * 2048 + col]));
            err = fmaxf(err, fabsf((jj == 1 ? 1.0f : 0.5f) * (1.0f + mv[2]) - GT[lj * 2048 + col])); }
    } else if (which == 9) {
        const float* x = XRES + (size_t)row * D; float ss = 0.f;
        for (int c = 0; c < D; ++c) ss += x[c] * x[c];
        const float rstd = 1.0f / sqrtf(ss / D + EPS);
        for (int c = tid; c < D; c += 512) err = fmaxf(err, fabsf(x[c] * rstd * args.in[18][c] - args.out[(size_t)row * D + c]));
    } else if (which == 6) {
        const int n = row >> 7, t = row & 127; float* st = fl;
        for (int s = tid; s <= t; s += 512) { const bf16* z = PROJ + (size_t)(n * 128 + s) * ABN + 4096; float m = 0.f; for (int c = 0; c < 1024; ++c) m += bf2f(z[c]); m /= 1024.0f;
            float q = 0.f; for (int c = 0; c < 1024; ++c) { const float d = bf2f(z[c]) - m; q += d * d; } st[2 * s] = m; st[2 * s + 1] = 1.0f / sqrtf(q / 1024.0f + EPS); }
        __syncthreads();
        for (int c = tid; c < 1024; c += 512) { const int g = c >> 7; float a = 0.f;
            for (int s = 0; s <= t; ++s) { const float zn = (bf2f(PROJ[(size_t)(n * 128 + s) * ABN + 4096 + c]) - st[2 * s]) * st[2 * s + 1] * args.in[12][j * 1024 + c] + args.in[13][j * 1024 + c];
                a += args.in[14][(((size_t)j * 8 + g) * 128 + t) * 128 + s] * zn; }
            a += args.in[15][(j * 8 + g) * 128 + t];
            const float ref = bf2f(PROJ[(size_t)row * ABN + 3072 + c]) * a; err = fmaxf(err, fabsf(ref - bf2f(CAT[(size_t)row * D + 1024 + c]))); }
    }
    dg_max(slot, err);
}
__global__ void diag_out(Args args) {
    const size_t i = (size_t)blockIdx.x * 256 + threadIdx.x; const unsigned* slot = (const unsigned*)(args.ws + WS_CTL) + DG_SLOT;
    if (i < (size_t)S * D) args.out[i] = (i == 0) ? 10.0f + 1.0e4f * __builtin_bit_cast(float, slot[0]) : 0.f;
}
#endif

extern "C" void kernel_launch(void* const* d_in, const int* in_sizes, int n_in, void* d_out, int out_size, void* d_ws, size_t ws_size, hipStream_t stream) {
    static int grid = 0;
    if (grid == 0) {
        if (n_in != 19 || in_sizes[0] != S * D || out_size != S * D || ws_size < WS_END) { fprintf(stderr, "kernel_launch: unexpected shapes (n_in %d, in0 %d, out %d, ws %zu); nothing launched\n", n_in, n_in > 0 ? in_sizes[0] : -1, out_size, ws_size); grid = -1; return; }
        int dev = 0, cus = 0, per_cu = 0;
        if (hipGetDevice(&dev) != hipSuccess || hipDeviceGetAttribute(&cus, hipDeviceAttributeMultiprocessorCount, dev) != hipSuccess) { grid = -1; return; }
        if (hipFuncSetAttribute((const void*)fwd_kernel, hipFuncAttributeMaxDynamicSharedMemorySize, LDS_BYTES) != hipSuccess) { fprintf(stderr, "kernel_launch: hipFuncSetAttribute failed\n"); grid = -1; return; }
        if (hipOccupancyMaxActiveBlocksPerMultiprocessor(&per_cu, (const void*)fwd_kernel, NWAVES * 64, LDS_BYTES) != hipSuccess || per_cu < 1)
            fprintf(stderr, "kernel_launch: note: occupancy query reports %d workgroups per CU\n", per_cu);
        (void)hipGetLastError();
        grid = cus;
    }
    if (grid < 0) return;
    if (hipMemsetAsync((char*)d_ws + WS_CTL, 0, CTL_ZERO_BYTES, stream) != hipSuccess) return;
    Args a{};
    for (int i = 0; i < 19; ++i) a.in[i] = (const float*)d_in[i];
    a.out = (float*)d_out; a.ws = (unsigned char*)d_ws;
#if MK_DIAG == 99
    {
        hipFuncSetAttribute((const void*)diag_check, hipFuncAttributeMaxDynamicSharedMemorySize, 143360);
        const int up_ph[8] = {3, 10, 13, 21, 24, 31, 34, 42}; int done = -1;
        for (int s = 1; s < 8; ++s) {
            for (int p = done + 1; p <= up_ph[s]; ++p) { a.ph_lo = p; a.ph_hi = p + 1; hipLaunchKernelGGL(fwd_kernel, dim3(grid), dim3(NWAVES * 64), LDS_BYTES, stream, a); }
            if (s == 1) hipLaunchKernelGGL(diag_check, dim3(16 * 12), dim3(512), 143360, stream, a, 8, 0);
            hipLaunchKernelGGL(diag_check, dim3(16), dim3(512), 143360, stream, a, 2, s);
            hipMemcpyAsync((char*)d_ws + WS_END, (char*)d_ws + WS_XRES, (size_t)S * D * 4, hipMemcpyDeviceToDevice, stream);
            a.ph_lo = up_ph[s] + 1; a.ph_hi = up_ph[s] + 2; hipLaunchKernelGGL(fwd_kernel, dim3(grid), dim3(NWAVES * 64), LDS_BYTES, stream, a);
            done = up_ph[s] + 1;
            hipLaunchKernelGGL(diag_check, dim3(16), dim3(512), 143360, stream, a, 3, s);
        }
        for (int p = done + 1; p < N_PHASES; ++p) { a.ph_lo = p; a.ph_hi = p + 1; hipLaunchKernelGGL(fwd_kernel, dim3(grid), dim3(NWAVES * 64), LDS_BYTES, stream, a); }
        hipLaunchKernelGGL(diag_check, dim3(16), dim3(512), 143360, stream, a, 9, 0);
        hipLaunchKernelGGL(diag_out, dim3((S * D + 255) / 256), dim3(256), 0, stream, a);
        return;
    }
#elif MK_DIAG
    {
        int digits[8], nd = 0; for (int v = MK_DIAG; v > 0; v /= 10) digits[nd++] = v % 10;
        hipFuncSetAttribute((const void*)diag_check, hipFuncAttributeMaxDynamicSharedMemorySize, 143360);
        int done = -1;
        for (int stage = 0; stage < 3; ++stage) {
            const int upto = ((stage == 0) ? 4 : (stage == 1) ? 7 : 8) + (MK_DIAGJ ? 21 : 0); bool any = false;
            for (int i = 0; i < nd; ++i) { const int w = digits[i]; const int st = (w <= 3) ? 0 : (w <= 6) ? 1 : 2; any |= (st == stage); }
            if (!any) continue;
            for (int p = done + 1; p <= upto; ++p) { a.ph_lo = p; a.ph_hi = p + 1; hipLaunchKernelGGL(fwd_kernel, dim3(grid), dim3(NWAVES * 64), LDS_BYTES, stream, a); }
            done = upto;
            for (int i = 0; i < nd; ++i) { const int w = digits[i]; const int st = (w <= 3) ? 0 : (w <= 6) ? 1 : 2; if (st == stage) hipLaunchKernelGGL(diag_check, dim3(w == 5 ? 128 : 16), dim3(512), 143360, stream, a, w, MK_DIAGJ); }
        }
        hipLaunchKernelGGL(diag_out, dim3((S * D + 255) / 256), dim3(256), 0, stream, a);
        return;
    }
#endif
#if MK_MULTI
    for (int p = 0; p < N_PHASES; ++p) { a.ph_lo = p; a.ph_hi = p + 1; hipLaunchKernelGGL(fwd_kernel, dim3(grid), dim3(NWAVES * 64), LDS_BYTES, stream, a); }
#else
    a.ph_lo = 0; a.ph_hi = N_PHASES;
    hipLaunchKernelGGL(fwd_kernel, dim3(grid), dim3(NWAVES * 64), LDS_BYTES, stream, a);
#endif
    const hipError_t le = hipPeekAtLastError();
    if (le != hipSuccess) fprintf(stderr, "kernel_launch: launch failed: %s\n", hipGetErrorName(le));
}
```

```cpp
#define MK_MULTI 0
#define MK_AB 1
#define MK_DSA 1
#include <hip/hip_runtime.h>
#include <cstdio>
#include <cstdint>
#ifndef MK_DIAG
#define MK_DIAG 0
#endif
#ifndef MK_DIAGJ
#define MK_DIAGJ 0
#endif
#ifndef MK_DUP
#define MK_DUP 0
#endif
#ifndef MK_SP2
#define MK_SP2 true
#endif
#ifndef MK_ALIGN
#define MK_ALIGN true
#endif
#ifndef MK_WGM_UP
#define MK_WGM_UP 4
#endif
#ifndef MK_WGM_DN
#define MK_WGM_DN 2
#endif
#ifndef MK_WGM_IN
#define MK_WGM_IN 4
#endif
#ifndef MK_WGM_OUT
#define MK_WGM_OUT 4
#endif
#ifndef MK_MULTI
#define MK_MULTI 0
#endif

namespace pg8 {
#define PG8_LAS __attribute__((address_space(3)))
typedef unsigned short bf16_t;
typedef short bf16x8 __attribute__((ext_vector_type(8)));
typedef float f32x4 __attribute__((ext_vector_type(4)));
typedef unsigned u32x4 __attribute__((ext_vector_type(4)));
constexpr int BM = 256, BK = 64, HALF = 128, HTB = HALF * BK * 2  , STAGE_BYTES = 8 * HTB, NXCD = 8;

__host__ __device__ __forceinline__ int lds_byte(int r, int c) { const int st = (r >> 4) * 2 + (c >> 5), rr = r & 15, cc = c & 31, ob = rr * 64 + cc * 2; return st * 1024 + (ob ^ (((ob >> 9) & 1) << 5)); }
__host__ __device__ __forceinline__ void stage_rc(int b, int& R, int& C) { const int st = b / 1024, sb = b % 1024, swz = sb ^ (((sb >> 9) & 1) << 5); R = (st >> 1) * 16 + swz / 64; C = (st & 1) * 32 + (swz % 64) / 2; }
__host__ __device__ __forceinline__ int perm32(int rho) { const int n = rho >> 4, i = rho & 15; return 8 * (i >> 2) + 4 * n + (i & 3); }

struct Unit { int pm, pn; };
struct Gemm { const bf16_t* A; const bf16_t* Bt; int M, N, K; int atile; };

struct StaticOrder {
    int nM, nN, nwg, G, c, WGM;
    __host__ __device__ void init(int M, int N, int G_, int c_, int wgm) { nM = M / BM; nN = N / BM; nwg = nM * nN; G = G_; c = c_; WGM = wgm; }
    __host__ __device__ bool next(int i, Unit& u) const {
        const long L = (long)i * G + c; if (L >= nwg) return false;
        int wgid = (int)L; { const int q = nwg / NXCD, r = nwg % NXCD, xcd = wgid % NXCD, off = wgid / NXCD; wgid = (xcd < r ? xcd * (q + 1) : r * (q + 1) + (xcd - r) * q) + off; }
        const int nig = WGM * nN, gid = wgid / nig, fm = gid * WGM, gsz = (nM - fm) < WGM ? (nM - fm) : WGM;
        u.pm = fm + ((wgid % nig) % gsz); u.pn = (wgid % nig) / gsz; return true;
    }
    __device__ __forceinline__ void a_ready(const Unit&) const {}
    __device__ __forceinline__ void done(const Unit&) const {}
};

__device__ __forceinline__ unsigned cvt_pk_bf16(float lo, float hi) { unsigned r; asm volatile("v_cvt_pk_bf16_f32 %0, %1, %2" : "=v"(r) : "v"(lo), "v"(hi)); return r; }
typedef float f32x2 __attribute__((ext_vector_type(2)));

__device__ __forceinline__ float fast_sigmoid(float x) { return __builtin_amdgcn_rcpf(1.0f + __builtin_amdgcn_exp2f(-1.4426950408889634f * x)); }
struct EpiSwiglu {
    static constexpr bool PERM = true, AFTER_DRAIN = false;
    bf16_t* O; int ldc;
    __device__ __forceinline__ void operator()(const f32x4 (&acc)[2][2][4][2], const Unit& u, int wr, int wc, int fr, int fq) const {
        const int rl0 = wr * 64 + fr, col0 = u.pn * HALF + wc * 32 + 8 * fq, kt = col0 >> 6, c = col0 & 63;
        bf16_t* tile = O + ((size_t)u.pm * (ldc >> 6) + kt) * (BM * BK) + c;
#pragma unroll
        for (int ai = 0; ai < 2; ++ai)
#pragma unroll
            for (int m = 0; m < 4; ++m) { bf16_t* rowp = tile + (size_t)(rl0 + ai * HALF + m * 16) * BK;
                const f32x4 g0 = acc[ai][0][m][0], g1 = acc[ai][0][m][1], u0 = acc[ai][1][m][0], u1 = acc[ai][1][m][1];
                float v[8];
#pragma unroll
                for (int j = 0; j < 4; ++j) { v[j] = g0[j] * fast_sigmoid(g0[j]) * u0[j]; v[4 + j] = g1[j] * fast_sigmoid(g1[j]) * u1[j]; }
                u32x4 w; w.x = cvt_pk_bf16(v[0], v[1]); w.y = cvt_pk_bf16(v[2], v[3]); w.z = cvt_pk_bf16(v[4], v[5]); w.w = cvt_pk_bf16(v[6], v[7]);
                *(u32x4*)rowp = w; }
    }
};
struct EpiResid {
    static constexpr bool PERM = false, AFTER_DRAIN = false;
    const float* base; float* out; const float* coef; int ldc;
    __device__ __forceinline__ void operator()(const f32x4 (&acc)[2][2][4][2], const Unit& u, int wr, int wc, int fr, int fq) const {
        const int row0 = u.pm * BM + wr * 64 + fr, col0 = u.pn * BM + wc * 32 + 4 * fq;
        f32x4 cv[2][2];
#pragma unroll
        for (int bj = 0; bj < 2; ++bj)
#pragma unroll
            for (int n = 0; n < 2; ++n) cv[bj][n] = *(const f32x4*)(coef + col0 + bj * HALF + n * 16);
#pragma unroll
        for (int ai = 0; ai < 2; ++ai)
#pragma unroll
            for (int m = 0; m < 4; ++m) { const size_t off = (size_t)(row0 + ai * HALF + m * 16) * ldc + col0;
#pragma unroll
                for (int bj = 0; bj < 2; ++bj)
#pragma unroll
                    for (int n = 0; n < 2; ++n) { const f32x4 b = *(const f32x4*)(base + off + bj * HALF + n * 16);
                        *(f32x4*)(out + off + bj * HALF + n * 16) = b + cv[bj][n] * acc[ai][bj][m][n]; } }
    }
};
struct EpiProj {
    static constexpr bool PERM = true, AFTER_DRAIN = false;
    bf16_t* O; int ldc; int nscale; float scale; int gelu_from;
    __device__ __forceinline__ void operator()(const f32x4 (&acc)[2][2][4][2], const Unit& u, int wr, int wc, int fr, int fq) const {
        const int row0 = u.pm * BM + wr * 64 + fr, col0 = u.pn * BM + wc * 32 + 8 * fq;
        const float sc = (u.pn < nscale) ? scale : 1.0f; const bool gl = (u.pn >= gelu_from);
#pragma unroll
        for (int ai = 0; ai < 2; ++ai)
#pragma unroll
            for (int m = 0; m < 4; ++m) { bf16_t* rowp = O + (size_t)(row0 + ai * HALF + m * 16) * ldc + col0;
#pragma unroll
                for (int bj = 0; bj < 2; ++bj) { f32x4 v0 = acc[ai][bj][m][0] * sc, v1 = acc[ai][bj][m][1] * sc;
                    if (gl) {
#pragma unroll
                        for (int j = 0; j < 4; ++j) { const float a = v0[j], b = v1[j];
                            v0[j] = a * fast_sigmoid(1.5957691216057308f * (a + 0.044715f * a * a * a));
                            v1[j] = b * fast_sigmoid(1.5957691216057308f * (b + 0.044715f * b * b * b)); } }
                    u32x4 w; w.x = cvt_pk_bf16(v0[0], v0[1]); w.y = cvt_pk_bf16(v0[2], v0[3]); w.z = cvt_pk_bf16(v1[0], v1[1]); w.w = cvt_pk_bf16(v1[2], v1[3]);
                    *(u32x4*)(rowp + bj * HALF) = w; } }
    }
};

template <class Epi, class Sched, bool ALIGN_EPI = false, bool SP2 = false>
__device__ __forceinline__ void gemm_phase(PG8_LAS unsigned char* lds, const Gemm g, const Sched& S, const Epi& E) {
    int tid_ = threadIdx.x; asm volatile("" : "+v"(tid_));
    const int tid = tid_, wid = __builtin_amdgcn_readfirstlane(tid >> 6), lane = tid & 63, wr = wid >> 2, wc = wid & 3, fr = lane & 15, fq = lane >> 4;
    const int K = g.K, nt = K / BK;
    unsigned voffA[2], voffB[2];
#pragma unroll
    for (int i = 0; i < 2; ++i) { int R, C; stage_rc(tid * 16 + i * 8192, R, C); const int Rb = Epi::PERM ? ((R & ~31) + perm32(R & 31)) : R;
        voffA[i] = g.atile ? (unsigned)(R * BK + C) * 2u : (unsigned)(R * K + C) * 2u; voffB[i] = (unsigned)(Rb * K + C) * 2u; }
    const size_t kstep = (size_t)(BK * 2);
    const size_t hstep = (size_t)HALF * K * 2;
    const size_t tstep = 2 * hstep;
    const size_t kstepA = g.atile ? (size_t)(BM * BK * 2) : kstep, hstepA = g.atile ? (size_t)(HALF * BK * 2) : hstep, tstepA = g.atile ? (size_t)nt * (BM * BK * 2) : tstep;
    const unsigned ldsw = (unsigned)wid * 1024u;
    const int aoff = lds_byte(wr * 64 + fr, fq * 8), boff = lds_byte(wc * 32 + fr, fq * 8);
#define PG8_SA(b, h) (((b) * 2 + (h)) * HTB)
#define PG8_SB(b, h) ((4 + (b) * 2 + (h)) * HTB)
#define PG8_STAGE(bufoff, gbase, voff) do { _Pragma("unroll") for (int _i = 0; _i < 2; ++_i) \
        __builtin_amdgcn_global_load_lds((const unsigned*)((const char*)(gbase) + (voff)[_i]), (PG8_LAS unsigned*)(lds + (bufoff) + ldsw + _i * 8192), 16, 0, 0); } while (0)
#define PG8_LDA(dst, b, h) do { _Pragma("unroll") for (int m = 0; m < 4; ++m) _Pragma("unroll") for (int k = 0; k < 2; ++k) dst[m][k] = *(const PG8_LAS bf16x8*)(lds + PG8_SA(b, h) + aoff + m * 2048 + k * 1024); } while (0)
#define PG8_LDB(dst, b, h) do { _Pragma("unroll") for (int n = 0; n < 2; ++n) _Pragma("unroll") for (int k = 0; k < 2; ++k) dst[n][k] = *(const PG8_LAS bf16x8*)(lds + PG8_SB(b, h) + boff + n * 2048 + k * 1024); } while (0)
#define PG8_MMA(ai, bj, At, Bt) do { __builtin_amdgcn_s_setprio(1); _Pragma("unroll") for (int m = 0; m < 4; ++m) _Pragma("unroll") for (int n = 0; n < 2; ++n) _Pragma("unroll") for (int k = 0; k < 2; ++k) \
        acc[ai][bj][m][n] = __builtin_amdgcn_mfma_f32_16x16x32_bf16(Bt[n][k], At[m][k], acc[ai][bj][m][n], 0, 0, 0); __builtin_amdgcn_s_setprio(0); } while (0)
#define PG8_WAIT_V(n) asm volatile("s_waitcnt vmcnt(" #n ")" ::: "memory")
#define PG8_WAIT_L(n) asm volatile("s_waitcnt lgkmcnt(" #n ")" ::: "memory")
#define PG8_BAR __builtin_amdgcn_s_barrier()
#define PG8_SCHED __builtin_amdgcn_sched_barrier(0)
    Unit cur, nxt; int ui = 0;
    if (!S.next(0, cur)) return;
    f32x4 acc[2][2][4][2];
#pragma unroll
    for (int a = 0; a < 2; ++a)
#pragma unroll
        for (int b = 0; b < 2; ++b)
#pragma unroll
            for (int m = 0; m < 4; ++m)
#pragma unroll
                for (int n = 0; n < 2; ++n) acc[a][b][m][n] = (f32x4){0.f, 0.f, 0.f, 0.f};
    bf16x8 At[4][2], B0[2][2], B1[2][2];
    const char* cA = (const char*)g.A + (size_t)cur.pm * tstepA; const char* cB = (const char*)g.Bt + (size_t)cur.pn * tstep;
    S.a_ready(cur);
    if constexpr (SP2) {
        PG8_STAGE(PG8_SB(0, 0), cB, voffB); PG8_STAGE(PG8_SB(0, 1), cB + hstep, voffB); PG8_STAGE(PG8_SA(0, 0), cA, voffA); PG8_STAGE(PG8_SA(0, 1), cA + hstepA, voffA);
        if (wr == 1) PG8_BAR;
        PG8_WAIT_V(2); PG8_BAR;
        PG8_STAGE(PG8_SB(1, 0), cB + kstep, voffB); PG8_STAGE(PG8_SA(1, 0), cA + kstepA, voffA); PG8_STAGE(PG8_SB(1, 1), cB + hstep + kstep, voffB);
        PG8_WAIT_V(6); PG8_BAR;
    } else {
        PG8_STAGE(PG8_SB(0, 0), cB, voffB); PG8_STAGE(PG8_SA(0, 0), cA, voffA); PG8_STAGE(PG8_SB(0, 1), cB + hstep, voffB); PG8_STAGE(PG8_SA(0, 1), cA + hstepA, voffA);
        if (wr == 1) PG8_BAR;
        PG8_WAIT_V(4); PG8_BAR;
        PG8_STAGE(PG8_SB(1, 0), cB + kstep, voffB); PG8_STAGE(PG8_SA(1, 0), cA + kstepA, voffA); PG8_STAGE(PG8_SB(1, 1), cB + hstep + kstep, voffB);
        PG8_WAIT_V(6); PG8_BAR;
    }
    for (;;) {
        const bool has_next = S.next(ui + 1, nxt);
        const char* nA = has_next ? (const char*)g.A + (size_t)nxt.pm * tstepA : cA; const char* nB = has_next ? (const char*)g.Bt + (size_t)nxt.pn * tstep : cB;
        for (int t = 0; t < nt; t += 2) {
            const bool last = (t == nt - 2);
            const char* a1 = cA + (size_t)(t + 1) * kstepA;
            const char* a2 = last ? nA : cA + (size_t)(t + 2) * kstepA; const char* b2 = last ? nB : cB + (size_t)(t + 2) * kstep;
            const char* a3 = a2 + kstepA; const char* b3 = b2 + kstep;
            if (last && has_next) S.a_ready(nxt);
            if constexpr (SP2) {
            PG8_LDB(B0, 0, 0); PG8_LDB(B1, 0, 1); PG8_SCHED; PG8_LDA(At, 0, 0); PG8_STAGE(PG8_SA(1, 1), a1 + hstepA, voffA);
            PG8_WAIT_V(8); PG8_WAIT_L(0); PG8_BAR; PG8_MMA(0, 0, At, B0); PG8_MMA(0, 1, At, B1); PG8_BAR; PG8_SCHED;
            PG8_LDA(At, 0, 1); PG8_STAGE(PG8_SB(0, 0), b2, voffB); PG8_STAGE(PG8_SB(0, 1), b2 + hstep, voffB); PG8_STAGE(PG8_SA(0, 0), a2, voffA);
            PG8_WAIT_V(8); PG8_WAIT_L(0); PG8_BAR; PG8_MMA(1, 0, At, B0); PG8_MMA(1, 1, At, B1); PG8_BAR; PG8_SCHED;
            PG8_LDB(B0, 1, 0); PG8_LDB(B1, 1, 1); PG8_SCHED; PG8_LDA(At, 1, 0); PG8_STAGE(PG8_SA(0, 1), a2 + hstepA, voffA);
            PG8_WAIT_V(8); PG8_WAIT_L(0); PG8_BAR; PG8_MMA(0, 0, At, B0); PG8_MMA(0, 1, At, B1); PG8_BAR; PG8_SCHED;
            PG8_LDA(At, 1, 1); PG8_STAGE(PG8_SB(1, 0), b3, voffB); PG8_STAGE(PG8_SB(1, 1), b3 + hstep, voffB); PG8_STAGE(PG8_SA(1, 0), a3, voffA);
            PG8_WAIT_V(8); PG8_WAIT_L(0); PG8_BAR; PG8_MMA(1, 0, At, B0); PG8_MMA(1, 1, At, B1); PG8_BAR; PG8_SCHED;
            } else {
            PG8_LDB(B0, 0, 0); PG8_SCHED; PG8_LDA(At, 0, 0); PG8_STAGE(PG8_SA(1, 1), a1 + hstepA, voffA);
            PG8_WAIT_L(8); PG8_BAR; PG8_WAIT_L(0); PG8_MMA(0, 0, At, B0); PG8_BAR; PG8_SCHED;
            PG8_LDB(B1, 0, 1); PG8_STAGE(PG8_SB(0, 0), b2, voffB);
            PG8_BAR; PG8_WAIT_L(0); PG8_MMA(0, 1, At, B1); PG8_BAR;
            PG8_LDA(At, 0, 1); PG8_STAGE(PG8_SA(0, 0), a2, voffA);
            PG8_BAR; PG8_WAIT_L(0); PG8_MMA(1, 0, At, B0); PG8_BAR; PG8_SCHED;
            PG8_STAGE(PG8_SB(0, 1), b2 + hstep, voffB);
            PG8_WAIT_V(6); PG8_BAR; PG8_MMA(1, 1, At, B1); PG8_BAR;
            PG8_LDB(B0, 1, 0); PG8_SCHED; PG8_LDA(At, 1, 0); PG8_STAGE(PG8_SA(0, 1), a2 + hstepA, voffA);
            PG8_WAIT_L(8); PG8_BAR; PG8_WAIT_L(0); PG8_MMA(0, 0, At, B0); PG8_BAR; PG8_SCHED;
            PG8_LDB(B1, 1, 1); PG8_STAGE(PG8_SB(1, 0), b3, voffB);
            PG8_BAR; PG8_WAIT_L(0); PG8_MMA(0, 1, At, B1); PG8_BAR;
            PG8_LDA(At, 1, 1); PG8_STAGE(PG8_SA(1, 0), a3, voffA);
            PG8_BAR; PG8_WAIT_L(0); PG8_MMA(1, 0, At, B0); PG8_BAR; PG8_SCHED;
            PG8_STAGE(PG8_SB(1, 1), b3 + hstep, voffB);
            PG8_WAIT_V(6); PG8_BAR; PG8_MMA(1, 1, At, B1); PG8_BAR;
            }
        }
        if constexpr (ALIGN_EPI) { if (wr == 0) PG8_BAR; }
        if constexpr (!Epi::AFTER_DRAIN) { E(acc, cur, wr, wc, fr, fq); S.done(cur); }
        if (!has_next) break;
#pragma unroll
        for (int a = 0; a < 2; ++a)
#pragma unroll
            for (int b = 0; b < 2; ++b)
#pragma unroll
                for (int m = 0; m < 4; ++m)
#pragma unroll
                    for (int n = 0; n < 2; ++n) acc[a][b][m][n] = (f32x4){0.f, 0.f, 0.f, 0.f};
        cur = nxt; cA = nA; cB = nB; ++ui;
        if constexpr (ALIGN_EPI) { if (wr == 1) PG8_BAR; }
    }
    PG8_WAIT_V(0);
    if constexpr (!ALIGN_EPI) { if (wr == 0) PG8_BAR; }
    PG8_BAR;
    if constexpr (Epi::AFTER_DRAIN) { E.fused(acc, cur, wr, wc, fr, fq, lds, wid, lane); S.done(cur); }
#undef PG8_SA
#undef PG8_SB
#undef PG8_STAGE
#undef PG8_LDA
#undef PG8_LDB
#undef PG8_MMA
#undef PG8_WAIT_V
#undef PG8_WAIT_L
#undef PG8_BAR
#undef PG8_SCHED
}
}

constexpr int S = 16384, D = 2048, DEPTH = 4, DFF = 5504, NMODV = 9 * 2048;
constexpr int ABN = 5120, CIN = 4176, CINP = 4352;
constexpr float EPS = 1e-6f, LOG2E = 1.4426950408889634f;
constexpr int NWAVES = 8;
constexpr size_t MiB = 1u << 20;
constexpr size_t WS_CTL = 0, CTL_ZERO_BYTES = 1 * MiB;
constexpr size_t WS_PART = 1 * MiB, WS_VEC = 3 * MiB;
constexpr size_t WS_W1T = 4 * MiB, WS_W2T = 348 * MiB, WS_ABIN = 520 * MiB, WS_ABOUT = 560 * MiB, WS_DSAIN = 576 * MiB, WS_DSAOUT = 610 * MiB;
constexpr size_t WS_XRES = 626 * MiB, WS_XN = 754 * MiB, WS_H = 818 * MiB, WS_PROJ = 990 * MiB, WS_CAT = 1150 * MiB, WS_SEL = 1214 * MiB, WS_END = 1222 * MiB;
constexpr size_t W1T_SZ = (size_t)2 * DFF * D, W2T_SZ = (size_t)D * DFF, ABIN_SZ = (size_t)ABN * D, SQ_SZ = (size_t)D * D, DSAIN_SZ = (size_t)CINP * D;
static_assert(WS_W1T + 8 * W1T_SZ * 2 <= WS_W2T && WS_W2T + 8 * W2T_SZ * 2 <= WS_ABIN && WS_ABIN + 2 * ABIN_SZ * 2 <= WS_ABOUT && WS_ABOUT + 2 * SQ_SZ * 2 <= WS_DSAIN &&
              WS_DSAIN + 2 * DSAIN_SZ * 2 <= WS_DSAOUT && WS_DSAOUT + 2 * SQ_SZ * 2 <= WS_XRES && WS_XRES + (size_t)S * D * 4 <= WS_XN && WS_XN + (size_t)S * D * 2 <= WS_H &&
              WS_H + (size_t)S * DFF * 2 <= WS_PROJ && WS_PROJ + (size_t)S * ABN * 2 <= WS_CAT && WS_CAT + (size_t)S * D * 2 <= WS_SEL && WS_SEL + (size_t)S * 256 * 2 <= WS_END, "d_ws map");
constexpr int CW_BAR = 4096;
constexpr int RING_BYTES = 147456;
constexpr int MISC_OFF = RING_BYTES;
constexpr int INP_OFF = RING_BYTES + 256;
constexpr int LDS_BYTES = RING_BYTES + 512;

#define GAS __attribute__((address_space(1)))
#define LAS __attribute__((address_space(3)))
typedef unsigned short bf16;
typedef unsigned v4u __attribute__((ext_vector_type(4)));
typedef unsigned v2u __attribute__((ext_vector_type(2)));
typedef float f32x4 __attribute__((ext_vector_type(4)));
typedef float f32x16 __attribute__((ext_vector_type(16)));
typedef short bf16x8 __attribute__((ext_vector_type(8)));
typedef short s16x4 __attribute__((ext_vector_type(4)));
typedef GAS unsigned gu32;
#define LDS_WAIT() asm volatile("s_waitcnt lgkmcnt(0)" ::: "memory")
#define VM_WAIT() asm volatile("s_waitcnt vmcnt(0)" ::: "memory")
__device__ __forceinline__ unsigned f2bf(float f) { unsigned u = __builtin_bit_cast(unsigned, f); return (u + 0x7fffu + ((u >> 16) & 1u)) >> 16; }
__device__ __forceinline__ unsigned pk2(float lo, float hi) { return f2bf(lo) | (f2bf(hi) << 16); }
__device__ __forceinline__ float bf2f(unsigned short b) { return __builtin_bit_cast(float, (unsigned)b << 16); }
typedef float f32x2_t __attribute__((ext_vector_type(2))); typedef __bf16 bf16x2_t __attribute__((ext_vector_type(2)));
__device__ __forceinline__ unsigned cvtpk(float lo, float hi) { f32x2_t v = {lo, hi}; bf16x2_t b = __builtin_convertvector(v, bf16x2_t); return __builtin_bit_cast(unsigned, b); }
__device__ __forceinline__ int crow(int i, int hh) { return (i & 3) + 8 * (i >> 2) + 4 * hh; }
template <int K> __device__ __forceinline__ float swz_xor(float v) { return __builtin_bit_cast(float, __builtin_amdgcn_ds_swizzle(__builtin_bit_cast(int, v), (K << 10) | 0x1f)); }
__device__ __forceinline__ float sum32(float v) { const unsigned u = __builtin_bit_cast(unsigned, v); auto rr = __builtin_amdgcn_permlane32_swap(u, u, false, false); return __builtin_bit_cast(float, (unsigned)rr[0]) + __builtin_bit_cast(float, (unsigned)rr[1]); }
__device__ __forceinline__ float max32(float v) { const unsigned u = __builtin_bit_cast(unsigned, v); auto rr = __builtin_amdgcn_permlane32_swap(u, u, false, false); return fmaxf(__builtin_bit_cast(float, (unsigned)rr[0]), __builtin_bit_cast(float, (unsigned)rr[1])); }
__device__ __forceinline__ float wave_sum(float v) {
    v += swz_xor<1>(v); v += swz_xor<2>(v); v += swz_xor<4>(v); v += swz_xor<8>(v); v += swz_xor<16>(v);
    return sum32(v);
}
__device__ __forceinline__ void glds16(const void* gsrc, unsigned lds_dst) { unsigned keep;
    asm volatile("s_mov_b32 %0, m0\n\ts_mov_b32 m0, %2\n\ts_nop 0\n\tglobal_load_lds_dwordx4 %1, off\n\ts_mov_b32 m0, %0" : "=&s"(keep) : "v"(gsrc), "s"(lds_dst) : "memory"); }
__device__ __forceinline__ unsigned lds_addr(const LAS unsigned char* p) { return (unsigned)(size_t)p; }
#define MFMA32(a, b, c) __builtin_amdgcn_mfma_f32_32x32x16_bf16((a), (b), (c), 0, 0, 0)
typedef short v4i16_t __attribute__((ext_vector_type(4)));
__device__ __forceinline__ s16x4 vtr(const LAS unsigned char* p) { return __builtin_bit_cast(s16x4, __builtin_amdgcn_ds_read_tr16_b64_v4i16((LAS v4i16_t*)p)); }
__device__ const unsigned char REL_BUCKET[129] = {
    0, 1, 2, 3, 4, 5, 6, 7, 8, 9, 10, 11, 12, 13, 14, 15,
    16, 16, 16, 17, 17, 18, 18, 18, 19, 19, 19, 20, 20, 20, 20, 21,
    21, 21, 21, 22, 22, 22, 22, 22, 23, 23, 23, 23, 23, 23, 24, 24,
    24, 24, 24, 24, 25, 25, 25, 25, 25, 25, 25, 26, 26, 26, 26, 26,
    26, 26, 26, 27, 27, 27, 27, 27, 27, 27, 27, 27, 27, 28, 28, 28,
    28, 28, 28, 28, 28, 28, 28, 29, 29, 29, 29, 29, 29, 29, 29, 29,
    29, 29, 29, 30, 30, 30, 30, 30, 30, 30, 30, 30, 30, 30, 30, 30,
    30, 31, 31, 31, 31, 31, 31, 31, 31, 31, 31, 31, 31, 31, 31, 31,
    31
};

#define XB_TMO      128
#define XB_XCNT(j)  (256  + 64 * (j))
#define XB_XSUB(j)  (1280 + 64 * (j))
#define XB_XGEN(j)  (2304 + 64 * (j))
#define XB_TOP      3328
#define XB_TOPGEN   3392
#define XCD_BAR_WORDS 3456
#define XB_SPIN_CAP (1u << 22)

__device__ __forceinline__ unsigned xb_ld(unsigned* p)              { return __hip_atomic_load(p, __ATOMIC_RELAXED, __HIP_MEMORY_SCOPE_AGENT); }
__device__ __forceinline__ unsigned xb_add(unsigned* p, unsigned v) { return __hip_atomic_fetch_add(p, v, __ATOMIC_RELAXED, __HIP_MEMORY_SCOPE_AGENT); }
__device__ __forceinline__ unsigned xb_xcc_id() { return (unsigned)__builtin_amdgcn_s_getreg((3 << 11) | 20) & 0xFu; }
#define XB_SPIN(cond, bar) do { unsigned _sp = 0; while (cond) { __builtin_amdgcn_s_sleep(1); \
    if ((++_sp & 255u) == 0u) { if (xb_ld(&(bar)[XB_TMO])) break; if (_sp > XB_SPIN_CAP) { atomicAdd(&(bar)[XB_TMO], 1u); break; } } } } while (0)

struct XcdBarrier {
    unsigned* bar; unsigned x;
    volatile LAS unsigned* st;
};

__device__ __forceinline__ bool xb_thread0(int wave) { unsigned z = 0u; asm volatile("" : "+v"(z)); return wave == 0 && __builtin_amdgcn_mbcnt_hi(~0u, __builtin_amdgcn_mbcnt_lo(~0u, z)) == 0u; }
__device__ __forceinline__ XcdBarrier xcd_barrier_post(unsigned* bar, volatile LAS unsigned* st, int wave) {
    XcdBarrier b; b.bar = bar; b.x = xb_xcc_id(); b.st = st;
    if (xb_thread0(wave)) (void)xb_add(&bar[XB_XCNT(b.x)], 1u);
    return b;
}
__device__ __forceinline__ void xcd_barrier_complete(unsigned* bar, unsigned x, unsigned& nloc, unsigned& nx) {
    const unsigned G = gridDim.x * gridDim.y * gridDim.z;
    unsigned sum, cnt, mine, sp = 0u;
    for (;;) {
        sum = 0u; cnt = 0u; mine = 0u;
#pragma unroll
        for (unsigned j = 0; j < 16; ++j) { const unsigned c = xb_ld(&bar[XB_XCNT(j)]); sum += c; cnt += (c > 0u) ? 1u : 0u; mine = (j == x) ? c : mine; }
        if (sum == G) break;
        __builtin_amdgcn_s_sleep(1);
        if ((++sp & 255u) == 0u) { if (xb_ld(&bar[XB_TMO])) break; if (sp > XB_SPIN_CAP) { atomicAdd(&bar[XB_TMO], 1u); break; } }
    }
    nloc = mine > 0u ? mine : 1u; nx = cnt > 0u ? cnt : 1u;
}

__device__ __forceinline__ void xcd_barrier(const XcdBarrier& b, int wave) {
    asm volatile("s_waitcnt vmcnt(0)" ::: "memory");
    __syncthreads();
    if (xb_thread0(wave)) {
        unsigned* bar = b.bar;
        __builtin_amdgcn_s_waitcnt(0);
        unsigned nloc = b.st[0], nx = b.st[1];
        if (nloc == 0u) { xcd_barrier_complete(bar, b.x, nloc, nx); b.st[0] = nloc; b.st[1] = nx; }
        const unsigned old = xb_add(&bar[XB_XSUB(b.x)], 1u);
        const unsigned gen = old / nloc;
        if (old + 1u == (gen + 1u) * nloc) {
            __builtin_amdgcn_fence(__ATOMIC_RELEASE, "agent");
            asm volatile("s_waitcnt vmcnt(0)" ::: "memory");
            const unsigned og = xb_add(&bar[XB_TOP], 1u);
            const unsigned tg = og / nx;
            if (og + 1u == (tg + 1u) * nx) xb_add(&bar[XB_TOPGEN], 1u);
            else XB_SPIN(xb_ld(&bar[XB_TOPGEN]) == tg, bar);
            __builtin_amdgcn_fence(__ATOMIC_ACQUIRE, "agent");
            xb_add(&bar[XB_XGEN(b.x)], 1u);
            asm volatile("s_waitcnt vmcnt(0)" ::: "memory");
        } else {
            XB_SPIN(xb_ld(&bar[XB_XGEN(b.x)]) == gen, bar);
            __builtin_amdgcn_fence(__ATOMIC_ACQUIRE, "agent");
            asm volatile("s_waitcnt vmcnt(0)" ::: "memory");
        }
    }
    __syncthreads();
}

struct Frame {
    LAS unsigned char* lds;
    int tid, lane, wave, vcu, G;
};

__device__ __forceinline__ void tr_item(const float* W, int K, int N, int ncols, bf16* WT, int out_row0, LAS float* scr, int k0, int n0, int lane) {
    const int col = n0 + (lane & 31); const bool ok = col < ncols;
    float tv[32];
    const float* wp = W + (size_t)(k0 + (lane >> 5)) * N + (ok ? col : 0);
#pragma unroll
    for (int i = 0; i < 32; ++i) tv[i] = wp[(size_t)(2 * i) * N];
#pragma unroll
    for (int i = 0; i < 32; ++i) scr[(2 * i + (lane >> 5)) * 33 + (lane & 31)] = ok ? tv[i] : 0.f;
    LDS_WAIT(); asm volatile("" ::: "memory");
    const int c = lane & 7;
#pragma unroll
    for (int j = 0; j < 4; ++j) { const int n = (lane >> 3) + 8 * j; const LAS float* s = scr + (8 * c) * 33 + n;
        v4u o; o.x = pk2(s[0 * 33], s[1 * 33]); o.y = pk2(s[2 * 33], s[3 * 33]); o.z = pk2(s[4 * 33], s[5 * 33]); o.w = pk2(s[6 * 33], s[7 * 33]);
        *(GAS v4u*)(WT + (size_t)(out_row0 + n) * K + k0 + 8 * c) = o; }
    LDS_WAIT(); asm volatile("" ::: "memory");
}
constexpr int I_W1 = 32 * 344, I_W2 = 86 * 64, I_ABI = 32 * 160, I_SQ = 32 * 64, I_DSI = 32 * 136;
constexpr int N_TR_ITEMS = 8 * I_W1 + 8 * I_W2 + 2 * I_ABI + 2 * I_SQ + 2 * I_DSI + 2 * I_SQ;
constexpr int N_GEMV_UNITS = 4 * 72 * 4;
struct Args; __device__ __forceinline__ const float* in_ptr(const Args& a, int i);
__device__ __forceinline__ void prologue_phase(Frame& F, const Args& A, unsigned char* ws) {
    const float* c = in_ptr(A, 1); const float* mod_w = in_ptr(A, 3); float* PART = (float*)(ws + WS_PART);
    for (int unit = F.vcu; unit < N_GEMV_UNITS; unit += F.G) {
        const int l = unit / 288, rem = unit % 288, cb = rem >> 2, kq = rem & 3;
        LAS float* sc = (LAS float*)F.lds + F.wave * 64;
        const int k0 = kq * 512 + F.wave * 64;
        { const float cv = c[k0 + F.lane]; sc[F.lane] = cv * pg8::fast_sigmoid(cv); }
        LDS_WAIT(); asm volatile("" ::: "memory");
        const float* W = mod_w + ((size_t)l * 2048 + k0) * NMODV + cb * 256 + 4 * F.lane;
        f32x4 acc = {0.f, 0.f, 0.f, 0.f};
#pragma unroll 16
        for (int kk = 0; kk < 64; ++kk) acc += sc[kk] * *(const f32x4*)(W + (size_t)kk * NMODV);
        *((LAS f32x4*)(F.lds + 4096) + F.wave * 64 + F.lane) = acc;
        __syncthreads();
        if (F.tid < 256) { float s = 0.f;
#pragma unroll
            for (int w = 0; w < 8; ++w) s += ((LAS float*)(F.lds + 4096))[w * 256 + F.tid];
            PART[(size_t)(kq * 4 + l) * NMODV + cb * 256 + F.tid] = s; }
        __syncthreads();
    }
    LAS float* scr = (LAS float*)(F.lds + 16384 + F.wave * 8704);
    const int gw = F.vcu * NWAVES + F.wave, NGW = F.G * NWAVES;
    for (int it = gw; it < N_TR_ITEMS; it += NGW) {
        int r = it;
        if (r < 8 * I_W1) { const int mi = r / I_W1, q = r % I_W1, kb = q / 344, nb = q % 344, n0 = nb * 32;
            const int orow = (n0 < DFF) ? (n0 / 128) * 256 + (n0 % 128) : ((n0 - DFF) / 128) * 256 + 128 + ((n0 - DFF) % 128);
            tr_item(in_ptr(A, 5) + (size_t)mi * D * 2 * DFF, D, 2 * DFF, 2 * DFF, (bf16*)(ws + WS_W1T) + (size_t)mi * W1T_SZ, orow, scr, kb * 64, n0, F.lane); continue; } r -= 8 * I_W1;
        if (r < 8 * I_W2) { const int mi = r / I_W2, q = r % I_W2, kb = q / 64, nb = q % 64;
            tr_item(in_ptr(A, 6) + (size_t)mi * DFF * D, DFF, D, D, (bf16*)(ws + WS_W2T) + (size_t)mi * W2T_SZ, nb * 32, scr, kb * 64, nb * 32, F.lane); continue; } r -= 8 * I_W2;
        if (r < 2 * I_ABI) { const int mi = r / I_ABI, q = r % I_ABI, kb = q / 160, nb = q % 160;
            tr_item(in_ptr(A, 8) + (size_t)mi * D * ABN, D, ABN, ABN, (bf16*)(ws + WS_ABIN) + (size_t)mi * ABIN_SZ, nb * 32, scr, kb * 64, nb * 32, F.lane); continue; } r -= 2 * I_ABI;
        if (r < 2 * I_SQ) { const int mi = r / I_SQ, q = r % I_SQ, kb = q / 64, nb = q % 64;
            tr_item(in_ptr(A, 9) + (size_t)mi * SQ_SZ, D, D, D, (bf16*)(ws + WS_ABOUT) + (size_t)mi * SQ_SZ, nb * 32, scr, kb * 64, nb * 32, F.lane); continue; } r -= 2 * I_SQ;
        if (r < 2 * I_DSI) { const int mi = r / I_DSI, q = r % I_DSI, kb = q / 136, nb = q % 136;
            tr_item(in_ptr(A, 16) + (size_t)mi * D * CIN, D, CIN, CIN, (bf16*)(ws + WS_DSAIN) + (size_t)mi * DSAIN_SZ, nb * 32, scr, kb * 64, nb * 32, F.lane); continue; } r -= 2 * I_DSI;
        { const int mi = r / I_SQ, q = r % I_SQ, kb = q / 64, nb = q % 64;
            tr_item(in_ptr(A, 17) + (size_t)mi * SQ_SZ, D, D, D, (bf16*)(ws + WS_DSAOUT) + (size_t)mi * SQ_SZ, nb * 32, scr, kb * 64, nb * 32, F.lane); }
    }
}
__device__ __forceinline__ void vec_phase(Frame& F, const Args& A, unsigned char* ws) {
    const float* PART = (const float*)(ws + WS_PART); const float* mod_b = in_ptr(A, 4); const float* norm_g = in_ptr(A, 2);
    float* NA = (float*)(ws + WS_VEC); float* NB = NA + 12 * 2048; float* GT = NB + 12 * 2048;
    for (int idx = F.vcu * 512 + F.tid; idx < 12 * 2048; idx += F.G * 512) {
        const int lj = idx >> 11, col = idx & 2047, l = lj / 3, j = lj % 3;
        float mv[3];
#pragma unroll
        for (int t = 0; t < 3; ++t) { const int n = (3 * j + t) * 2048 + col; float s = mod_b[l * NMODV + n];
#pragma unroll
            for (int kq = 0; kq < 4; ++kq) s += PART[(size_t)(kq * 4 + l) * NMODV + n];
            mv[t] = s; }
        NA[idx] = norm_g[idx] * (1.0f + mv[1]); NB[idx] = mv[0]; GT[idx] = (j == 1 ? 1.0f : 0.5f) * (1.0f + mv[2]);
    }
}
__device__ __forceinline__ void norm_phase(Frame& F, const float* src, const float* na, const float* nb, bf16* dst) {
    const int gw = F.vcu * NWAVES + F.wave, NGW = F.G * NWAVES;
    for (int m = gw; m < S; m += NGW) {
        const GAS f32x4* xr = (const GAS f32x4*)(src + (size_t)m * D) + F.lane;
        f32x4 v[8]; float ss = 0.f;
#pragma unroll
        for (int j = 0; j < 8; ++j) { v[j] = xr[64 * j]; ss += (v[j].x * v[j].x + v[j].y * v[j].y) + (v[j].z * v[j].z + v[j].w * v[j].w); }
        const float rstd = 1.0f / sqrtf(wave_sum(ss) * (1.0f / D) + EPS);
        GAS v2u* o8 = (GAS v2u*)(dst + (size_t)m * D) + F.lane;
#pragma unroll
        for (int j = 0; j < 8; ++j) { const f32x4 a = ((const f32x4*)na)[64 * j + F.lane], b = ((const f32x4*)nb)[64 * j + F.lane]; const f32x4 o = v[j] * rstd * a + b;
            v2u w; w.x = cvtpk(o.x, o.y); w.y = cvtpk(o.z, o.w); o8[64 * j] = w; }
    }
}
__device__ __forceinline__ void final_norm_phase(Frame& F, const float* src, const float* g, float* out) {
    const int gw = F.vcu * NWAVES + F.wave, NGW = F.G * NWAVES;
    for (int m = gw; m < S; m += NGW) {
        const GAS f32x4* xr = (const GAS f32x4*)(src + (size_t)m * D) + F.lane;
        f32x4 v[8]; float ss = 0.f;
#pragma unroll
        for (int j = 0; j < 8; ++j) { v[j] = xr[64 * j]; ss += (v[j].x * v[j].x + v[j].y * v[j].y) + (v[j].z * v[j].z + v[j].w * v[j].w); }
        const float rstd = 1.0f / sqrtf(wave_sum(ss) * (1.0f / D) + EPS);
        GAS f32x4* o = (GAS f32x4*)(out + (size_t)m * D) + F.lane;
#pragma unroll
        for (int j = 0; j < 8; ++j) o[64 * j] = v[j] * rstd * ((const f32x4*)g)[64 * j + F.lane];
    }
}

namespace da {
constexpr int PITCH = ABN, KOFF = 1024, VOFF = 2048;
constexpr float C2 = 0.125f * LOG2E;
constexpr int NBUF = 4, LDS_LUT = NBUF * 32768;
#define DA_WAIT_BAR(N) asm volatile("s_waitcnt vmcnt(" #N ") lgkmcnt(0)\n\ts_barrier" ::: "memory")
constexpr float THR = 8.0f;
__device__ __forceinline__ void dma_tile(LAS unsigned char* lds, const bf16* P, int h, int k0, int buf, int wid, int lane) {
#pragma unroll
    for (int i = 0; i < 2; ++i) {
        const int piece = wid * 2 + i, row = piece * 4 + (lane >> 4), pc = lane & 15;
        const int ck = pc ^ (row & 15), cv = pc ^ (2 * (row & 7));
        const bf16* rp = P + (size_t)(k0 + row) * PITCH + h * 128;
        glds16(rp + KOFF + ck * 8, (unsigned)__builtin_amdgcn_readfirstlane(lds_addr(lds) + buf * 32768 + piece * 1024));
        glds16(rp + VOFF + cv * 8, (unsigned)__builtin_amdgcn_readfirstlane(lds_addr(lds) + buf * 32768 + 16384 + piece * 1024));
    }
}
__device__ __forceinline__ float max3_asm(float a, float b, float c) { float r; asm("v_max3_f32 %0, %1, %2, %3" : "=v"(r) : "v"(a), "v"(b), "v"(c)); return r; }
__device__ __forceinline__ void unit(int tid, LAS unsigned char* lds, const bf16* P, bf16* CAT, int h, int qb, float lam, float oscale, const float* subg, const float* rel) {
    const int lane = tid & 63, wid = __builtin_amdgcn_readfirstlane(tid >> 6), r = lane & 31, hh = lane >> 5;
    const int rb = wid >> 1, m = wid & 1;
    const int q0w = qb * 128 + rb * 32, qpos = q0w + r;
    LAS float* lut = (LAS float*)(lds + LDS_LUT);
    __syncthreads();
    if (tid < 258) { const int mm = tid / 129, d = tid % 129; const int b = REL_BUCKET[d];
        lut[mm * 132 + d] = (rel[b * 16 + h * 2 + mm] - rel[31 * 16 + h * 2 + mm]) * LOG2E; }
    const int NT = 2 * qb + 2;
    bf16x8 qf[4];
#pragma unroll
    for (int ks = 0; ks < 4; ++ks) qf[ks] = *(const bf16x8*)(P + (size_t)qpos * PITCH + h * 128 + m * 64 + ks * 16 + hh * 8);
    asm volatile("s_waitcnt vmcnt(0)" : "+v"(qf[0]), "+v"(qf[1]), "+v"(qf[2]), "+v"(qf[3]) :: "memory");
    dma_tile(lds, P, h, 0, 0, wid, lane); dma_tile(lds, P, h, 64, 1, wid, lane);
    if (NT > 2) dma_tile(lds, P, h, 128, 2, wid, lane);
    f32x16 O[4];
#pragma unroll
    for (int e = 0; e < 4; ++e)
#pragma unroll
        for (int i = 0; i < 16; ++i) O[e][i] = 0.f;
    float mref = 0.f, ls4[4] = {0.f, 0.f, 0.f, 0.f};
    f32x16 negm;
#pragma unroll
    for (int i = 0; i < 16; ++i) negm[i] = 0.f;
    const int klane = r * 256, kbits0 = (8 * m + hh) ^ (r & 15);
    const int l16 = lane & 15, qq = l16 >> 2, p4 = l16 & 3, G4 = lane >> 4;
    const int x0 = 4 * hh + qq, lanev20 = (2 * (G4 & 1) + (p4 >> 1)) ^ (2 * x0), vlane = x0 * 256 + (p4 & 1) * 8;
    if (NT > 2) DA_WAIT_BAR(8); else DA_WAIT_BAR(4);
    for (int t = 0; t < NT; ++t) {
        const int buf = t & 3, k0 = t * 64;
        if (t + 3 < NT) dma_tile(lds, P, h, k0 + 192, (t + 3) & 3, wid, lane);
        int kbits = kbits0, lanev2 = lanev20; asm volatile("" : "+v"(kbits), "+v"(lanev2));
        if (k0 <= q0w + 31) {
            const LAS unsigned char* Kb = lds + buf * 32768; const LAS unsigned char* Vb = Kb + 16384;
            const bool two = (k0 + 32 <= q0w + 31);
            bf16x8 kf[2][4];
#pragma unroll
            for (int kb = 0; kb < 2; ++kb)
#pragma unroll
                for (int ks = 0; ks < 4; ++ks) kf[kb][ks] = *(const LAS bf16x8*)(Kb + kb * 8192 + klane + (((2 * ks) ^ kbits) << 4));
            __builtin_amdgcn_sched_barrier(0);
            f32x16 s0 = negm, s1 = negm;
            __builtin_amdgcn_s_setprio(1);
#pragma unroll
            for (int ks = 0; ks < 4; ++ks) { s0 = MFMA32(kf[0][ks], qf[ks], s0); s1 = MFMA32(kf[1][ks], qf[ks], s1); }
            __builtin_amdgcn_s_setprio(0);
            asm volatile("s_nop 15\n\ts_nop 7" : "+v"(s0), "+v"(s1));
            if (k0 + 191 > q0w) {
#pragma unroll
                for (int i = 0; i < 16; ++i) { const int d0 = qpos - (k0 + crow(i, hh)), d1 = d0 - 32;
                    s0[i] = d0 < 0 ? -INFINITY : s0[i] + lut[m * 132 + (d0 > 128 ? 128 : d0)];
                    s1[i] = d1 < 0 ? -INFINITY : s1[i] + lut[m * 132 + (d1 > 128 ? 128 : d1)]; }
            }
            float mx = max3_asm(s0[0], s0[1], s0[2]), my = max3_asm(s1[0], s1[1], s1[2]);
#pragma unroll
            for (int i = 3; i < 15; i += 2) { mx = max3_asm(mx, s0[i], s0[i + 1]); my = max3_asm(my, s1[i], s1[i + 1]); }
            mx = max3_asm(mx, s0[15], my); mx = fmaxf(mx, s1[15]);
            mx = max32(mx);
            if (__any(mx > THR)) {
                const float dl = fmaxf(mx, 0.f), alpha = __builtin_amdgcn_exp2f(-dl);
                mref += dl;
#pragma unroll
                for (int i = 0; i < 16; ++i) { s0[i] -= dl; s1[i] -= dl; negm[i] = -mref; }
#pragma unroll
                for (int j = 0; j < 4; ++j) ls4[j] *= alpha;
#pragma unroll
                for (int e = 0; e < 4; ++e)
#pragma unroll
                    for (int i = 0; i < 16; ++i) O[e][i] *= alpha;
            }
#pragma unroll
            for (int i = 0; i < 16; ++i) { s0[i] = __builtin_amdgcn_exp2f(s0[i]); s1[i] = __builtin_amdgcn_exp2f(s1[i]); }
#pragma unroll
            for (int i = 0; i < 16; ++i) { ls4[i & 3] += s0[i]; }
#pragma unroll
            for (int i = 0; i < 16; ++i) { ls4[i & 3] += s1[i]; }
            bf16x8 pk[4];
#pragma unroll
            for (int s2 = 0; s2 < 2; ++s2) { v4u w0, w1;
                w0.x = cvtpk(s0[8 * s2], s0[8 * s2 + 1]); w0.y = cvtpk(s0[8 * s2 + 2], s0[8 * s2 + 3]); w0.z = cvtpk(s0[8 * s2 + 4], s0[8 * s2 + 5]); w0.w = cvtpk(s0[8 * s2 + 6], s0[8 * s2 + 7]);
                w1.x = cvtpk(s1[8 * s2], s1[8 * s2 + 1]); w1.y = cvtpk(s1[8 * s2 + 2], s1[8 * s2 + 3]); w1.z = cvtpk(s1[8 * s2 + 4], s1[8 * s2 + 5]); w1.w = cvtpk(s1[8 * s2 + 6], s1[8 * s2 + 7]);
                pk[s2] = __builtin_bit_cast(bf16x8, w0); pk[2 + s2] = __builtin_bit_cast(bf16x8, w1); }
#pragma unroll
            for (int kk = 0; kk < 4; ++kk) {
                if (kk < 2 || two) {
#pragma unroll
                    for (int e = 0; e < 4; ++e) {
                        const LAS unsigned char* a0 = Vb + (16 * kk) * 256 + vlane + (((4 * e) ^ lanev2) << 4);
                        const s16x4 lo = vtr(a0), hi = vtr(a0 + 2048);
                        const bf16x8 vf = (bf16x8){lo[0], lo[1], lo[2], lo[3], hi[0], hi[1], hi[2], hi[3]};
                        O[e] = MFMA32(vf, pk[kk], O[e]);
                    }
                }
            }
        }
        if (t + 3 < NT) DA_WAIT_BAR(8); else if (t + 2 < NT) DA_WAIT_BAR(4); else DA_WAIT_BAR(0);
    }
    float lsum = sum32((ls4[0] + ls4[1]) + (ls4[2] + ls4[3]));
    LAS float* xch = (LAS float*)lds + rb * 4096 + lane;
    if (m == 1) { const float i1 = lam / lsum;
#pragma unroll
        for (int e = 0; e < 4; ++e)
#pragma unroll
            for (int i = 0; i < 16; ++i) xch[(e * 16 + i) * 64] = O[e][i] * i1; }
    __syncthreads();
    if (m == 0) {
        const float i0 = 1.0f / lsum; float ss = 0.f;
#pragma unroll
        for (int e = 0; e < 4; ++e)
#pragma unroll
            for (int i = 0; i < 16; ++i) { const float o = O[e][i] * i0 - xch[(e * 16 + i) * 64]; O[e][i] = o; ss += o * o; }
        ss = sum32(ss);
        const float rs = oscale / sqrtf(ss * (1.0f / 128.0f) + EPS);
        GAS bf16* orow = (GAS bf16*)CAT + (size_t)qpos * D + h * 128;
#pragma unroll
        for (int e = 0; e < 4; ++e)
#pragma unroll
            for (int g4 = 0; g4 < 4; ++g4) { const int ecol = 32 * e + 8 * g4 + 4 * hh; const f32x4 gv = *(const f32x4*)(subg + ecol);
                v2u w; w.x = cvtpk(O[e][4 * g4] * rs * gv.x, O[e][4 * g4 + 1] * rs * gv.y); w.y = cvtpk(O[e][4 * g4 + 2] * rs * gv.z, O[e][4 * g4 + 3] * rs * gv.w);
                *(GAS v2u*)(orow + ecol) = w; }
    }
}
}

namespace sgp {
constexpr int PITCH = ABN, UOFF = 3072, ZOFF = 4096;
constexpr int L_ST = 0, L_W = 1024, L_Z = 1024 + 128 * 272, RS = 272;
__device__ __forceinline__ void unit(int tid, LAS unsigned char* lds, const bf16* P, bf16* CAT, int n, int g, const float* lng, const float* lnb, const float* sgw, const float* sgb) {
    const int lane = tid & 63, wid = __builtin_amdgcn_readfirstlane(tid >> 6), r = lane & 31, hh = lane >> 5;
    const int R0 = n * 128;
    LAS float* st = (LAS float*)(lds + L_ST);
    __syncthreads();
    for (int rr = 0; rr < 16; ++rr) { const int rl = wid * 16 + rr; const bf16* zp = P + (size_t)(R0 + rl) * PITCH + ZOFF + lane * 16;
        const bf16x8 a = *(const bf16x8*)zp, b = *(const bf16x8*)(zp + 8);
        float x[16]; float s = 0.f;
#pragma unroll
        for (int i = 0; i < 8; ++i) { x[i] = bf2f((unsigned short)a[i]); x[8 + i] = bf2f((unsigned short)b[i]); }
#pragma unroll
        for (int i = 0; i < 16; ++i) s += x[i];
        const float mean = wave_sum(s) * (1.0f / 1024.0f); float q = 0.f;
#pragma unroll
        for (int i = 0; i < 16; ++i) { const float d = x[i] - mean; q += d * d; }
        const float rstd = 1.0f / sqrtf(wave_sum(q) * (1.0f / 1024.0f) + EPS);
        if (lane == 0) { st[2 * rl] = mean; st[2 * rl + 1] = rstd; } }
    __syncthreads();
    LAS bf16* ZT = (LAS bf16*)(lds + L_Z); LAS bf16* WT = (LAS bf16*)(lds + L_W);
#pragma unroll
    for (int i = 0; i < 4; ++i) { const int item = tid + 512 * i, sr = item >> 4, ch = item & 15;
        const bf16x8 z = *(const bf16x8*)(P + (size_t)(R0 + sr) * PITCH + ZOFF + g * 128 + ch * 8);
        const float mean = st[2 * sr], rstd = st[2 * sr + 1];
#pragma unroll
        for (int e = 0; e < 8; ++e) { const int c = ch * 8 + e; const float zn = (bf2f((unsigned short)z[e]) - mean) * rstd * lng[g * 128 + c] + lnb[g * 128 + c];
            ZT[c * (RS / 2) + sr] = (bf16)f2bf(zn); } }
#pragma unroll
    for (int i = 0; i < 4; ++i) { const int item = tid + 512 * i, t = item >> 4, sch = item & 15;
        const float* wp = sgw + ((size_t)g * 128 + t) * 128 + sch * 8; const f32x4 a = *(const f32x4*)wp, b = *(const f32x4*)(wp + 4);
        float w[8] = {a.x, a.y, a.z, a.w, b.x, b.y, b.z, b.w};
#pragma unroll
        for (int e = 0; e < 8; ++e) if (sch * 8 + e > t) w[e] = 0.f;
        v4u o; o.x = pk2(w[0], w[1]); o.y = pk2(w[2], w[3]); o.z = pk2(w[4], w[5]); o.w = pk2(w[6], w[7]);
        *(LAS v4u*)(lds + L_W + t * RS + sch * 16) = o; }
    __syncthreads();
    const int tb = wid >> 1, cbp = (wid & 1) * 2;
    f32x16 acc[2];
#pragma unroll
    for (int cc = 0; cc < 2; ++cc)
#pragma unroll
        for (int i = 0; i < 16; ++i) acc[cc][i] = 0.f;
#pragma unroll
    for (int ks = 0; ks < 8; ++ks) {
        if (16 * ks <= 32 * tb + 31) {
            const bf16x8 a = *(const LAS bf16x8*)(lds + L_W + (32 * tb + r) * RS + (16 * ks + 8 * hh) * 2);
#pragma unroll
            for (int cc = 0; cc < 2; ++cc) { const bf16x8 b = *(const LAS bf16x8*)(lds + L_Z + (32 * (cbp + cc) + r) * RS + (16 * ks + 8 * hh) * 2); acc[cc] = MFMA32(a, b, acc[cc]); }
        }
    }
#pragma unroll
    for (int cc = 0; cc < 2; ++cc) { const int c = g * 128 + 32 * (cbp + cc) + r;
#pragma unroll
        for (int i = 0; i < 16; ++i) { const int t = 32 * tb + crow(i, hh); const size_t row = (size_t)(R0 + t);
            const float u = bf2f(P[row * PITCH + UOFF + c]); CAT[row * D + 1024 + c] = (bf16)f2bf(u * (acc[cc][i] + sgb[g * 128 + t])); } }
}
}


namespace dsa {
constexpr int PITCH = CINP, KOFF = 2048, VOFF = 2560, QIOFF = 3072, KIOFF = 4096, WIOFF = 4160;
constexpr float CQ = 0.08838834764831845f * LOG2E;
#define MFMA16(a, b, c) __builtin_amdgcn_mfma_f32_16x16x32_bf16((a), (b), (c), 0, 0, 0)
__device__ __forceinline__ float relu_asm(float x) { float r; asm("v_max_f32_e32 %0, 0, %1" : "=v"(r) : "v"(x)); return r; }
constexpr int L_HIST = 0, L_SEL = 0, L_CS = 16384, L_CK = 32768, L_KT = 65536, L_META = 131072, L_TMP = 131584;
#define IDX_WAIT_BAR(N) asm volatile("s_waitcnt vmcnt(" #N ") lgkmcnt(0)\n\ts_barrier" ::: "memory")
constexpr int NCAND = 128;
__device__ __forceinline__ void dma_ktile(LAS unsigned char* lds, const bf16* P, int t, int buf, int wid, int lane) {
#pragma unroll
    for (int i = 0; i < 2; ++i) { const int piece = wid * 2 + i, row = piece * 8 + (lane >> 3), pc = lane & 7, c = pc ^ ((row >> 1) & 7);
        glds16(P + (size_t)(128 * t + row) * PITCH + KIOFF + c * 8, (unsigned)__builtin_amdgcn_readfirstlane(lds_addr(lds) + L_KT + buf * 16384 + piece * 1024)); }
}
template <int PASS, bool FULL> __device__ __forceinline__ void score_tile(LAS unsigned char* lds, const LAS unsigned char* KT, int kb_, int key0, int u, int wid, int r, int hh, int qmaxw,
                                                                          const bf16x8 (&aq)[2][4], const float (&w)[2][16], int T0, int T1) {
    LAS unsigned* hist = (LAS unsigned*)(lds + L_HIST); LAS unsigned short* sel = (LAS unsigned short*)(lds + L_SEL);
    LAS float* cs = (LAS float*)(lds + L_CS); LAS unsigned short* ck = (LAS unsigned short*)(lds + L_CK); LAS int* meta = (LAS int*)(lds + L_META);
    bf16x8 bk[2][4];
#pragma unroll
    for (int ks = 0; ks < 4; ++ks) bk[0][ks] = *(const LAS bf16x8*)(KT + (((2 * ks) ^ kb_) << 4));
#pragma unroll
    for (int sb = 0; sb < 4; ++sb) {
        if (sb < 3) {
#pragma unroll
            for (int ks = 0; ks < 4; ++ks) bk[(sb + 1) & 1][ks] = *(const LAS bf16x8*)(KT + (sb + 1) * 4096 + (((2 * ks) ^ kb_) << 4));
        }
        __builtin_amdgcn_sched_barrier(0);
        if (FULL || key0 + 32 * sb <= qmaxw) {
            f32x16 acc[2];
#pragma unroll
            for (int p = 0; p < 2; ++p)
#pragma unroll
                for (int i = 0; i < 16; ++i) acc[p][i] = 0.f;
            __builtin_amdgcn_s_setprio(1);
#pragma unroll
            for (int ks = 0; ks < 4; ++ks)
#pragma unroll
                for (int p = 0; p < 2; ++p) acc[p] = MFMA32(aq[p][ks], bk[sb & 1][ks], acc[p]);
            __builtin_amdgcn_s_setprio(0);
            asm volatile("s_nop 15\n\ts_nop 7" : "+v"(acc[0]), "+v"(acc[1]));
#pragma unroll
            for (int p = 0; p < 2; ++p) {
                float s4[4] = {0.f, 0.f, 0.f, 0.f};
#pragma unroll
                for (int i = 0; i < 16; ++i) s4[i & 3] += relu_asm(acc[p][i]) * w[p][i];
                const float sc = (s4[0] + s4[1]) + (s4[2] + s4[3]);
                const int rl = 4 * wid + 2 * p + hh, key = key0 + 32 * sb + r;
                int b = (int)((sc + 32.0f) * 8.0f); b = b < 0 ? 0 : (b > 511 ? 511 : b);
                if (FULL || key <= 32 * u + rl) {
                    if (PASS == 1) (void)__hip_atomic_fetch_add(&hist[rl * 512 + b], 1u, __ATOMIC_RELAXED, __HIP_MEMORY_SCOPE_WORKGROUP);
                    else { const int T = p ? T1 : T0;
                        if (b > T) { const int pos = __hip_atomic_fetch_add(&meta[rl], 1, __ATOMIC_RELAXED, __HIP_MEMORY_SCOPE_WORKGROUP); if (pos < 256) sel[rl * 256 + pos] = (unsigned short)key; }
                        else if (b == T) { const int pos = __hip_atomic_fetch_add(&meta[32 + rl], 1, __ATOMIC_RELAXED, __HIP_MEMORY_SCOPE_WORKGROUP); if (pos < NCAND) { cs[rl * NCAND + pos] = sc; ck[rl * NCAND + pos] = (unsigned short)key; } } }
                }
            }
        }
    }
}
template <int PASS> __device__ __forceinline__ void score_pass(LAS unsigned char* lds, const bf16* P, int u, int wid, int lane, const bf16x8 (&aq)[2][4], const float (&w)[2][16], int T0, int T1) {
    const int r = lane & 31, hh = lane >> 5;
    const int NT = (32 * u + 32 + 127) >> 7, qmaxw = 32 * u + 4 * wid + 3;
    const int kb0 = hh ^ ((r >> 1) & 7);
    VM_WAIT();
    dma_ktile(lds, P, 0, 0, wid, lane);
    if (NT > 1) dma_ktile(lds, P, 1, 1, wid, lane);
    IDX_WAIT_BAR(0);
    for (int t = 0; t < NT; t += 2) {
        if (t + 2 < NT) dma_ktile(lds, P, t + 2, (t + 2) & 3, wid, lane);
        if (t + 3 < NT) dma_ktile(lds, P, t + 3, (t + 3) & 3, wid, lane);
        int kb_ = kb0; asm volatile("" : "+v"(kb_));
#pragma unroll
        for (int h2 = 0; h2 < 2; ++h2) {
            const int tt = t + h2;
            if (tt < NT) {
                const LAS unsigned char* KT = lds + L_KT + (tt & 3) * 16384 + r * 128;
                if (128 * tt + 127 <= 32 * u) score_tile<PASS, true>(lds, KT, kb_, 128 * tt, u, wid, r, hh, qmaxw, aq, w, T0, T1);
                else score_tile<PASS, false>(lds, KT, kb_, 128 * tt, u, wid, r, hh, qmaxw, aq, w, T0, T1);
            }
        }
        IDX_WAIT_BAR(0);
    }
}
__device__ __forceinline__ void index_phase(Frame& F, const bf16* P, unsigned short* SEL) {
    LAS unsigned char* lds = F.lds; const int wid = F.wave;
    LAS unsigned* hist = (LAS unsigned*)(lds + L_HIST); LAS unsigned short* sel = (LAS unsigned short*)(lds + L_SEL);
    LAS float* cs = (LAS float*)(lds + L_CS); LAS unsigned short* ck = (LAS unsigned short*)(lds + L_CK); LAS int* meta = (LAS int*)(lds + L_META);
    for (int ui = F.vcu; ui < 512; ui += F.G) {
        int tid = F.tid; asm volatile("" : "+v"(tid));
        const int lane = tid & 63, r = lane & 31, hh = lane >> 5;
        const int u = (ui < 256) ? ui : 767 - ui;
        __syncthreads();
        if (u < 8) {
            for (int e = tid; e < 32 * 256; e += 512) { const int q = 32 * u + (e >> 8), jj = e & 255; SEL[(size_t)q * 256 + jj] = (unsigned short)(jj <= q ? jj : 0); }
            continue;
        }
        { v4u z = {0u, 0u, 0u, 0u};
#pragma unroll
            for (int i = 0; i < 8; ++i) *(LAS v4u*)(lds + L_HIST + (tid + 512 * i) * 16) = z;
            if (tid < 128) meta[tid] = 0; }
        bf16x8 aq[2][4]; float w[2][16];
#pragma unroll
        for (int p = 0; p < 2; ++p) { const int qrow = 32 * u + 4 * wid + 2 * p + ((r >> 2) & 1), head = (r & 3) + 4 * (r >> 3);
#pragma unroll
            for (int ks = 0; ks < 4; ++ks) aq[p][ks] = *(const bf16x8*)(P + (size_t)qrow * PITCH + QIOFF + head * 64 + ks * 16 + hh * 8);
            const bf16* wp = P + (size_t)(32 * u + 4 * wid + 2 * p + hh) * PITCH + WIOFF;
            const bf16x8 w0 = *(const bf16x8*)wp, w1 = *(const bf16x8*)(wp + 8);
#pragma unroll
            for (int i = 0; i < 8; ++i) { w[p][i] = bf2f((unsigned short)w0[i]) * 0.125f; w[p][8 + i] = bf2f((unsigned short)w1[i]) * 0.125f; } }
        __syncthreads();
        score_pass<1>(lds, P, u, wid, lane, aq, w, 0, 0);
        LAS int* tmp = (LAS int*)(lds + L_TMP) + wid * 64;
        for (int rr = 0; rr < 4; ++rr) { const int rl = 4 * wid + rr;
            unsigned cw[8]; { const v4u a = *(const LAS v4u*)(hist + rl * 512 + 8 * lane), b = *(const LAS v4u*)(hist + rl * 512 + 8 * lane + 4);
                cw[0] = a.x; cw[1] = a.y; cw[2] = a.z; cw[3] = a.w; cw[4] = b.x; cw[5] = b.y; cw[6] = b.z; cw[7] = b.w; }
            int ls = 0;
#pragma unroll
            for (int i = 0; i < 8; ++i) ls += (int)cw[i];
            int suf = ls;
#pragma unroll
            for (int off = 1; off < 64; off <<= 1) { tmp[lane] = suf; LDS_WAIT(); const int o2 = lane + off; const int v = tmp[o2 < 64 ? o2 : 63]; LDS_WAIT(); suf += (o2 < 64) ? v : 0; }
            const unsigned long long bal = __ballot(suf >= 256);
            const int L = 63 - __builtin_clzll(bal | 1ull);
            if (lane == L) { int cum = suf - ls, T = 8 * L, cab = cum; bool found = false;
#pragma unroll
                for (int bb = 7; bb >= 0; --bb) { const int cnt = (int)cw[bb];
                    if (!found) { if (cum + cnt >= 256) { T = 8 * L + bb; cab = cum; found = true; } else cum += cnt; } }
                meta[64 + rl] = T; meta[96 + rl] = cab; }
            LDS_WAIT(); asm volatile("" ::: "memory"); }
        __syncthreads();
        { v4u z = {0u, 0u, 0u, 0u};
#pragma unroll
            for (int i = 0; i < 2; ++i) *(LAS v4u*)(lds + L_SEL + (tid + 512 * i) * 16) = z; }
        const int T0 = meta[64 + 4 * wid + hh], T1 = meta[64 + 4 * wid + 2 + hh];
        score_pass<2>(lds, P, u, wid, lane, aq, w, T0, T1);
        for (int rr = 0; rr < 4; ++rr) { const int rl = 4 * wid + rr; const int cab = meta[96 + rl], need = 256 - cab; int m = meta[32 + rl]; m = m > NCAND ? NCAND : m;
#pragma unroll
            for (int half = 0; half < 2; ++half) { const int i = lane + 64 * half; const float si = cs[rl * NCAND + i]; const int ki = ck[rl * NCAND + i]; int rank = 0;
                for (int j2 = 0; j2 < m; ++j2) { const float sj = cs[rl * NCAND + j2]; const int kj = ck[rl * NCAND + j2]; rank += (sj > si || (sj == si && kj < ki)) ? 1 : 0; }
                if (i < m && rank < need) sel[rl * 256 + cab + rank] = (unsigned short)ki; }
            LDS_WAIT(); asm volatile("" ::: "memory");
            const v2u o = *(const LAS v2u*)(lds + L_SEL + rl * 512 + lane * 8);
            *(GAS v2u*)(SEL + (size_t)(32 * u + rl) * 256 + 4 * lane) = o; }
#if MK_DUP & 128
        __syncthreads(); score_pass<1>(lds, P, u, wid, lane, aq, w, 0, 0);
#endif
#if MK_DUP & 256
        __syncthreads(); score_pass<2>(lds, P, u, wid, lane, aq, w, T0 + 512, T1 + 512);
#endif
    }
}
constexpr int A_LUT = 0, A_SEL = 8448, A_V = 16384;
__device__ __forceinline__ void attn_phase(Frame& F, const bf16* P, const unsigned short* SEL, bf16* CAT, const float* rel) {
    LAS unsigned char* lds = F.lds; const int tid = F.tid, lane = F.lane, wid = F.wave;
    LAS float* lut = (LAS float*)(lds + A_LUT);
    __syncthreads();
    for (int e = tid; e < 129 * 16; e += 512) lut[e] = rel[REL_BUCKET[e >> 4] * 16 + (e & 15)] * LOG2E;
    __syncthreads();
    LAS unsigned short* sb = (LAS unsigned short*)(lds + A_SEL) + wid * 256; LAS unsigned char* vbuf = lds + A_V + wid * 16384;
    const int c16 = lane & 15, q4 = lane >> 4, qq = c16 >> 2, p4 = c16 & 3;
    const int rho = 4 * q4 + qq, vx0 = rho & 7, vbase = rho * 256 + (p4 & 1) * 8;
    const int gw = F.vcu * NWAVES + wid, NGW = F.G * NWAVES;
    for (int q = gw; q < S; q += NGW) {
        const int count = (q + 1 < 256) ? q + 1 : 256;
        *(LAS v2u*)(sb + 4 * lane) = *(const GAS v2u*)(SEL + (size_t)q * 256 + 4 * lane);
        LDS_WAIT(); asm volatile("" ::: "memory");
        for (int g = 0; g < 4; ++g) {
            const int head = 4 * g + (c16 & 3);
            bf16x8 qb[4];
#pragma unroll
            for (int ks = 0; ks < 4; ++ks) qb[ks] = *(const bf16x8*)(P + (size_t)q * PITCH + head * 128 + q4 * 32 + ks * 8);
            f32x4 s[16];
#pragma unroll
            for (int bt = 0; bt < 2; ++bt) {
                bf16x8 ak[8][4];
#pragma unroll
                for (int b2 = 0; b2 < 8; ++b2) { const int kpos = sb[16 * (8 * bt + b2) + c16]; const bf16* kp = P + (size_t)kpos * PITCH + KOFF + g * 128 + q4 * 32;
#pragma unroll
                    for (int ks = 0; ks < 4; ++ks) ak[b2][ks] = *(const bf16x8*)(kp + ks * 8); }
#pragma unroll
                for (int b2 = 0; b2 < 8; ++b2) { f32x4 a = {0.f, 0.f, 0.f, 0.f};
#pragma unroll
                    for (int ks = 0; ks < 4; ++ks) a = MFMA16(ak[b2][ks], qb[ks], a);
                    s[8 * bt + b2] = a; }
            }
            float mx = -INFINITY;
#pragma unroll
            for (int b = 0; b < 16; ++b) { const v2u kk2 = *(const LAS v2u*)(sb + 16 * b + 4 * q4);
#pragma unroll
                for (int i = 0; i < 4; ++i) { const int jj = 16 * b + 4 * q4 + i; const int kpos = (int)(((i & 2) ? kk2.y : kk2.x) >> ((i & 1) * 16)) & 0xffff;
                    int dist = q - kpos; dist = dist < 0 ? 0 : (dist > 128 ? 128 : dist);
                    (void)jj; s[b][i] += lut[dist * 16 + head]; } }
            if (count < 256) {
                int cnt = count - 4 * q4; asm volatile("" : "+v"(cnt));
#pragma unroll
                for (int b = 0; b < 16; ++b)
#pragma unroll
                    for (int i = 0; i < 4; ++i) if (16 * b + i >= cnt) s[b][i] = -INFINITY; }
#pragma unroll
            for (int b = 0; b < 16; ++b)
#pragma unroll
                for (int i = 0; i < 4; ++i) mx = fmaxf(mx, s[b][i]);
            mx = fmaxf(mx, swz_xor<16>(mx)); mx = max32(mx);
            float sum = 0.f;
#pragma unroll
            for (int b = 0; b < 16; ++b)
#pragma unroll
                for (int i = 0; i < 4; ++i) { const float pv = __builtin_amdgcn_exp2f(s[b][i] - mx); s[b][i] = pv; sum += pv; }
            sum += swz_xor<16>(sum); sum = sum32(sum);
            bf16x8 pb[8];
#pragma unroll
            for (int kk = 0; kk < 8; ++kk) { v4u wv; wv.x = cvtpk(s[2 * kk][0], s[2 * kk][1]); wv.y = cvtpk(s[2 * kk][2], s[2 * kk][3]); wv.z = cvtpk(s[2 * kk + 1][0], s[2 * kk + 1][1]); wv.w = cvtpk(s[2 * kk + 1][2], s[2 * kk + 1][3]);
                pb[kk] = __builtin_bit_cast(bf16x8, wv); }
            f32x4 O[8];
#pragma unroll
            for (int db = 0; db < 8; ++db) O[db] = (f32x4){0.f, 0.f, 0.f, 0.f};
#define SPA_DMA(kk_) do { _Pragma("unroll") for (int pi = 0; pi < 8; ++pi) { const int row = 4 * pi + (lane >> 4), pc = lane & 15, c = pc ^ (2 * (row & 7)); const int kpos = sb[32 * (kk_) + row]; \
                glds16(P + (size_t)kpos * PITCH + VOFF + g * 128 + c * 8, (unsigned)__builtin_amdgcn_readfirstlane(lds_addr(vbuf) + ((kk_) & 1) * 8192 + pi * 1024)); } } while (0)
            VM_WAIT();
            SPA_DMA(0);
#pragma unroll
            for (int kk = 0; kk < 8; ++kk) {
                if (kk < 7) { LDS_WAIT(); SPA_DMA(kk + 1); asm volatile("s_waitcnt vmcnt(8)" ::: "memory"); }
                else asm volatile("s_waitcnt vmcnt(0)" ::: "memory");
                int vx = vx0; asm volatile("" : "+v"(vx));
#pragma unroll
                for (int db = 0; db < 8; ++db) { const LAS unsigned char* a0 = vbuf + (kk & 1) * 8192 + vbase + (((((db ^ vx) << 1) | (p4 >> 1))) << 4);
                    const s16x4 lo = vtr(a0), hi = vtr(a0 + 4096);
                    const bf16x8 vf = (bf16x8){lo[0], lo[1], lo[2], lo[3], hi[0], hi[1], hi[2], hi[3]};
                    O[db] = MFMA16(vf, pb[kk], O[db]); }
            }
#undef SPA_DMA
            if (c16 < 4) { const float inv = 1.0f / sum; GAS bf16* op = (GAS bf16*)CAT + (size_t)q * D + head * 128 + 4 * q4;
#pragma unroll
                for (int db = 0; db < 8; ++db) { v2u wv; wv.x = cvtpk(O[db][0] * inv, O[db][1] * inv); wv.y = cvtpk(O[db][2] * inv, O[db][3] * inv); *(GAS v2u*)(op + 16 * db) = wv; } }
        }
    }
}
}


struct Args;
__device__ __forceinline__ const float* in_ptr(const Args& a, int i);
struct Args { const float* in[19]; float* out; unsigned char* ws; int ph_lo, ph_hi; };
__device__ __forceinline__ const float* in_ptr(const Args& a, int i) { (void)a; extern __shared__ __attribute__((aligned(16))) unsigned char lds_all[];
    const unsigned long long v = ((const LAS unsigned long long*)((LAS unsigned char*)lds_all + INP_OFF))[i];
    const unsigned lo = __builtin_amdgcn_readfirstlane((unsigned)v), hi = __builtin_amdgcn_readfirstlane((unsigned)(v >> 32));
    return (const float*)(((unsigned long long)hi << 32) | lo); }
constexpr int N_PHASES = 45 + ((MK_DUP & 4) ? 2 : 0) + ((MK_DUP & 8) ? 2 : 0) + ((MK_DUP & 64) ? 8 : 0) + ((MK_DUP & 16) ? 1 : 0) + ((MK_DUP & 1) ? 2 : 0) + ((MK_DUP & 2) ? 2 : 0) + ((MK_DUP & 512) ? 8 : 0) + ((MK_DUP & 32) ? 8 : 0);
typedef pg8::StaticOrder SOrd;
#define GEMM_PHASE(EPI, g, E, WGM_) do { int bx_ = (int)blockIdx.x, G_ = F.G; asm volatile("" : "+s"(bx_), "+s"(G_));   \
    SOrd S_; S_.init((g).M, (g).N, G_, bx_, (WGM_)); pg8::gemm_phase<EPI, SOrd, MK_ALIGN, MK_SP2>(F.lds, (g), S_, (E)); } while (0)

__global__ void __launch_bounds__(NWAVES * 64, 2) fwd_kernel(Args args) {
    extern __shared__ __attribute__((aligned(16))) unsigned char lds[];
    Frame F;
    F.lds = (LAS unsigned char*)lds;
    F.tid = threadIdx.x; F.lane = F.tid & 63; F.wave = __builtin_amdgcn_readfirstlane(F.tid >> 6);
    F.G = gridDim.x; { const int bx = blockIdx.x; F.vcu = (F.G % 8 == 0) ? (bx % 8) * (F.G / 8) + bx / 8 : bx; }
    volatile LAS unsigned* MISC = (volatile LAS unsigned*)(F.lds + MISC_OFF);
    if (F.tid < 64) MISC[F.tid] = 0u;
    if (F.tid == 0) { LAS unsigned long long* ip = (LAS unsigned long long*)(F.lds + INP_OFF);
#pragma unroll
        for (int i = 0; i < 19; ++i) ip[i] = (unsigned long long)args.in[i]; }
    __syncthreads();
    const int lo = args.ph_lo, hi = args.ph_hi;
    XcdBarrier bar; bar.bar = (unsigned*)(args.ws + WS_CTL) + CW_BAR; bar.x = 0; bar.st = nullptr;
    if (hi - lo > 1) bar = xcd_barrier_post((unsigned*)(args.ws + WS_CTL) + CW_BAR, MISC + 8, F.wave);
    int ph = 0;
#define RUN() (lo <= ph && ph < hi)
#define SEAM() do { if (lo <= ph && ph + 1 < hi) { XcdBarrier b_ = bar; asm volatile("" : "+s"(b_.bar), "+s"(b_.x));   xcd_barrier(b_, F.wave); } ++ph; } while (0)

#define WSP() unsigned char* ws = args.ws; asm volatile("" : "+s"(ws)); \
    { int t_ = threadIdx.x; asm volatile("" : "+v"(t_)); F.tid = t_; F.lane = t_ & 63; }     \
    float* XRES = (float*)(ws + WS_XRES); bf16* XN = (bf16*)(ws + WS_XN); bf16* H = (bf16*)(ws + WS_H); bf16* PROJ = (bf16*)(ws + WS_PROJ); bf16* CAT = (bf16*)(ws + WS_CAT); \
    const float* NA = (const float*)(ws + WS_VEC); const float* NB = NA + 12 * 2048; const float* GT = NB + 12 * 2048; \
    (void)XRES; (void)XN; (void)H; (void)PROJ; (void)CAT; (void)NA; (void)NB; (void)GT;
#define INP(i) in_ptr(args, (i))

    if (RUN()) { WSP(); prologue_phase(F, args, ws); }
#if MK_DUP & 16
    SEAM(); if (RUN()) { WSP(); prologue_phase(F, args, ws); }
#endif
    SEAM();
    if (RUN()) { WSP(); vec_phase(F, args, ws); }
    SEAM();

    for (int s = 0; s < 8; ++s) {
        asm volatile("" : "+s"(F.wave), "+s"(F.vcu), "+s"(F.G));
        const int l = s >> 1, f = s & 1, jn = f ? 2 : 0;
        if (RUN()) { WSP(); const float* xsrc = (s == 0) ? INP(0) : XRES; norm_phase(F, xsrc, NA + (l * 3 + jn) * 2048, NB + (l * 3 + jn) * 2048, XN); }
        SEAM();
#if MK_DUP & 32
        if (RUN()) { WSP(); const float* xsrc = (s == 0) ? INP(0) : XRES; norm_phase(F, xsrc, NA + (l * 3 + jn) * 2048, NB + (l * 3 + jn) * 2048, XN); }
        SEAM();
#endif
        if (RUN()) { WSP(); pg8::Gemm g{XN, (const bf16*)(ws + WS_W1T) + (size_t)s * W1T_SZ, S, 2 * DFF, D, 0}; pg8::EpiSwiglu E{H, DFF}; GEMM_PHASE(pg8::EpiSwiglu, g, E, MK_WGM_UP); }
        SEAM();
#if MK_DUP & 64
        if (RUN()) { WSP(); pg8::Gemm g{XN, (const bf16*)(ws + WS_W1T) + (size_t)s * W1T_SZ, S, 2 * DFF, D, 0}; pg8::EpiSwiglu E{H, DFF}; GEMM_PHASE(pg8::EpiSwiglu, g, E, MK_WGM_UP); }
        SEAM();
#endif
        if (RUN()) { WSP(); const float* xsrc = (s == 0) ? INP(0) : XRES; pg8::Gemm g{H, (const bf16*)(ws + WS_W2T) + (size_t)s * W2T_SZ, S, D, DFF, 1}; pg8::EpiResid E{xsrc, XRES, GT + (l * 3 + jn) * 2048, D}; GEMM_PHASE(pg8::EpiResid, g, E, MK_WGM_DN); }
        SEAM();
#if MK_DUP & 512
        if (RUN()) { WSP(); pg8::Gemm g{H, (const bf16*)(ws + WS_W2T) + (size_t)s * W2T_SZ, S, D, DFF, 1}; pg8::EpiResid E{XRES, XRES, (const float*)(ws + WS_CTL + 524288), D}; GEMM_PHASE(pg8::EpiResid, g, E, MK_WGM_OUT); }
        SEAM();
#endif
        if (f == 0) {
            if (RUN()) { WSP(); norm_phase(F, XRES, NA + (l * 3 + 1) * 2048, NB + (l * 3 + 1) * 2048, XN); }
            SEAM();
            const int j = l >> 1;
            if ((l & 1) == 0) {
                if (RUN()) { WSP(); pg8::Gemm g{XN, (const bf16*)(ws + WS_ABIN) + (size_t)j * ABIN_SZ, S, ABN, D, 0}; pg8::EpiProj E{PROJ, ABN, 4, da::C2, 12}; GEMM_PHASE(pg8::EpiProj, g, E, MK_WGM_IN); }
                SEAM();
                if (RUN()) {
#if MK_AB
                    WSP();
                    const float* lp = INP(10) + j * 256;
                    const float s01 = wave_sum(lp[F.lane] * lp[64 + F.lane]), s23 = wave_sum(lp[128 + F.lane] * lp[192 + F.lane]);
                    const float lam_init = (j == 0) ? 0.2f : 0.4707130183435842f;
                    const float lam = expf(s01) - expf(s23) + lam_init;
                    for (int ui = F.vcu; ui < 1024; ui += F.G) { const int v = ui & 255, k = ui >> 8, h = v >> 5, p = v & 31;
                        const int qb = (k == 0) ? p : (k == 1) ? 127 - p : (k == 2) ? 63 - p : 64 + p;
                        da::unit(F.tid, F.lds, PROJ, CAT, h, qb, lam, 1.0f - lam_init, INP(11) + j * 128, INP(7)); }
                    for (int ui = F.vcu; ui < 1024; ui += F.G)
                        sgp::unit(F.tid, F.lds, PROJ, CAT, ui >> 3, ui & 7, INP(12) + j * 1024, INP(13) + j * 1024, INP(14) + (size_t)j * 8 * 128 * 128, INP(15) + j * 8 * 128);
#endif
                }
                SEAM();
#if MK_DUP & 2
                if (RUN()) { WSP();
                    for (int ui = F.vcu; ui < 1024; ui += F.G)
                        sgp::unit(F.tid, F.lds, PROJ, CAT, ui >> 3, ui & 7, INP(12) + j * 1024, INP(13) + j * 1024, INP(14) + (size_t)j * 8 * 128 * 128, INP(15) + j * 8 * 128); }
                SEAM();
#endif
#if MK_DUP & 1
                if (RUN()) {
#if MK_AB
                    WSP();
                    const float* lp = INP(10) + j * 256;
                    const float s01 = wave_sum(lp[F.lane] * lp[64 + F.lane]), s23 = wave_sum(lp[128 + F.lane] * lp[192 + F.lane]);
                    const float lam_init = (j == 0) ? 0.2f : 0.4707130183435842f;
                    const float lam = expf(s01) - expf(s23) + lam_init;
                    for (int ui = F.vcu; ui < 1024; ui += F.G) { const int v = ui & 255, k = ui >> 8, h = v >> 5, p = v & 31;
                        const int qb = (k == 0) ? p : (k == 1) ? 127 - p : (k == 2) ? 63 - p : 64 + p;
                        da::unit(F.tid, F.lds, PROJ, CAT, h, qb, lam, 1.0f - lam_init, INP(11) + j * 128, INP(7)); }
                    for (int ui = F.vcu; ui < 1024; ui += F.G)
                        sgp::unit(F.tid, F.lds, PROJ, CAT, ui >> 3, ui & 7, INP(12) + j * 1024, INP(13) + j * 1024, INP(14) + (size_t)j * 8 * 128 * 128, INP(15) + j * 8 * 128);
#endif
                }
                SEAM();
#endif
                if (RUN()) {
#if MK_AB
                    WSP(); pg8::Gemm g{CAT, (const bf16*)(ws + WS_ABOUT) + (size_t)j * SQ_SZ, S, D, D, 0}; pg8::EpiResid E{XRES, XRES, GT + (l * 3 + 1) * 2048, D}; GEMM_PHASE(pg8::EpiResid, g, E, MK_WGM_OUT);
#endif
                }
                SEAM();
            } else {
                if (RUN()) {
#if MK_DSA
                    WSP(); pg8::Gemm g{XN, (const bf16*)(ws + WS_DSAIN) + (size_t)j * DSAIN_SZ, S, CINP, D, 0}; pg8::EpiProj E{PROJ, CINP, 8, dsa::CQ, 1000}; GEMM_PHASE(pg8::EpiProj, g, E, MK_WGM_IN);
#endif
                }
                SEAM();
                if (RUN()) {
#if MK_DSA
                    WSP(); dsa::index_phase(F, PROJ, (unsigned short*)(ws + WS_SEL));
#endif
                }
                SEAM();
#if MK_DUP & 4
                if (RUN()) { WSP(); dsa::index_phase(F, PROJ, (unsigned short*)(ws + WS_SEL)); }
                SEAM();
#endif
                if (RUN()) {
#if MK_DSA
                    WSP(); dsa::attn_phase(F, PROJ, (const unsigned short*)(ws + WS_SEL), CAT, INP(7));
#endif
                }
                SEAM();
#if MK_DUP & 8
                if (RUN()) { WSP(); dsa::attn_phase(F, PROJ, (const unsigned short*)(ws + WS_SEL), CAT, INP(7)); }
                SEAM();
#endif
                if (RUN()) {
#if MK_DSA
                    WSP(); pg8::Gemm g{CAT, (const bf16*)(ws + WS_DSAOUT) + (size_t)j * SQ_SZ, S, D, D, 0}; pg8::EpiResid E{XRES, XRES, GT + (l * 3 + 1) * 2048, D}; GEMM_PHASE(pg8::EpiResid, g, E, MK_WGM_OUT);
#endif
                }
                SEAM();
            }
        }
    }
    if (RUN()) { WSP(); final_norm_phase(F, XRES, INP(18), args.out); }
    ++ph;
#undef RUN
#undef SEAM
}


extern "C" void kernel_launch(void* const* d_in, const int* in_sizes, int n_in, void* d_out, int out_size, void* d_ws, size_t ws_size, hipStream_t stream) {
    static int grid = 0;
    if (grid == 0) {
        if (n_in != 19 || in_sizes[0] != S * D || out_size != S * D || ws_size < WS_END) { fprintf(stderr, "kernel_launch: unexpected shapes (n_in %d, in0 %d, out %d, ws %zu); nothing launched\n", n_in, n_in > 0 ? in_sizes[0] : -1, out_size, ws_size); grid = -1; return; }
        int dev = 0, cus = 0, per_cu = 0;
        if (hipGetDevice(&dev) != hipSuccess || hipDeviceGetAttribute(&cus, hipDeviceAttributeMultiprocessorCount, dev) != hipSuccess) { grid = -1; return; }
        if (hipFuncSetAttribute((const void*)fwd_kernel, hipFuncAttributeMaxDynamicSharedMemorySize, LDS_BYTES) != hipSuccess) { fprintf(stderr, "kernel_launch: hipFuncSetAttribute failed\n"); grid = -1; return; }
        if (hipOccupancyMaxActiveBlocksPerMultiprocessor(&per_cu, (const void*)fwd_kernel, NWAVES * 64, LDS_BYTES) != hipSuccess || per_cu < 1)
            fprintf(stderr, "kernel_launch: note: occupancy query reports %d workgroups per CU\n", per_cu);
        (void)hipGetLastError();
        grid = cus;
    }
    if (grid < 0) return;
    if (hipMemsetAsync((char*)d_ws + WS_CTL, 0, CTL_ZERO_BYTES, stream) != hipSuccess) return;
    Args a{};
    for (int i = 0; i < 19; ++i) a.in[i] = (const float*)d_in[i];
    a.out = (float*)d_out; a.ws = (unsigned char*)d_ws;
#if MK_DIAG == 99
    {
        hipFuncSetAttribute((const void*)diag_check, hipFuncAttributeMaxDynamicSharedMemorySize, 143360);
        const int up_ph[8] = {3, 10, 13, 21, 24, 31, 34, 42}; int done = -1;
        for (int s = 1; s < 8; ++s) {
            for (int p = done + 1; p <= up_ph[s]; ++p) { a.ph_lo = p; a.ph_hi = p + 1; hipLaunchKernelGGL(fwd_kernel, dim3(grid), dim3(NWAVES * 64), LDS_BYTES, stream, a); }
            if (s == 1) hipLaunchKernelGGL(diag_check, dim3(16 * 12), dim3(512), 143360, stream, a, 8, 0);
            hipLaunchKernelGGL(diag_check, dim3(16), dim3(512), 143360, stream, a, 2, s);
            hipMemcpyAsync((char*)d_ws + WS_END, (char*)d_ws + WS_XRES, (size_t)S * D * 4, hipMemcpyDeviceToDevice, stream);
            a.ph_lo = up_ph[s] + 1; a.ph_hi = up_ph[s] + 2; hipLaunchKernelGGL(fwd_kernel, dim3(grid), dim3(NWAVES * 64), LDS_BYTES, stream, a);
            done = up_ph[s] + 1;
            hipLaunchKernelGGL(diag_check, dim3(16), dim3(512), 143360, stream, a, 3, s);
        }
        for (int p = done + 1; p < N_PHASES; ++p) { a.ph_lo = p; a.ph_hi = p + 1; hipLaunchKernelGGL(fwd_kernel, dim3(grid), dim3(NWAVES * 64), LDS_BYTES, stream, a); }
        hipLaunchKernelGGL(diag_check, dim3(16), dim3(512), 143360, stream, a, 9, 0);
        hipLaunchKernelGGL(diag_out, dim3((S * D + 255) / 256), dim3(256), 0, stream, a);
        return;
    }
#elif MK_DIAG
    {
        int digits[8], nd = 0; for (int v = MK_DIAG; v > 0; v /= 10) digits[nd++] = v % 10;
        hipFuncSetAttribute((const void*)diag_check, hipFuncAttributeMaxDynamicSharedMemorySize, 143360);
        int done = -1;
        for (int stage = 0; stage < 3; ++stage) {
            const int upto = ((stage == 0) ? 4 : (stage == 1) ? 7 : 8) + (MK_DIAGJ ? 21 : 0); bool any = false;
            for (int i = 0; i < nd; ++i) { const int w = digits[i]; const int st = (w <= 3) ? 0 : (w <= 6) ? 1 : 2; any |= (st == stage); }
            if (!any) continue;
            for (int p = done + 1; p <= upto; ++p) { a.ph_lo = p; a.ph_hi = p + 1; hipLaunchKernelGGL(fwd_kernel, dim3(grid), dim3(NWAVES * 64), LDS_BYTES, stream, a); }
            done = upto;
            for (int i = 0; i < nd; ++i) { const int w = digits[i]; const int st = (w <= 3) ? 0 : (w <= 6) ? 1 : 2; if (st == stage) hipLaunchKernelGGL(diag_check, dim3(w == 5 ? 128 : 16), dim3(512), 143360, stream, a, w, MK_DIAGJ); }
        }
        hipLaunchKernelGGL(diag_out, dim3((S * D + 255) / 256), dim3(256), 0, stream, a);
        return;
    }
#endif
#if MK_MULTI
    for (int p = 0; p < N_PHASES; ++p) { a.ph_lo = p; a.ph_hi = p + 1; hipLaunchKernelGGL(fwd_kernel, dim3(grid), dim3(NWAVES * 64), LDS_BYTES, stream, a); }
#else
    a.ph_lo = 0; a.ph_hi = N_PHASES;
    hipLaunchKernelGGL(fwd_kernel, dim3(grid), dim3(NWAVES * 64), LDS_BYTES, stream, a);
#endif
    const hipError_t le = hipPeekAtLastError();
    if (le != hipSuccess) fprintf(stderr, "kernel_launch: launch failed: %s\n", hipGetErrorName(le));
}
```
